# Optimizing an MI355X kernel written in HIP

```python
import jax, jax.numpy as jnp
from jax import lax
import numpy as np

D_MODEL = 2048
BATCH = 4
SEQ = 4096
DEPTH = 1

GRID_W = 64
CTX_LEN = 256
HEAD_DIM = 128
ATT_HEADS = 8
ATT_KV_HEADS = 2
ATT_GROUP = ATT_HEADS // ATT_KV_HEADS
RET_HEADS = 4
RET_QK_DIM = 128
RET_V_DIM = 256
ROPE_THETA = 10000.0
Q_BLOCK = 128
RET_CHUNK = 128
N_EXPERTS = 16
EXPERT_FF = 2048
EC_FACTOR = 2
EPS = 1e-6

ATT_W = ATT_HEADS * HEAD_DIM
ATT_KV_W = ATT_KV_HEADS * HEAD_DIM
RET_QK_W = RET_HEADS * RET_QK_DIM
RET_V_W = RET_HEADS * RET_V_DIM
Q_SIZES = (ATT_W, RET_QK_W, RET_V_W, D_MODEL, D_MODEL)
KV_SIZES = (ATT_KV_W, ATT_KV_W, RET_QK_W, RET_V_W)
Q_WIDTH = ATT_W + RET_QK_W + RET_V_W + 2 * D_MODEL
KV_WIDTH = 2 * ATT_KV_W + RET_QK_W + RET_V_W
IN_WIDTH = Q_WIDTH + KV_WIDTH

kernel_name = 'hybrid_gqa_retention_ec_moe_prefix_dit'


def _points(sizes):
    return [int(p) for p in np.cumsum(sizes)[:-1]]


def rms_norm(x, g):
    xf = x.astype(jnp.float32)
    y = xf * lax.rsqrt(jnp.mean(xf * xf, axis=-1, keepdims=True) + EPS)
    return (y * g.astype(jnp.float32)).astype(x.dtype)


def modulate(x, shift, scale):
    return x * (1.0 + scale) + shift


def axial_rope_tables(n_tokens):
    rows = n_tokens // GRID_W
    r, cl = jnp.meshgrid(jnp.arange(rows), jnp.arange(GRID_W), indexing='ij')
    r = r.reshape(-1).astype(jnp.float32)
    cl = cl.reshape(-1).astype(jnp.float32)
    quarter = HEAD_DIM // 4
    inv = ROPE_THETA ** (-jnp.arange(quarter, dtype=jnp.float32) / quarter)
    ang_r = r[:, None] * inv
    ang_c = cl[:, None] * inv
    ang = jnp.concatenate([ang_r, ang_r, ang_c, ang_c], axis=-1)
    return jnp.cos(ang), jnp.sin(ang)


def apply_rope(x, cos, sin):
    x4 = x.reshape(x.shape[:-1] + (2, 2, HEAD_DIM // 4))
    rot = jnp.stack([-x4[..., 1, :], x4[..., 0, :]], axis=-2).reshape(x.shape)
    out = x.astype(jnp.float32) * cos[:, None, :] + rot.astype(jnp.float32) * sin[:, None, :]
    return out.astype(x.dtype)


def q_heads(z_q, q_norm_g, cos, sin):
    B, T, _ = z_q.shape
    q_a, q_r, g_r, gate_a, gate_r = jnp.split(z_q, _points(Q_SIZES), axis=-1)
    q_a = rms_norm(q_a.reshape(B, T, ATT_HEADS, HEAD_DIM), q_norm_g)
    q_r = q_r.reshape(B, T, RET_HEADS, RET_QK_DIM)
    if cos is not None:
        q_a = apply_rope(q_a, cos, sin)
        q_r = apply_rope(q_r, cos, sin)
    q_r = q_r.transpose(0, 2, 1, 3).astype(jnp.float32)
    return q_a, q_r, g_r, gate_a, gate_r


def kv_heads(z_kv, k_norm_g, cos, sin):
    B, T, _ = z_kv.shape
    k_a, v_a, k_r, v_r = jnp.split(z_kv, _points(KV_SIZES), axis=-1)
    k_a = rms_norm(k_a.reshape(B, T, ATT_KV_HEADS, HEAD_DIM), k_norm_g)
    v_a = v_a.reshape(B, T, ATT_KV_HEADS, HEAD_DIM)
    k_r = k_r.reshape(B, T, RET_HEADS, RET_QK_DIM) * (RET_QK_DIM ** -0.5)
    if cos is not None:
        k_a = apply_rope(k_a, cos, sin)
        k_r = apply_rope(k_r, cos, sin)
    k_r = k_r.transpose(0, 2, 1, 3).astype(jnp.float32)
    v_r = v_r.reshape(B, T, RET_HEADS, RET_V_DIM).transpose(0, 2, 1, 3).astype(jnp.float32)
    return k_a, v_a, k_r, v_r


def latent_attention(q, k, v, k_ctx, v_ctx):
    B, T, _, _ = q.shape
    nb = T // Q_BLOCK
    keys = jnp.concatenate([k_ctx, k], axis=1).transpose(0, 2, 1, 3)
    vals = jnp.concatenate([v_ctx, v], axis=1).transpose(0, 2, 1, 3)
    qb = q.reshape(B, nb, Q_BLOCK, ATT_KV_HEADS, ATT_GROUP, HEAD_DIM).transpose(1, 0, 3, 4, 2, 5)
    scale = HEAD_DIM ** -0.5

    def block(qi):
        s = jnp.einsum('bhgqd,bhkd->bhgqk', qi, keys).astype(jnp.float32) * scale
        p = jax.nn.softmax(s, axis=-1).astype(vals.dtype)
        return jnp.einsum('bhgqk,bhkd->bhgqd', p, vals)

    o = lax.map(block, qb)
    return o.transpose(1, 0, 4, 2, 3, 5).reshape(B, T, ATT_W)


def context_attention(q, k, v):
    B, L, _, _ = q.shape
    qg = q.reshape(B, L, ATT_KV_HEADS, ATT_GROUP, HEAD_DIM)
    s = jnp.einsum('blhgd,bmhd->bhglm', qg, k).astype(jnp.float32) * (HEAD_DIM ** -0.5)
    p = jax.nn.softmax(s, axis=-1).astype(v.dtype)
    return jnp.einsum('bhglm,bmhd->blhgd', p, v).reshape(B, L, ATT_W)


def retention_chunked(q, k, v, log_g, s0):
    B, H, T, dk = q.shape
    dv = v.shape[-1]
    C = RET_CHUNK
    n = T // C
    i = jnp.arange(C, dtype=jnp.float32)
    diff = i[:, None] - i[None, :]
    mask = jnp.where(diff >= 0, jnp.exp(jnp.maximum(diff, 0.0)[None] * log_g[:, None, None]), 0.0)
    qc = q.reshape(B, H, n, C, dk)
    kc = k.reshape(B, H, n, C, dk)
    vc = v.reshape(B, H, n, C, dv)
    s = jnp.einsum('bhnid,bhnjd->bhnij', qc, kc) * mask[None, :, None]
    o_inner = jnp.einsum('bhnij,bhnjv->bhniv', s, vc)
    w_k = jnp.exp((C - 1 - i)[None] * log_g[:, None])
    u = jnp.einsum('bhnjd,bhnjv->nbhdv', kc * w_k[None, :, None, :, None], vc)
    g_chunk = jnp.exp(C * log_g)[None, :, None, None]

    def step(state, u_n):
        return g_chunk * state + u_n, state

    s_final, s_prev = lax.scan(step, s0, u)
    w_q = jnp.exp((i + 1.0)[None] * log_g[:, None])
    o_cross = jnp.einsum('bhnid,nbhdv->bhniv', qc * w_q[None, :, None, :, None], s_prev)
    return (o_inner + o_cross).reshape(B, H, T, dv), s_final


def retention_final_state(k, v, log_g):
    L = k.shape[2]
    age = jnp.arange(L - 1, -1, -1, dtype=jnp.float32)
    w = jnp.exp(age[None] * log_g[:, None])
    return jnp.einsum('bhld,bhlv->bhdv', k * w[None, :, :, None], v)


def bidir_retention(q, k, v, log_f, log_b, s_f, s_b):
    o_f, _ = retention_chunked(q, k, v, log_f, s_f)
    o_b, _ = retention_chunked(jnp.flip(q, 2), jnp.flip(k, 2), jnp.flip(v, 2), log_b, s_b)
    return o_f + jnp.flip(o_b, 2)


def retention_output(o, g_r, gn_g):
    B, H, T, dv = o.shape
    mu = jnp.mean(o, axis=-1, keepdims=True)
    var = jnp.mean(jnp.square(o - mu), axis=-1, keepdims=True)
    y = ((o - mu) * lax.rsqrt(var + EPS)).transpose(0, 2, 1, 3).reshape(B, T, H * dv)
    y = y * gn_g.astype(jnp.float32) * jax.nn.silu(g_r.astype(jnp.float32))
    return y.astype(g_r.dtype)


def merge_branches(o_att, o_ret, gate_a, gate_r, w_o_att, w_o_ret, w_out):
    y = jax.nn.sigmoid(gate_a) * (o_att @ w_o_att) + jax.nn.sigmoid(gate_r) * (o_ret @ w_o_ret)
    return y @ w_out


def expert_choice_ffn(h, w_router, w_gate, w_up, w_down):
    B, T, D = h.shape
    cap = EC_FACTOR * T // N_EXPERTS
    aff = jax.nn.softmax((h @ w_router).astype(jnp.float32), axis=-1)
    top_w, top_i = lax.top_k(aff.transpose(0, 2, 1), cap)
    xg = jax.vmap(lambda hb, ib: hb[ib])(h, top_i)
    a = jnp.einsum('becd,edf->becf', xg, w_gate)
    b = jnp.einsum('becd,edf->becf', xg, w_up)
    y = jnp.einsum('becf,efd->becd', jax.nn.silu(a) * b, w_down) * top_w[..., None].astype(h.dtype)
    return jax.vmap(lambda yb, ib: jnp.zeros((T, D), h.dtype).at[ib.reshape(-1)].add(yb.reshape(-1, D)))(y, top_i)


def setup_inputs(seed: int = 0) -> dict:
    key = jax.random.key(seed)
    ks = jax.random.split(key, 24)
    f32 = jnp.float32

    def nrm(k, shape, s):
        return jax.random.normal(k, shape, f32) * s

    def gain(k, shape):
        return 1.0 + 0.01 * jax.random.normal(k, shape, f32)

    gamma0 = 1.0 - 2.0 ** (-5.0 - np.arange(RET_HEADS))
    p0 = np.log(np.expm1(-np.log(gamma0))).astype(np.float32)
    return {
        'x': nrm(ks[0], (BATCH, SEQ, D_MODEL), 1.0),
        'c': nrm(ks[1], (BATCH, D_MODEL), 1.0),
        'ctx': nrm(ks[2], (BATCH, CTX_LEN, D_MODEL), 1.0),
        'c_ctx': nrm(ks[3], (D_MODEL,), 1.0),
        'w_mod': nrm(ks[4], (DEPTH, D_MODEL, 6 * D_MODEL), 0.5 * D_MODEL ** -0.5),
        'b_mod': nrm(ks[5], (DEPTH, 6 * D_MODEL), 0.01),
        'pre_norm1': gain(ks[6], (DEPTH, D_MODEL)),
        'post_norm1': gain(ks[7], (DEPTH, D_MODEL)),
        'pre_norm2': gain(ks[8], (DEPTH, D_MODEL)),
        'post_norm2': gain(ks[9], (DEPTH, D_MODEL)),
        'w_in': nrm(ks[10], (DEPTH, D_MODEL, IN_WIDTH), D_MODEL ** -0.5),
        'q_norm': gain(ks[11], (DEPTH, HEAD_DIM)),
        'k_norm': gain(ks[12], (DEPTH, HEAD_DIM)),
        'ret_decay': jnp.asarray(p0)[None, None, :] + nrm(ks[13], (DEPTH, 2, RET_HEADS), 0.05),
        'ret_gn': gain(ks[14], (DEPTH, RET_V_W)),
        'w_o_att': nrm(ks[15], (DEPTH, ATT_W, D_MODEL), ATT_W ** -0.5),
        'w_o_ret': nrm(ks[16], (DEPTH, RET_V_W, D_MODEL), RET_V_W ** -0.5),
        'w_out': nrm(ks[17], (DEPTH, D_MODEL, D_MODEL), D_MODEL ** -0.5),
        'w_router': nrm(ks[18], (DEPTH, D_MODEL, N_EXPERTS), D_MODEL ** -0.5),
        'w_gate': nrm(ks[19], (DEPTH, N_EXPERTS, D_MODEL, EXPERT_FF), D_MODEL ** -0.5),
        'w_up': nrm(ks[20], (DEPTH, N_EXPERTS, D_MODEL, EXPERT_FF), D_MODEL ** -0.5),
        'w_down': nrm(ks[21], (DEPTH, N_EXPERTS, EXPERT_FF, D_MODEL), EXPERT_FF ** -0.5),
    }


def reference(x, c, ctx, c_ctx, w_mod, b_mod, pre_norm1, post_norm1, pre_norm2, post_norm2,
              w_in, q_norm, k_norm, ret_decay, ret_gn, w_o_att, w_o_ret, w_out,
              w_router, w_gate, w_up, w_down):
    B, T, _ = x.shape
    cos, sin = axial_rope_tables(T)
    xc = ctx
    for layer in range(DEPTH):
        last = layer == DEPTH - 1
        mod = jax.nn.silu(c) @ w_mod[layer] + b_mod[layer]
        sh1, sc1, gt1, sh2, sc2, gt2 = [m[:, None, :] for m in jnp.split(mod, 6, axis=-1)]
        mod_c = jax.nn.silu(c_ctx) @ w_mod[layer] + b_mod[layer]
        csh1, csc1, cgt1, csh2, csc2, cgt2 = jnp.split(mod_c, 6, axis=-1)
        log_f = -jax.nn.softplus(ret_decay[layer, 0].astype(jnp.float32))
        log_b = -jax.nn.softplus(ret_decay[layer, 1].astype(jnp.float32))

        h = modulate(rms_norm(x, pre_norm1[layer]), sh1, sc1)
        hc = modulate(rms_norm(xc, pre_norm1[layer]), csh1, csc1)
        kc_a, vc_a, kc_r, vc_r = kv_heads(hc @ w_in[layer][:, Q_WIDTH:], k_norm[layer], None, None)
        sc_f = retention_final_state(kc_r, vc_r, log_f)
        sc_b = retention_final_state(jnp.flip(kc_r, 2), jnp.flip(vc_r, 2), log_b)
        z = h @ w_in[layer]
        q_a, q_r, g_r, gate_a, gate_r = q_heads(z[..., :Q_WIDTH], q_norm[layer], cos, sin)
        k_a, v_a, k_r, v_r = kv_heads(z[..., Q_WIDTH:], k_norm[layer], cos, sin)
        o_att = latent_attention(q_a, k_a, v_a, kc_a, vc_a)
        o_ret = retention_output(bidir_retention(q_r, k_r, v_r, log_f, log_b, sc_f, sc_b), g_r, ret_gn[layer])
        y = merge_branches(o_att, o_ret, gate_a, gate_r, w_o_att[layer], w_o_ret[layer], w_out[layer])
        x = x + gt1 * rms_norm(y, post_norm1[layer])
        if not last:
            qc_a, qc_r, gc_r, gatec_a, gatec_r = q_heads(hc @ w_in[layer][:, :Q_WIDTH], q_norm[layer], None, None)
            oc_att = context_attention(qc_a, kc_a, vc_a)
            zero_state = jnp.zeros_like(sc_f)
            oc_ret = retention_output(bidir_retention(qc_r, kc_r, vc_r, log_f, log_b, zero_state, zero_state),
                                      gc_r, ret_gn[layer])
            yc = merge_branches(oc_att, oc_ret, gatec_a, gatec_r, w_o_att[layer], w_o_ret[layer], w_out[layer])
            xc = xc + cgt1 * rms_norm(yc, post_norm1[layer])

        h2 = modulate(rms_norm(x, pre_norm2[layer]), sh2, sc2)
        y2 = expert_choice_ffn(h2, w_router[layer], w_gate[layer], w_up[layer], w_down[layer])
        x = x + gt2 * rms_norm(y2, post_norm2[layer])
        if not last:
            hc2 = modulate(rms_norm(xc, pre_norm2[layer]), csh2, csc2)
            yc2 = expert_choice_ffn(hc2, w_router[layer], w_gate[layer], w_up[layer], w_down[layer])
            xc = xc + cgt2 * rms_norm(yc2, post_norm2[layer])
    return x
```

```cpp
#include <hip/hip_runtime.h>
#include <cstdio>
#include <cstdint>

#ifndef MK_N_LAUNCHES
#define MK_N_LAUNCHES 15
#endif

namespace pg8 {
#define PG8_LAS __attribute__((address_space(3)))
typedef unsigned short bf16_t;
typedef short bf16x8 __attribute__((ext_vector_type(8)));
typedef float f32x4 __attribute__((ext_vector_type(4)));
typedef unsigned u32x4 __attribute__((ext_vector_type(4)));
constexpr int BM = 256, BK = 64, HALF = 128, HTB = HALF * BK * 2, STAGE_BYTES = 8 * HTB, NXCD = 8, WGM = 8;

__host__ __device__ __forceinline__ int lds_byte(int r, int c) { const int st = (r >> 4) * 2 + (c >> 5), rr = r & 15, cc = c & 31, ob = rr * 64 + cc * 2; return st * 1024 + (ob ^ (((ob >> 9) & 1) << 5)); }
__host__ __device__ __forceinline__ void stage_rc(int b, int& R, int& C) { const int st = b / 1024, sb = b % 1024, swz = sb ^ (((sb >> 9) & 1) << 5); R = (st >> 1) * 16 + swz / 64; C = (st & 1) * 32 + (swz % 64) / 2; }
__host__ __device__ __forceinline__ int perm32(int rho) { const int n = rho >> 4, i = rho & 15; return 8 * (i >> 2) + 4 * n + (i & 3); }

struct Unit { int pm, pn; };
struct Gemm { const bf16_t* A; const bf16_t* Bt; int lda, ldb, K; };

struct StaticOrder {
    int nM, nN, nwg, G, c;
    __host__ __device__ void init(int M, int N, int G_, int c_) { nM = M / BM; nN = N / BM; nwg = nM * nN; G = G_; c = c_; }
    __host__ __device__ bool next(int i, Unit& u) const {
        const long L = (long)i * G + c; if (L >= nwg) return false;
        int wgid = (int)L; { const int q = nwg / NXCD, r = nwg % NXCD, xcd = wgid % NXCD, off = wgid / NXCD; wgid = (xcd < r ? xcd * (q + 1) : r * (q + 1) + (xcd - r) * q) + off; }
        const int nig = WGM * nN, gid = wgid / nig, fm = gid * WGM, gsz = (nM - fm) < WGM ? (nM - fm) : WGM;
        u.pm = fm + ((wgid % nig) % gsz); u.pn = (wgid % nig) / gsz; return true;
    }
};
struct InProjOrder {
    StaticOrder so; int G, c;
    __host__ __device__ void init(int G_, int c_) { so.init(16384, 8704, G_, c_); G = G_; c = c_; }
    __host__ __device__ bool next(int i, Unit& u) const {
        const long L = (long)i * G + c; if (L < so.nwg) return so.next(i, u);
        const int r = (int)(L - so.nwg); if (r >= 32) return false;
        u.pm = 64 + (r >> 3); u.pn = 26 + (r & 7); return true;
    }
};
struct ExpertOrder {
    int nPm, nPn, per, total, G, c;
    __host__ __device__ void init(int nE, int nPm_, int nPn_, int G_, int c_) { nPm = nPm_; nPn = nPn_; per = nPm * nPn; total = nE * per; G = G_; c = c_; }
    __host__ __device__ bool next(int i, Unit& u) const {
        const long L = (long)i * G + c; if (L >= total) return false;
        const int e = (int)L / per, rem = (int)L % per; u.pm = e * nPm + rem % nPm; u.pn = e * nPn + rem / nPm; return true;
    }
};

__device__ __forceinline__ unsigned cvt_pk_bf16(float lo, float hi) { unsigned r; asm volatile("v_cvt_pk_bf16_f32 %0, %1, %2" : "=v"(r) : "v"(lo), "v"(hi)); return r; }
__device__ __forceinline__ float bflo(unsigned w) { return __uint_as_float(w << 16); }
__device__ __forceinline__ float bfhi(unsigned w) { return __uint_as_float(w & 0xffff0000u); }
__device__ __forceinline__ float sigmoidf_(float x) { return 1.0f / (1.0f + __expf(-x)); }

#define PG8_EPI_LOOP_BEGIN _Pragma("unroll") for (int ai = 0; ai < 2; ++ai) _Pragma("unroll") for (int m = 0; m < 4; ++m) { const int rloc = ai * HALF + wr * 64 + m * 16 + fr;
#define PG8_EPI_LOOP_END }
__device__ __forceinline__ u32x4 pack8(const f32x4& v0, const f32x4& v1) { u32x4 w; w.x = cvt_pk_bf16(v0[0], v0[1]); w.y = cvt_pk_bf16(v0[2], v0[3]); w.z = cvt_pk_bf16(v1[0], v1[1]); w.w = cvt_pk_bf16(v1[2], v1[3]); return w; }

struct EpiZ {
    static constexpr bool PERM = true;
    bf16_t *QA, *QR, *GR, *GATE, *KA, *VA, *KR, *VR;
    __device__ __forceinline__ void operator()(const f32x4 (&acc)[2][2][4][2], const Unit& u, int wr, int wc, int fr, int fq) const {
        const int pn = u.pn, pm = u.pm; bf16_t* base; int ldc, colt;
        if (pn < 4) { base = QA; ldc = 1024; colt = pn * 256; } else if (pn < 6) { base = QR; ldc = 512; colt = (pn - 4) * 256; } else if (pn < 10) { base = GR; ldc = 1024; colt = (pn - 6) * 256; }
        else if (pn < 26) { base = GATE; ldc = 4096; colt = (pn - 10) * 256; } else if (pn == 26) { base = KA; ldc = 256; colt = 0; } else if (pn == 27) { base = VA; ldc = 256; colt = 0; }
        else if (pn < 30) { base = KR; ldc = 512; colt = (pn - 28) * 256; } else { base = VR; ldc = 1024; colt = (pn - 30) * 256; }
        int rowt; if (pn < 26) rowt = pm * 256; else if (pm < 64) rowt = (pm >> 4) * 4352 + 256 + (pm & 15) * 256; else rowt = (pm - 64) * 4352;
        const int col0 = colt + wc * 32 + 8 * fq;
        PG8_EPI_LOOP_BEGIN
            bf16_t* rowp = base + (size_t)(rowt + rloc) * ldc + col0;
#pragma unroll
            for (int bj = 0; bj < 2; ++bj) *(u32x4*)(rowp + bj * HALF) = pack8(acc[ai][bj][m][0], acc[ai][bj][m][1]);
        PG8_EPI_LOOP_END
    }
};
struct EpiPlain {
    static constexpr bool PERM = true;
    bf16_t* O; int ldc;
    __device__ __forceinline__ void operator()(const f32x4 (&acc)[2][2][4][2], const Unit& u, int wr, int wc, int fr, int fq) const {
        const int col0 = u.pn * BM + wc * 32 + 8 * fq;
        PG8_EPI_LOOP_BEGIN
            bf16_t* rowp = O + (size_t)(u.pm * BM + rloc) * ldc + col0;
#pragma unroll
            for (int bj = 0; bj < 2; ++bj) *(u32x4*)(rowp + bj * HALF) = pack8(acc[ai][bj][m][0], acc[ai][bj][m][1]);
        PG8_EPI_LOOP_END
    }
};
template <bool ADD> struct EpiGate {
    static constexpr bool PERM = true;
    bf16_t* Y; const bf16_t* gate; int goff;
    __device__ __forceinline__ void operator()(const f32x4 (&acc)[2][2][4][2], const Unit& u, int wr, int wc, int fr, int fq) const {
        const int col0 = u.pn * BM + wc * 32 + 8 * fq;
        PG8_EPI_LOOP_BEGIN
            const size_t row = (size_t)(u.pm * BM + rloc);
#pragma unroll
            for (int bj = 0; bj < 2; ++bj) {
                const u32x4 g = *(const u32x4*)(gate + row * 4096 + goff + col0 + bj * HALF);
                f32x4 v0 = acc[ai][bj][m][0], v1 = acc[ai][bj][m][1];
                v0[0] *= sigmoidf_(bflo(g.x)); v0[1] *= sigmoidf_(bfhi(g.x)); v0[2] *= sigmoidf_(bflo(g.y)); v0[3] *= sigmoidf_(bfhi(g.y));
                v1[0] *= sigmoidf_(bflo(g.z)); v1[1] *= sigmoidf_(bfhi(g.z)); v1[2] *= sigmoidf_(bflo(g.w)); v1[3] *= sigmoidf_(bfhi(g.w));
                bf16_t* yp = Y + row * 2048 + col0 + bj * HALF;
                if (ADD) { const u32x4 y = *(const u32x4*)yp;
                    v0[0] += bflo(y.x); v0[1] += bfhi(y.x); v0[2] += bflo(y.y); v0[3] += bfhi(y.y); v1[0] += bflo(y.z); v1[1] += bfhi(y.z); v1[2] += bflo(y.w); v1[3] += bfhi(y.w); }
                *(u32x4*)yp = pack8(v0, v1);
            }
        PG8_EPI_LOOP_END
    }
};
struct EpiSwiGLU {
    static constexpr bool PERM = true;
    bf16_t* ACT;
    __device__ __forceinline__ void operator()(const f32x4 (&acc)[2][2][4][2], const Unit& u, int wr, int wc, int fr, int fq) const {
        const int col0 = (u.pn & 15) * 128 + wc * 32 + 8 * fq;
        PG8_EPI_LOOP_BEGIN
            f32x4 v0, v1;
#pragma unroll
            for (int j = 0; j < 4; ++j) { const float a0 = acc[ai][0][m][0][j], a1 = acc[ai][0][m][1][j]; v0[j] = a0 * sigmoidf_(a0) * acc[ai][1][m][0][j]; v1[j] = a1 * sigmoidf_(a1) * acc[ai][1][m][1][j]; }
            *(u32x4*)(ACT + (size_t)(u.pm * BM + rloc) * 2048 + col0) = pack8(v0, v1);
        PG8_EPI_LOOP_END
    }
};
struct EpiDown {
    static constexpr bool PERM = true;
    bf16_t* Y; const float* topw;
    __device__ __forceinline__ void operator()(const f32x4 (&acc)[2][2][4][2], const Unit& u, int wr, int wc, int fr, int fq) const {
        const int col0 = (u.pn & 7) * BM + wc * 32 + 8 * fq;
        PG8_EPI_LOOP_BEGIN
            const size_t row = (size_t)(u.pm * BM + rloc); const float w = topw[row];
#pragma unroll
            for (int bj = 0; bj < 2; ++bj) *(u32x4*)(Y + row * 2048 + col0 + bj * HALF) = pack8(acc[ai][bj][m][0] * w, acc[ai][bj][m][1] * w);
        PG8_EPI_LOOP_END
    }
};

template <class Epi, class Sched, bool ALIGN_EPI>
__device__ __forceinline__ void gemm_phase(PG8_LAS unsigned char* lds, const Gemm g, const Sched& S, const Epi& E, const int tid) {
    const int wid = __builtin_amdgcn_readfirstlane(tid >> 6), lane = tid & 63, wr = wid >> 2, wc = wid & 3, fr = lane & 15, fq = lane >> 4;
    const int K = g.K, nt = K / BK;
    unsigned voffA[2], voffB[2];
#pragma unroll
    for (int i = 0; i < 2; ++i) { int R, C; stage_rc(tid * 16 + i * 8192, R, C); const int Rb = Epi::PERM ? ((R & ~31) + perm32(R & 31)) : R;
        voffA[i] = (unsigned)(R * g.lda + C) * 2u; voffB[i] = (unsigned)(Rb * g.ldb + C) * 2u; }
    const size_t kstep = (size_t)(BK * 2);
    const size_t hA = (size_t)HALF * g.lda * 2, hB = (size_t)HALF * g.ldb * 2;
    const size_t tA = 2 * hA, tB = 2 * hB;
    const unsigned ldsw = (unsigned)wid * 1024u;
    const int aoff = lds_byte(wr * 64 + fr, fq * 8), boff = lds_byte(wc * 32 + fr, fq * 8);
#define PG8_SA(b, h) (((b) * 2 + (h)) * HTB)
#define PG8_SB(b, h) ((4 + (b) * 2 + (h)) * HTB)
#define PG8_STAGE(bufoff, gbase, voff) do { _Pragma("unroll") for (int _i = 0; _i < 2; ++_i) \
        __builtin_amdgcn_global_load_lds((const unsigned*)((const char*)(gbase) + (voff)[_i]), (PG8_LAS unsigned*)(lds + (bufoff) + ldsw + _i * 8192), 16, 0, 0); } while (0)
#define PG8_LDA(dst, b, h) do { _Pragma("unroll") for (int m = 0; m < 4; ++m) _Pragma("unroll") for (int k = 0; k < 2; ++k) dst[m][k] = *(const PG8_LAS bf16x8*)(lds + PG8_SA(b, h) + aoff + m * 2048 + k * 1024); } while (0)
#define PG8_LDB(dst, b, h) do { _Pragma("unroll") for (int n = 0; n < 2; ++n) _Pragma("unroll") for (int k = 0; k < 2; ++k) dst[n][k] = *(const PG8_LAS bf16x8*)(lds + PG8_SB(b, h) + boff + n * 2048 + k * 1024); } while (0)
#define PG8_MMA(ai, bj, At, Bt) do { __builtin_amdgcn_s_setprio(1); _Pragma("unroll") for (int m = 0; m < 4; ++m) _Pragma("unroll") for (int n = 0; n < 2; ++n) _Pragma("unroll") for (int k = 0; k < 2; ++k) \
        acc[ai][bj][m][n] = __builtin_amdgcn_mfma_f32_16x16x32_bf16(Bt[n][k], At[m][k], acc[ai][bj][m][n], 0, 0, 0); __builtin_amdgcn_s_setprio(0); } while (0)
#define PG8_WAIT_V(n) asm volatile("s_waitcnt vmcnt(" #n ")" ::: "memory")
#define PG8_WAIT_L(n) asm volatile("s_waitcnt lgkmcnt(" #n ")" ::: "memory")
#define PG8_BAR __builtin_amdgcn_s_barrier()
#define PG8_SCHED __builtin_amdgcn_sched_barrier(0)
    Unit cur, nxt; int ui = 0;
    if (!S.next(0, cur)) return;
    f32x4 acc[2][2][4][2];
#pragma unroll
    for (int a = 0; a < 2; ++a)
#pragma unroll
        for (int b = 0; b < 2; ++b)
#pragma unroll
            for (int m = 0; m < 4; ++m)
#pragma unroll
                for (int n = 0; n < 2; ++n) acc[a][b][m][n] = (f32x4){0.f, 0.f, 0.f, 0.f};
    bf16x8 At[4][2], B0[2][2], B1[2][2];
    const char* cA = (const char*)g.A + (size_t)cur.pm * tA; const char* cB = (const char*)g.Bt + (size_t)cur.pn * tB;
    PG8_STAGE(PG8_SB(0, 0), cB, voffB); PG8_STAGE(PG8_SB(0, 1), cB + hB, voffB); PG8_STAGE(PG8_SA(0, 0), cA, voffA); PG8_STAGE(PG8_SA(0, 1), cA + hA, voffA);
    if (wr == 1) PG8_BAR;
    PG8_WAIT_V(2); PG8_BAR;
    PG8_STAGE(PG8_SB(1, 0), cB + kstep, voffB); PG8_STAGE(PG8_SA(1, 0), cA + kstep, voffA); PG8_STAGE(PG8_SB(1, 1), cB + hB + kstep, voffB);
    PG8_WAIT_V(6); PG8_BAR;
    for (;;) {
        const bool has_next = S.next(ui + 1, nxt);
        const char* nA = has_next ? (const char*)g.A + (size_t)nxt.pm * tA : cA; const char* nB = has_next ? (const char*)g.Bt + (size_t)nxt.pn * tB : cB;
        for (int t = 0; t < nt; t += 2) {
            const bool last = (t == nt - 2);
            const char* a1 = cA + (size_t)(t + 1) * kstep;
            const char* a2 = last ? nA : cA + (size_t)(t + 2) * kstep; const char* b2 = last ? nB : cB + (size_t)(t + 2) * kstep;
            const char* a3 = a2 + kstep; const char* b3 = b2 + kstep;
            PG8_LDB(B0, 0, 0); PG8_LDB(B1, 0, 1); PG8_SCHED; PG8_LDA(At, 0, 0); PG8_STAGE(PG8_SA(1, 1), a1 + hA, voffA);
            PG8_WAIT_V(8); PG8_WAIT_L(0); PG8_BAR; PG8_MMA(0, 0, At, B0); PG8_MMA(0, 1, At, B1); PG8_BAR; PG8_SCHED;
            PG8_LDA(At, 0, 1); PG8_STAGE(PG8_SB(0, 0), b2, voffB); PG8_STAGE(PG8_SB(0, 1), b2 + hB, voffB); PG8_STAGE(PG8_SA(0, 0), a2, voffA);
            PG8_WAIT_V(8); PG8_WAIT_L(0); PG8_BAR; PG8_MMA(1, 0, At, B0); PG8_MMA(1, 1, At, B1); PG8_BAR; PG8_SCHED;
            PG8_LDB(B0, 1, 0); PG8_LDB(B1, 1, 1); PG8_SCHED; PG8_LDA(At, 1, 0); PG8_STAGE(PG8_SA(0, 1), a2 + hA, voffA);
            PG8_WAIT_V(8); PG8_WAIT_L(0); PG8_BAR; PG8_MMA(0, 0, At, B0); PG8_MMA(0, 1, At, B1); PG8_BAR; PG8_SCHED;
            PG8_LDA(At, 1, 1); PG8_STAGE(PG8_SB(1, 0), b3, voffB); PG8_STAGE(PG8_SB(1, 1), b3 + hB, voffB); PG8_STAGE(PG8_SA(1, 0), a3, voffA);
            PG8_WAIT_V(8); PG8_WAIT_L(0); PG8_BAR; PG8_MMA(1, 0, At, B0); PG8_MMA(1, 1, At, B1); PG8_BAR; PG8_SCHED;
        }
        if constexpr (ALIGN_EPI) { if (wr == 0) PG8_BAR; }
        E(acc, cur, wr, wc, fr, fq);
        if (!has_next) break;
#pragma unroll
        for (int a = 0; a < 2; ++a)
#pragma unroll
            for (int b = 0; b < 2; ++b)
#pragma unroll
                for (int m = 0; m < 4; ++m)
#pragma unroll
                    for (int n = 0; n < 2; ++n) acc[a][b][m][n] = (f32x4){0.f, 0.f, 0.f, 0.f};
        cur = nxt; cA = nA; cB = nB; ++ui;
        if constexpr (ALIGN_EPI) { if (wr == 1) PG8_BAR; }
    }
    PG8_WAIT_V(0);
    if constexpr (!ALIGN_EPI) { if (wr == 0) PG8_BAR; }
    PG8_BAR;
#undef PG8_SA
#undef PG8_SB
#undef PG8_STAGE
#undef PG8_LDA
#undef PG8_LDB
#undef PG8_MMA
#undef PG8_WAIT_V
#undef PG8_WAIT_L
#undef PG8_BAR
#undef PG8_SCHED
}
}

namespace att {
typedef unsigned short bf16;
constexpr int D = 128, NW = 8, QBLK = 32, KVBLK = 64;
constexpr float SCALE = 0.088388347648318440f;
constexpr float THR = 8.f;
constexpr int LDQ = 1024, LDK = 256, LDO = 2048;
constexpr size_t SHM_V = KVBLK * D * 2, SHM_K = KVBLK * D * 2, SHM_ATTN = 2 * SHM_V + 2 * SHM_K + NW * 64 * 4;
using bf16x8 = __attribute__((ext_vector_type(8))) short;
using s16x4  = __attribute__((ext_vector_type(4))) short;
using f32x16 = __attribute__((ext_vector_type(16))) float;
using u32x4  = __attribute__((ext_vector_type(4))) unsigned;
#define KSWZ(row, colB) ((row) * 256 + ((colB) ^ (((row) & 7) << 4)))
#define SBAR() __builtin_amdgcn_sched_barrier(0)
__device__ __forceinline__ int crow(int r, int hi) { return (r & 3) + 8 * (r >> 2) + 4 * hi; }
__device__ __forceinline__ unsigned cvtpk(float lo, float hi) { unsigned r; asm volatile("v_cvt_pk_bf16_f32 %0, %1, %2" : "=v"(r) : "v"(lo), "v"(hi)); return r; }
__device__ __forceinline__ void partialSM(f32x16& p0, f32x16& p1, float& m_reg, float& mn, float& alpha) {
  constexpr float C = SCALE * 1.4426950408889634f;
  float pmax = p0[0]; for (int r = 1; r < 16; ++r) pmax = fmaxf(pmax, p0[r]); for (int r = 0; r < 16; ++r) pmax = fmaxf(pmax, p1[r]);
  { auto rr = __builtin_amdgcn_permlane32_swap(__float_as_uint(pmax), __float_as_uint(pmax), false, false);
    pmax = fmaxf(__uint_as_float(rr[0]), __uint_as_float(rr[1])); }
  if (__builtin_expect(__all(pmax - m_reg <= THR / SCALE), 1)) { mn = m_reg; alpha = 1.f; }
  else { mn = fmaxf(m_reg, pmax); alpha = __builtin_amdgcn_exp2f((m_reg - mn) * C); m_reg = mn; }
  float mnC = -mn * C;
  for (int r = 0; r < 16; ++r) p0[r] = fmaf(p0[r], C, mnC); for (int r = 0; r < 16; ++r) p1[r] = fmaf(p1[r], C, mnC);
  for (int r = 0; r < 16; ++r) p0[r] = __builtin_amdgcn_exp2f(p0[r]);
}
__device__ __forceinline__ void finishSM(f32x16& p0, f32x16& p1, float alpha, float& l_reg, bf16x8& pa0, bf16x8& pa1, bf16x8& pa2, bf16x8& pa3) {
  for (int r = 0; r < 16; ++r) p1[r] = __builtin_amdgcn_exp2f(p1[r]);
  float ps = 0; for (int r = 0; r < 16; ++r) ps += p0[r]; for (int r = 0; r < 16; ++r) ps += p1[r];
  { auto rr = __builtin_amdgcn_permlane32_swap(__float_as_uint(ps), __float_as_uint(ps), false, false);
    ps = __uint_as_float(rr[0]) + __uint_as_float(rr[1]); }
  l_reg = l_reg * alpha + ps;
#define PK4(P, BASE, OUT) do { unsigned a0 = cvtpk(P[BASE + 0], P[BASE + 1]), a1 = cvtpk(P[BASE + 2], P[BASE + 3]);   \
    unsigned b0 = cvtpk(P[BASE + 4], P[BASE + 5]), b1 = cvtpk(P[BASE + 6], P[BASE + 7]);                              \
    auto r0 = __builtin_amdgcn_permlane32_swap(a0, b0, false, false); auto r1 = __builtin_amdgcn_permlane32_swap(a1, b1, false, false); \
    u32x4 w = {r0[0], r1[0], r0[1], r1[1]}; OUT = *reinterpret_cast<bf16x8*>(&w); } while (0)
  PK4(p0, 0, pa0); PK4(p0, 8, pa1); PK4(p1, 0, pa2); PK4(p1, 8, pa3);
#undef PK4
}
__device__ __forceinline__ void qkt(f32x16& p0, f32x16& p1, const bf16* Ks, const bf16x8* qr, int r32, int hi) {
  p0 = f32x16{}; p1 = f32x16{};
  for (int d0 = 0; d0 < 8; ++d0) { int cb = (d0 * 16 + hi * 8) * 2;
    bf16x8 b0 = *reinterpret_cast<const bf16x8*>((const char*)Ks + KSWZ(r32, cb));
    bf16x8 b1 = *reinterpret_cast<const bf16x8*>((const char*)Ks + KSWZ(32 + r32, cb));
    p0 = __builtin_amdgcn_mfma_f32_32x32x16_bf16(b0, qr[d0], p0, 0, 0, 0);
    p1 = __builtin_amdgcn_mfma_f32_32x32x16_bf16(b1, qr[d0], p1, 0, 0, 0); }
}
__device__ __forceinline__ int v_st(int k, int c) { const int kk = (k & ~0xC) | ((k & 4) << 1) | ((k & 8) >> 1); return ((kk >> 3) * 4 + (c >> 5)) * 512 + ((kk & 7) * 32 + (c & 31)) * 2; }
__device__ __forceinline__ int v_rd_base(int lane) { return ((lane & 3) << 3) | (((lane >> 2) & 3) << 6) | (((lane >> 4) & 1) << 5) | (((lane >> 5) & 1) << 8); }
constexpr int v_rd_off(int d0, int ks, int half) { return d0 * 512 + ks * 4096 + half * 2048; }
template <int OFF> __device__ __forceinline__ s16x4 tr_read(int vb) {
  s16x4 r; asm volatile("ds_read_b64_tr_b16 %0, %1 offset:%2" : "=&v"(r) : "v"(vb), "i"(OFF) : "memory"); return r;
}
template <int D0> __device__ __forceinline__ void pv_one(f32x16& od, int vb, bf16x8 pa0, bf16x8 pa1, bf16x8 pa2, bf16x8 pa3) {
  const s16x4 l0 = tr_read<v_rd_off(D0, 0, 0)>(vb), h0 = tr_read<v_rd_off(D0, 0, 1)>(vb), l1 = tr_read<v_rd_off(D0, 1, 0)>(vb), h1 = tr_read<v_rd_off(D0, 1, 1)>(vb);
  const s16x4 l2 = tr_read<v_rd_off(D0, 2, 0)>(vb), h2 = tr_read<v_rd_off(D0, 2, 1)>(vb), l3 = tr_read<v_rd_off(D0, 3, 0)>(vb), h3 = tr_read<v_rd_off(D0, 3, 1)>(vb);
  asm volatile("s_waitcnt lgkmcnt(0)" ::: "memory"); SBAR();
#define PK(L, H) (bf16x8){L[0], L[1], L[2], L[3], H[0], H[1], H[2], H[3]}
  od = __builtin_amdgcn_mfma_f32_32x32x16_bf16(pa0, PK(l0, h0), od, 0, 0, 0);
  od = __builtin_amdgcn_mfma_f32_32x32x16_bf16(pa1, PK(l1, h1), od, 0, 0, 0);
  od = __builtin_amdgcn_mfma_f32_32x32x16_bf16(pa2, PK(l2, h2), od, 0, 0, 0);
  od = __builtin_amdgcn_mfma_f32_32x32x16_bf16(pa3, PK(l3, h3), od, 0, 0, 0);
#undef PK
}
__device__ __forceinline__ void pv_d0(f32x16* o, int vb, bf16x8 pa0, bf16x8 pa1, bf16x8 pa2, bf16x8 pa3) {
  pv_one<0>(o[0], vb, pa0, pa1, pa2, pa3); pv_one<1>(o[1], vb, pa0, pa1, pa2, pa3); pv_one<2>(o[2], vb, pa0, pa1, pa2, pa3); pv_one<3>(o[3], vb, pa0, pa1, pa2, pa3);
}
__device__ __forceinline__ void attn_dense_body(const bf16* __restrict__ Qb, const bf16* __restrict__ Kh, const bf16* __restrict__ Vh, bf16* __restrict__ Ob, int seq, char* lds, const int tid) {
  const int wid = tid >> 6, lane = tid & 63, r32 = lane & 31, hi = lane >> 5;
  bf16* V_lds = (bf16*)lds; bf16* K_lds = (bf16*)(lds + 2 * SHM_V);
  float* ws = (float*)(lds + 2 * SHM_V + 2 * SHM_K) + wid * 64; float* li_l = ws; float* al_l = ws + 32;
  float m_reg = -1e30f, l_reg = 0; f32x16 o[4] = {}; bf16x8 qr[8];
  const bf16* Qw = Qb + (long)(wid * QBLK + r32) * LDQ + hi * 8;
#pragma unroll
  for (int d0 = 0; d0 < 8; ++d0) qr[d0] = *reinterpret_cast<const bf16x8*>(Qw + d0 * 16);
  const int sr = tid >> 4, sc = (tid & 15) * 8, vst0 = v_st(sr, sc), vst1 = v_st(32 + sr, sc);
  const int vb0 = (int)(uintptr_t)V_lds + v_rd_base(lane);
  struct { bf16x8 vs0, vs1, ks0, ks1; } sr_[2];
#define LD8(p) (*reinterpret_cast<const bf16x8*>(p))
#define SLOAD(i, k0) do { sr_[i].vs0 = LD8(&Vh[(long)((k0) + sr) * LDK + sc]); sr_[i].vs1 = LD8(&Vh[(long)((k0) + 32 + sr) * LDK + sc]); \
    sr_[i].ks0 = LD8(&Kh[(long)((k0) + sr) * LDK + sc]); sr_[i].ks1 = LD8(&Kh[(long)((k0) + 32 + sr) * LDK + sc]); } while (0)
#define SWRITE(b, i) do { *(bf16x8*)((char*)V_lds + (b) * SHM_V + vst0) = sr_[i].vs0;          \
    *(bf16x8*)((char*)V_lds + (b) * SHM_V + vst1) = sr_[i].vs1; int kc = sc * 2;               \
    *(bf16x8*)((char*)K_lds + (b) * SHM_K + KSWZ(sr, kc)) = sr_[i].ks0;                       \
    *(bf16x8*)((char*)K_lds + (b) * SHM_K + KSWZ(32 + sr, kc)) = sr_[i].ks1; } while (0)
#define SWAIT() asm volatile("s_waitcnt vmcnt(4)" ::: "memory")
#define RESC(a) do { if (__any((a) < 1.f)) { if (hi == 0) al_l[r32] = (a); asm volatile("s_waitcnt lgkmcnt(0)" ::: "memory"); \
    for (int d = 0; d < 4; ++d) for (int r = 0; r < 16; ++r) o[d][r] *= al_l[crow(r, hi)]; } } while (0)
  f32x16 pA0, pA1, pB0, pB1; float mnA, mnB, alA, alB; bf16x8 pa0, pa1, pa2, pa3; const int NT = seq / KVBLK;
  constexpr int SE = 0, SO = 1;
  SLOAD(SE, 0); asm volatile("s_waitcnt vmcnt(0)" ::: "memory"); SWRITE(0, SE); __syncthreads();
  qkt(pA0, pA1, K_lds, qr, r32, hi); partialSM(pA0, pA1, m_reg, mnA, alA);
  SLOAD(SO, KVBLK); if (2 < NT) SLOAD(SE, 2 * KVBLK);
  SWAIT(); SWRITE(1, SO); __syncthreads();
  for (int j = 1; j + 1 < NT; j += 2) {
    SBAR(); qkt(pB0, pB1, (bf16*)((char*)K_lds + SHM_K), qr, r32, hi);
    finishSM(pA0, pA1, alA, l_reg, pa0, pa1, pa2, pa3); SBAR();
    SLOAD(SO, (j + 2) * KVBLK); SBAR();
    pv_d0(o, vb0, pa0, pa1, pa2, pa3); partialSM(pB0, pB1, m_reg, mnB, alB);
    __syncthreads(); SWAIT(); SWRITE(0, SE);
    RESC(alB); __syncthreads();
    SBAR(); qkt(pA0, pA1, K_lds, qr, r32, hi);
    finishSM(pB0, pB1, alB, l_reg, pa0, pa1, pa2, pa3); SBAR();
    if (j + 3 < NT) SLOAD(SE, (j + 3) * KVBLK); SBAR();
    pv_d0(o, vb0 + (int)SHM_V, pa0, pa1, pa2, pa3); partialSM(pA0, pA1, m_reg, mnA, alA);
    __syncthreads(); SWAIT(); SWRITE(1, SO);
    RESC(alA); __syncthreads();
  }
  SBAR(); qkt(pB0, pB1, (bf16*)((char*)K_lds + SHM_K), qr, r32, hi);
  finishSM(pA0, pA1, alA, l_reg, pa0, pa1, pa2, pa3); SBAR();
  pv_d0(o, vb0, pa0, pa1, pa2, pa3); partialSM(pB0, pB1, m_reg, mnB, alB);
  __syncthreads(); RESC(alB);
  finishSM(pB0, pB1, alB, l_reg, pa0, pa1, pa2, pa3); SBAR();
  pv_d0(o, vb0 + (int)SHM_V, pa0, pa1, pa2, pa3);
  if (hi == 0) li_l[r32] = l_reg; asm volatile("s_waitcnt lgkmcnt(0)" ::: "memory");
  float rli[16];
#pragma unroll
  for (int r = 0; r < 16; ++r) rli[r] = __builtin_amdgcn_rcpf(li_l[crow(r, hi)]);
  bf16* Ow = Ob + (long)(wid * QBLK) * LDO;
#pragma unroll
  for (int r = 0; r < 16; ++r) { int orow = crow(r, hi);
#pragma unroll
    for (int d0 = 0; d0 < 4; d0 += 1) { const unsigned w = cvtpk(o[d0][r] * rli[r], 0.f); Ow[(long)orow * LDO + d0 * 32 + r32] = (bf16)(w & 0xffffu); } }
  __syncthreads();
#undef LD8
#undef SLOAD
#undef SWRITE
#undef SWAIT
#undef RESC
}
}

constexpr int NWAVES = 8;
constexpr int N_LAUNCHES = MK_N_LAUNCHES;
constexpr int N_PHASES = 15;
constexpr int DM = 2048, NB = 4, T = 4096, LC = 256, M = NB * T, MC = NB * LC, SKV = LC + T;
constexpr int NE = 16, FFD = 2048, CAP = 512;
constexpr float EPS = 1e-6f;

constexpr size_t MiB = 1u << 20;
constexpr size_t WS_CTL = 0, CTL_ZERO_BYTES = 1 * MiB;
constexpr size_t WS_ROPE = 1 * MiB;
constexpr size_t WS_MOD = WS_ROPE + 64 * 1024;
constexpr size_t WS_AFF = 2 * MiB;
constexpr size_t WS_ROWIDX = 3 * MiB;
constexpr size_t WS_TOPW = WS_ROWIDX + 256 * 1024;
constexpr size_t WS_INV = 4 * MiB;
constexpr size_t WS_MODP = 5 * MiB;
constexpr size_t WS_WIN = 8 * MiB;
constexpr size_t WS_WOA = 42 * MiB, WS_WOR = 46 * MiB, WS_WOUT = 50 * MiB;
constexpr size_t WS_WGU = 58 * MiB;
constexpr size_t WS_WDN = 314 * MiB;
constexpr size_t WS_H = 442 * MiB;
constexpr size_t WS_QA = 510 * MiB, WS_QR = 542 * MiB, WS_GR = 558 * MiB, WS_GATE = 590 * MiB;
constexpr size_t WS_KA = 718 * MiB, WS_VA = WS_KA + (size_t)NB * SKV * 256 * 2, WS_KR = 735 * MiB, WS_VR = 752 * MiB;
constexpr size_t WS_ACT = 510 * MiB, WS_YEXP = 638 * MiB;
constexpr size_t WS_U = 786 * MiB;
constexpr size_t WS_ST = 854 * MiB;
constexpr size_t WS_YO = 786 * MiB;
constexpr size_t WS_Y = 854 * MiB;
constexpr size_t WS_XG = 786 * MiB;
constexpr size_t WS_O = 918 * MiB;
constexpr size_t WS_END = 982 * MiB;
static_assert(WS_VA + (size_t)NB * SKV * 256 * 2 <= WS_KR && WS_KR + (size_t)NB * SKV * 512 * 2 <= WS_VR && WS_VR + (size_t)NB * SKV * 1024 * 2 <= WS_U, "z map");
static_assert(WS_XG + (size_t)32768 * 2048 * 2 <= WS_O, "xg map");
constexpr int CW_TMO = 0, CW_CODE = 1, CW_BAR = 4096;

constexpr int RING_OFF = 0, RING_BYTES = 131072;
constexpr int SCRATCH_BYTES = 155648;
constexpr int LDSCTL_OFF = SCRATCH_BYTES, MISC_OFF = LDSCTL_OFF + 320;
constexpr int LDS_BYTES = 156672;
static_assert(MISC_OFF + 128 <= LDS_BYTES, "LDS map");

#define GAS __attribute__((address_space(1)))
#define LAS __attribute__((address_space(3)))
typedef unsigned short bf16;
typedef unsigned v4u __attribute__((ext_vector_type(4)));
typedef unsigned v2u __attribute__((ext_vector_type(2)));
typedef float f32x4 __attribute__((ext_vector_type(4)));
typedef GAS unsigned gu32;
#define RLX_AGENT __ATOMIC_RELAXED, __HIP_MEMORY_SCOPE_AGENT
#define LDS_WAIT() asm volatile("s_waitcnt lgkmcnt(0)" ::: "memory")
#define VM_WAIT() asm volatile("s_waitcnt vmcnt(0)" ::: "memory")
__device__ __forceinline__ unsigned pk2(float lo, float hi) { return pg8::cvt_pk_bf16(lo, hi); }
__device__ __forceinline__ float bflo(unsigned w) { return __uint_as_float(w << 16); }
__device__ __forceinline__ float bfhi(unsigned w) { return __uint_as_float(w & 0xffff0000u); }
__device__ __forceinline__ float bf1(bf16 b) { return __uint_as_float(((unsigned)b) << 16); }
__device__ __forceinline__ float siluf_(float x) { return x / (1.0f + __expf(-x)); }

#define XB_TMO      128
#define XB_XCNT(j)  (256  + 64 * (j))
#define XB_XSUB(j)  (1280 + 64 * (j))
#define XB_XGEN(j)  (2304 + 64 * (j))
#define XB_TOP      3328
#define XB_TOPGEN   3392
#define XCD_BAR_WORDS 3456
#define XB_SPIN_CAP (1u << 18)
__device__ __forceinline__ unsigned xb_ld(unsigned* p)              { return __hip_atomic_load(p, __ATOMIC_RELAXED, __HIP_MEMORY_SCOPE_AGENT); }
__device__ __forceinline__ unsigned xb_add(unsigned* p, unsigned v) { return __hip_atomic_fetch_add(p, v, __ATOMIC_RELAXED, __HIP_MEMORY_SCOPE_AGENT); }
__device__ __forceinline__ unsigned xb_xcc_id() { return (unsigned)__builtin_amdgcn_s_getreg((3 << 11) | 20) & 0xFu; }
#define XB_SPIN(cond, bar) do { unsigned _sp = 0; while (cond) { __builtin_amdgcn_s_sleep(1); \
    if ((++_sp & 255u) == 0u) { if (xb_ld(&(bar)[XB_TMO])) break; if (_sp > XB_SPIN_CAP) { atomicAdd(&(bar)[XB_TMO], 1u); break; } } } } while (0)
struct XcdBarrier { unsigned* bar; unsigned x; volatile LAS unsigned* st; };
__device__ __forceinline__ XcdBarrier xcd_barrier_post(unsigned* bar, volatile LAS unsigned* st) {
    XcdBarrier b; b.bar = bar; b.x = xb_xcc_id(); b.st = st;
    if (threadIdx.x == 0) (void)xb_add(&bar[XB_XCNT(b.x)], 1u);
    return b;
}
__device__ __forceinline__ void xcd_barrier_complete(unsigned* bar, unsigned x, unsigned& nloc, unsigned& nx) {
    const unsigned G = gridDim.x * gridDim.y * gridDim.z;
    unsigned sum, cnt, mine, sp = 0u;
    for (;;) {
        sum = 0u; cnt = 0u; mine = 0u;
#pragma unroll
        for (unsigned j = 0; j < 16; ++j) { const unsigned c = xb_ld(&bar[XB_XCNT(j)]); sum += c; cnt += (c > 0u) ? 1u : 0u; mine = (j == x) ? c : mine; }
        if (sum == G) break;
        __builtin_amdgcn_s_sleep(1);
        if ((++sp & 255u) == 0u) { if (xb_ld(&bar[XB_TMO])) break; if (sp > XB_SPIN_CAP) { atomicAdd(&bar[XB_TMO], 1u); break; } }
    }
    nloc = mine > 0u ? mine : 1u; nx = cnt > 0u ? cnt : 1u;
}
__device__ __forceinline__ void xcd_barrier(const XcdBarrier& b) {
    asm volatile("s_waitcnt vmcnt(0)" ::: "memory");
    __syncthreads();
    if (threadIdx.x == 0) {
        unsigned* bar = b.bar;
        __builtin_amdgcn_s_waitcnt(0);
        unsigned nloc = b.st[0], nx = b.st[1];
        if (nloc == 0u) { xcd_barrier_complete(bar, b.x, nloc, nx); b.st[0] = nloc; b.st[1] = nx; }
        const unsigned old = xb_add(&bar[XB_XSUB(b.x)], 1u);
        const unsigned gen = old / nloc;
        if (old + 1u == (gen + 1u) * nloc) {
            __builtin_amdgcn_fence(__ATOMIC_RELEASE, "agent");
            asm volatile("s_waitcnt vmcnt(0)" ::: "memory");
            const unsigned og = xb_add(&bar[XB_TOP], 1u);
            const unsigned tg = og / nx;
            if (og + 1u == (tg + 1u) * nx) xb_add(&bar[XB_TOPGEN], 1u);
            else XB_SPIN(xb_ld(&bar[XB_TOPGEN]) == tg, bar);
            __builtin_amdgcn_fence(__ATOMIC_ACQUIRE, "agent");
            xb_add(&bar[XB_XGEN(b.x)], 1u);
            asm volatile("s_waitcnt vmcnt(0)" ::: "memory");
        } else {
            XB_SPIN(xb_ld(&bar[XB_XGEN(b.x)]) == gen, bar);
            __builtin_amdgcn_fence(__ATOMIC_ACQUIRE, "agent");
            asm volatile("s_waitcnt vmcnt(0)" ::: "memory");
        }
    }
    __syncthreads();
}

struct Frame {
    LAS unsigned char* lds;
    volatile LAS unsigned* MISC;
    gu32* ctl;
    int tid, lane, wave;
    int vcu, G;
    float* out; unsigned char* ws;
};
enum { I_X = 0, I_C, I_CTX, I_CCTX, I_WMOD, I_BMOD, I_PRE1, I_POST1, I_PRE2, I_POST2, I_WIN, I_QN, I_KN, I_DECAY, I_GN, I_WOA, I_WOR, I_WOUT, I_WR, I_WG, I_WU, I_WD };
__device__ __forceinline__ const float* inp(const Frame& F, int k) {
    const unsigned long long v = ((const LAS unsigned long long*)(F.lds + LDSCTL_OFF))[k];
    const unsigned lo = __builtin_amdgcn_readfirstlane((unsigned)v), hi = __builtin_amdgcn_readfirstlane((unsigned)(v >> 32));
    return (const float*)(const GAS float*)(((unsigned long long)hi << 32) | lo);
}

__device__ __forceinline__ float wave_sum(float v) {
#pragma unroll
    for (int o = 1; o < 64; o <<= 1) v += __shfl_xor(v, o);
    return v;
}

__device__ __forceinline__ void p0_transpose_item(const float* W, int ldw, int k0, int n0, bf16* WT, int ldt, int drow0, LAS float* scr, int lane) {
#pragma unroll 8
    for (int i = 0; i < 32; ++i) { const int kk = 2 * i + (lane >> 5); scr[kk * 33 + (lane & 31)] = W[(size_t)(k0 + kk) * ldw + n0 + (lane & 31)]; }
    LDS_WAIT(); asm volatile("" ::: "memory");
    const int c = lane & 7;
#pragma unroll
    for (int j = 0; j < 4; ++j) { const int n = (lane >> 3) + 8 * j; const LAS float* s = scr + (8 * c) * 33 + n;
        v4u o; o.x = pk2(s[0 * 33], s[1 * 33]); o.y = pk2(s[2 * 33], s[3 * 33]); o.z = pk2(s[4 * 33], s[5 * 33]); o.w = pk2(s[6 * 33], s[7 * 33]);
        *(GAS v4u*)(WT + (size_t)(drow0 + n) * ldt + k0 + 8 * c) = o; }
    LDS_WAIT(); asm volatile("" ::: "memory");
}
__device__ __forceinline__ void p0_prologue(Frame& F) {
    unsigned char* ws = F.ws;
    {
        LAS float* sl = (LAS float*)(F.lds);
        LAS float* red = (LAS float*)(F.lds + 40960);
        for (int i = F.tid; i < 5 * 2048; i += 512) { const int b = i >> 11, k = i & 2047; const float v = b < 4 ? inp(F, I_C)[b * 2048 + k] : inp(F, I_CCTX)[k]; sl[i] = siluf_(v); }
        __syncthreads();
        const int kg = F.tid >> 7, c4 = F.tid & 127;
        for (int u = F.vcu; u < 192; u += F.G) {
            const int kc = u / 24, nc = u % 24;
            f32x4 a0 = {0, 0, 0, 0}, a1 = a0, a2 = a0, a3 = a0, a4 = a0;
            const float* wp = inp(F, I_WMOD) + (size_t)(256 * kc + kg) * 12288 + 512 * nc + 4 * c4;
#pragma unroll 8
            for (int kk = 0; kk < 64; ++kk) {
                const f32x4 w = *(const f32x4*)(wp + (size_t)(4 * kk) * 12288); const int k = 256 * kc + 4 * kk + kg;
                a0 += w * sl[k]; a1 += w * sl[2048 + k]; a2 += w * sl[4096 + k]; a3 += w * sl[6144 + k]; a4 += w * sl[8192 + k];
            }
            *(LAS f32x4*)(red + (kg * 5 + 0) * 512 + 4 * c4) = a0; *(LAS f32x4*)(red + (kg * 5 + 1) * 512 + 4 * c4) = a1; *(LAS f32x4*)(red + (kg * 5 + 2) * 512 + 4 * c4) = a2;
            *(LAS f32x4*)(red + (kg * 5 + 3) * 512 + 4 * c4) = a3; *(LAS f32x4*)(red + (kg * 5 + 4) * 512 + 4 * c4) = a4;
            __syncthreads();
            float* mp = (float*)(ws + WS_MODP) + (size_t)kc * 5 * 12288 + 512 * nc;
            for (int i = F.tid; i < 5 * 512; i += 512) { const int b = i >> 9, n = i & 511; mp[b * 12288 + n] = red[(0 * 5 + b) * 512 + n] + red[(1 * 5 + b) * 512 + n] + red[(2 * 5 + b) * 512 + n] + red[(3 * 5 + b) * 512 + n]; }
            __syncthreads();
        }
    }
    if (F.vcu == F.G - 1) {
        float* tab = (float*)(ws + WS_ROPE);
        for (int i = F.tid; i < 64 * 32; i += 512) { const int p = i >> 5, j = i & 31; const float inv = powf(10000.0f, -(float)j / 32.0f); const float ang = (float)p * inv; tab[2 * i] = cosf(ang); tab[2 * i + 1] = sinf(ang); }
    }
    LAS float* scr = (LAS float*)(F.lds + 81920 + F.wave * 8704);
    const int gw = F.vcu * NWAVES + F.wave, NGW = F.G * NWAVES;
    constexpr int I_IN = 32 * 272, I_OA = 16 * 64, I_OUT = 32 * 64, I_EX = 16 * 2048;
    constexpr int NITEMS = I_IN + 2 * I_OA + I_OUT + 3 * I_EX;
    for (int it = gw; it < NITEMS; it += NGW) {
        int r = it;
        if (r < I_IN) { const int kb = r / 272, nb = r % 272; p0_transpose_item(inp(F, I_WIN), 8704, 64 * kb, 32 * nb, (bf16*)(ws + WS_WIN), 2048, 32 * nb, scr, F.lane); continue; } r -= I_IN;
        if (r < I_OA) { const int kb = r / 64, nb = r % 64; p0_transpose_item(inp(F, I_WOA), 2048, 64 * kb, 32 * nb, (bf16*)(ws + WS_WOA), 1024, 32 * nb, scr, F.lane); continue; } r -= I_OA;
        if (r < I_OA) { const int kb = r / 64, nb = r % 64; p0_transpose_item(inp(F, I_WOR), 2048, 64 * kb, 32 * nb, (bf16*)(ws + WS_WOR), 1024, 32 * nb, scr, F.lane); continue; } r -= I_OA;
        if (r < I_OUT) { const int kb = r / 64, nb = r % 64; p0_transpose_item(inp(F, I_WOUT), 2048, 64 * kb, 32 * nb, (bf16*)(ws + WS_WOUT), 2048, 32 * nb, scr, F.lane); continue; } r -= I_OUT;
        if (r < 2 * I_EX) { const int up = r >= I_EX; if (up) r -= I_EX; const int e = r >> 11, q = r & 2047, kb = q / 64, nb = q % 64, n0 = 32 * nb;
            p0_transpose_item(inp(F, up ? I_WU : I_WG) + (size_t)e * 2048 * 2048, 2048, 64 * kb, n0, (bf16*)(ws + WS_WGU), 2048, e * 4096 + (n0 >> 7) * 256 + up * 128 + (n0 & 127), scr, F.lane); continue; } r -= 2 * I_EX;
        { const int e = r >> 11, q = r & 2047, kb = q / 64, nb = q % 64; p0_transpose_item(inp(F, I_WD) + (size_t)e * 2048 * 2048, 2048, 64 * kb, 32 * nb, (bf16*)(ws + WS_WDN), 2048, e * 2048 + 32 * nb, scr, F.lane); }
    }
}

__device__ __forceinline__ float mod_val(const Frame& F, int b, int n) {
    const float* mp = (const float*)(F.ws + WS_MODP) + (size_t)b * 12288 + n; float s = inp(F, I_BMOD)[n];
#pragma unroll
    for (int kc = 0; kc < 8; ++kc) s += mp[(size_t)kc * 5 * 12288];
    return s;
}
__device__ __forceinline__ void rms_mod_row(const float* xrow, bf16* orow, const LAS float* A, const LAS float* Bv, int lane) {
    const f32x4* xr = (const f32x4*)xrow + lane; f32x4 v[8]; float s = 0.f;
#pragma unroll
    for (int j = 0; j < 8; ++j) { v[j] = xr[64 * j]; s += (v[j].x * v[j].x + v[j].y * v[j].y) + (v[j].z * v[j].z + v[j].w * v[j].w); }
    const float r = 1.0f / sqrtf(wave_sum(s) * (1.0f / DM) + EPS);
    v2u* o8 = (v2u*)orow + lane;
#pragma unroll
    for (int j = 0; j < 8; ++j) { const f32x4 a = *(const LAS f32x4*)(A + 4 * (64 * j + lane)), b = *(const LAS f32x4*)(Bv + 4 * (64 * j + lane)); const f32x4 h = v[j] * r * a + b;
        v2u w; w.x = pk2(h.x, h.y); w.y = pk2(h.z, h.w); o8[64 * j] = w; }
}
__device__ __forceinline__ void p1_h(Frame& F) {
    LAS float* A = (LAS float*)F.lds; LAS float* Bv = A + 2048; LAS float* Ac = A + 4096; LAS float* Bc = A + 6144;
    const int b = F.vcu & 3, sub = F.vcu >> 2, nsub = F.G >> 2;
    for (int k = F.tid; k < 2048; k += 512) { const float g = inp(F, I_PRE1)[k];
        A[k] = g * (1.0f + mod_val(F, b, 2048 + k)); Bv[k] = mod_val(F, b, k); Ac[k] = g * (1.0f + mod_val(F, 4, 2048 + k)); Bc[k] = mod_val(F, 4, k); }
    float* MOD = (float*)(F.ws + WS_MOD);
    for (int i = F.vcu * 512 + F.tid; i < 5 * 12288; i += F.G * 512) MOD[i] = mod_val(F, i / 12288, i % 12288);
    __syncthreads();
    bf16* H = (bf16*)(F.ws + WS_H);
    for (int t = sub * NWAVES + F.wave; t < T; t += nsub * NWAVES) { const size_t m = (size_t)b * T + t; rms_mod_row(inp(F, I_X) + m * DM, H + m * DM, A, Bv, F.lane); }
    for (int r = F.vcu * NWAVES + F.wave; r < MC; r += F.G * NWAVES) rms_mod_row(inp(F, I_CTX) + (size_t)r * DM, H + (size_t)(M + r) * DM, Ac, Bc, F.lane);
}

__device__ __forceinline__ void head_op(bf16* hp, int c, bool active, bool do_norm, const float* g, bool do_scale, bool do_rope, int prow, int pcol, const float* tab) {
    v4u raw = {0u, 0u, 0u, 0u}; if (active) raw = *(const v4u*)(hp + 8 * c);
    float v[8] = {bflo(raw.x), bfhi(raw.x), bflo(raw.y), bfhi(raw.y), bflo(raw.z), bfhi(raw.z), bflo(raw.w), bfhi(raw.w)};
    float ss = 0.f;
#pragma unroll
    for (int i = 0; i < 8; ++i) ss += v[i] * v[i];
    ss += __shfl_xor(ss, 1); ss += __shfl_xor(ss, 2); ss += __shfl_xor(ss, 4); ss += __shfl_xor(ss, 8);
    const float r = 1.0f / sqrtf(ss * (1.0f / 128.0f) + EPS);
#pragma unroll
    for (int i = 0; i < 8; ++i) { float x = v[i]; if (do_norm) x = x * r * g[8 * c + i]; if (do_scale) x *= 0.08838834764831845f; v[i] = x; }
    const int a = c >> 3, p = (c >> 2) & 1, jb = (c & 3) * 8, pos = a ? pcol : prow;
#pragma unroll
    for (int i = 0; i < 8; ++i) { const float pv = __shfl_xor(v[i], 4);
        if (do_rope) { const float cs = tab[(pos * 32 + jb + i) * 2], sn = tab[(pos * 32 + jb + i) * 2 + 1]; v[i] = p ? (v[i] * cs + pv * sn) : (v[i] * cs - pv * sn); } }
    if (active) { v4u o; o.x = pk2(v[0], v[1]); o.y = pk2(v[2], v[3]); o.z = pk2(v[4], v[5]); o.w = pk2(v[6], v[7]); *(v4u*)(hp + 8 * c) = o; }
}
__device__ __forceinline__ void p3_rope(Frame& F) {
    unsigned char* ws = F.ws; const float* tab = (const float*)(ws + WS_ROPE);
    const int gw = F.vcu * NWAVES + F.wave, NGW = F.G * NWAVES, grp = F.lane >> 4, c = F.lane & 15;
    for (int m = gw; m < M; m += NGW) {
        const int b = m >> 12, t = m & 4095, prow = t >> 6, pcol = t & 63; const size_t kvrow = (size_t)b * SKV + LC + t;
#pragma unroll
        for (int s = 0; s < 5; ++s) {
            const int slot = 4 * s + grp; const bool active = slot < 18;
            bf16* hp; bool do_norm = false, do_scale = false; const float* g = inp(F, I_QN);
            if (slot < 8) { hp = (bf16*)(ws + WS_QA) + (size_t)m * 1024 + slot * 128; do_norm = true; }
            else if (slot < 12) { hp = (bf16*)(ws + WS_QR) + (size_t)m * 512 + (slot - 8) * 128; }
            else if (slot < 14) { hp = (bf16*)(ws + WS_KA) + kvrow * 256 + (slot - 12) * 128; do_norm = true; g = inp(F, I_KN); }
            else { hp = (bf16*)(ws + WS_KR) + kvrow * 512 + ((slot - 14) & 3) * 128; do_scale = true; }
            head_op(hp, c, active, do_norm, g, do_scale, true, prow, pcol, tab);
        }
    }
    for (int r = gw; r < MC; r += NGW) {
        const int b = r >> 8, l = r & 255; const size_t kvrow = (size_t)b * SKV + l;
#pragma unroll
        for (int s = 0; s < 2; ++s) {
            const int slot = 4 * s + grp; const bool active = slot < 6;
            bf16* hp; bool do_norm = false, do_scale = false;
            if (slot < 2) { hp = (bf16*)(ws + WS_KA) + kvrow * 256 + slot * 128; do_norm = true; }
            else { hp = (bf16*)(ws + WS_KR) + kvrow * 512 + ((slot - 2) & 3) * 128; do_scale = true; }
            head_op(hp, c, active, do_norm, inp(F, I_KN), do_scale, false, 0, 0, tab);
        }
    }
}

__device__ __forceinline__ float softplusf_(float x) { return x > 20.f ? x : log1pf(expf(x)); }
__device__ __forceinline__ float log_gamma(const Frame& F, int dir, int h) { return -softplusf_(inp(F, I_DECAY)[dir * 4 + h]); }

__device__ __forceinline__ void p4_chunk_states(Frame& F) {
    unsigned char* ws = F.ws;
    LAS bf16* Ks = (LAS bf16*)F.lds;
    LAS bf16* Vs = (LAS bf16*)(F.lds + 32768);
    for (int u = F.vcu; u < NB * 4 * 34; u += F.G) {
        int tid = F.tid; asm volatile("" : "+v"(tid));
        const int td = tid & 15, tv = tid >> 4;
        const int cidx = u % 34, h = (u / 34) & 3, b = u / (34 * 4);
        const float lgf = log_gamma(F, 0, h), lgb = log_gamma(F, 1, h);
        const size_t row0 = (size_t)b * SKV + 128 * cidx;
        const bf16* Kg = (const bf16*)(ws + WS_KR) + row0 * 512 + h * 128; const bf16* Vg = (const bf16*)(ws + WS_VR) + row0 * 1024 + h * 256;
        for (int i = tid; i < 128 * 16; i += 512) { const int j = i >> 4, cc = i & 15; *(LAS v4u*)(Ks + j * 128 + 8 * cc) = *(const v4u*)(Kg + (size_t)j * 512 + 8 * cc); }
        for (int i = tid; i < 128 * 32; i += 512) { const int j = i >> 5, cc = i & 31; *(LAS v4u*)(Vs + j * 256 + 8 * cc) = *(const v4u*)(Vg + (size_t)j * 1024 + 8 * cc); }
        __syncthreads();
        float af[8][8], ab[8][8];
#pragma unroll
        for (int x = 0; x < 8; ++x)
#pragma unroll
            for (int y = 0; y < 8; ++y) { af[x][y] = 0.f; ab[x][y] = 0.f; }
        for (int j = 0; j < 128; ++j) {
            const v4u kr = *(const LAS v4u*)(Ks + j * 128 + 8 * td), vr = *(const LAS v4u*)(Vs + j * 256 + 8 * tv);
            const float wf = __expf(lgf * (float)(127 - j)), wb = __expf(lgb * (float)j);
            const float kk[8] = {bflo(kr.x), bfhi(kr.x), bflo(kr.y), bfhi(kr.y), bflo(kr.z), bfhi(kr.z), bflo(kr.w), bfhi(kr.w)};
            const float vv[8] = {bflo(vr.x), bfhi(vr.x), bflo(vr.y), bfhi(vr.y), bflo(vr.z), bfhi(vr.z), bflo(vr.w), bfhi(vr.w)};
#pragma unroll
            for (int x = 0; x < 8; ++x) { const float vf = vv[x] * wf, vbk = vv[x] * wb;
#pragma unroll
                for (int y = 0; y < 8; ++y) { af[x][y] += vf * kk[y]; ab[x][y] += vbk * kk[y]; } }
        }
        bf16* Uf = (bf16*)(ws + WS_U) + ((((size_t)(b * 4 + h) * 2 + 0) * 34 + cidx) * 256) * 128; bf16* Ub = Uf + (size_t)34 * 256 * 128;
#pragma unroll
        for (int x = 0; x < 8; ++x) { v4u o; o.x = pk2(af[x][0], af[x][1]); o.y = pk2(af[x][2], af[x][3]); o.z = pk2(af[x][4], af[x][5]); o.w = pk2(af[x][6], af[x][7]); *(v4u*)(Uf + (size_t)(8 * tv + x) * 128 + 8 * td) = o;
            o.x = pk2(ab[x][0], ab[x][1]); o.y = pk2(ab[x][2], ab[x][3]); o.z = pk2(ab[x][4], ab[x][5]); o.w = pk2(ab[x][6], ab[x][7]); *(v4u*)(Ub + (size_t)(8 * tv + x) * 128 + 8 * td) = o; }
        __syncthreads();
    }
}
__device__ __forceinline__ void p5_scan(Frame& F) {
    unsigned char* ws = F.ws;
    for (int it = F.vcu * 512 + F.tid; it < 32 * 4096; it += F.G * 512) {
        const int e8 = it & 4095, bhd = it >> 12, dir = bhd & 1, h = (bhd >> 1) & 3;
        const float g = __expf(128.0f * log_gamma(F, dir, h));
        const bf16* U = (const bf16*)(ws + WS_U) + (size_t)bhd * 34 * 32768 + 8 * e8; bf16* ST = (bf16*)(ws + WS_ST) + (size_t)bhd * 32 * 32768 + 8 * e8;
        float s[8];
#pragma unroll
        for (int i = 0; i < 8; ++i) s[i] = 0.f;
        for (int stp = 0; stp < 34; ++stp) {
            const int cidx = dir == 0 ? stp : (stp < 2 ? 1 - stp : 35 - stp);
            if (stp >= 2) { v4u o; o.x = pk2(s[0], s[1]); o.y = pk2(s[2], s[3]); o.z = pk2(s[4], s[5]); o.w = pk2(s[6], s[7]); *(v4u*)(ST + (size_t)(cidx - 2) * 32768) = o; }
            const v4u ur = *(const v4u*)(U + (size_t)cidx * 32768);
            const float uu[8] = {bflo(ur.x), bfhi(ur.x), bflo(ur.y), bfhi(ur.y), bflo(ur.z), bfhi(ur.z), bflo(ur.w), bfhi(ur.w)};
#pragma unroll
            for (int i = 0; i < 8; ++i) s[i] = g * s[i] + uu[i];
        }
    }
}
__device__ __forceinline__ void p5_attention(Frame& F, char* lds_generic) {
    unsigned char* ws = F.ws;
    for (int u = F.vcu; u < NB * 8 * 16; u += F.G) {
        const int qb = u & 15, hq = (u >> 4) & 7, b = u >> 7, kvh = hq >> 2;
        const bf16* Q = (const bf16*)(ws + WS_QA) + ((size_t)b * T + qb * 256) * 1024 + hq * 128;
        const bf16* K = (const bf16*)(ws + WS_KA) + (size_t)b * SKV * 256 + kvh * 128; const bf16* V = (const bf16*)(ws + WS_VA) + (size_t)b * SKV * 256 + kvh * 128;
        bf16* O = (bf16*)(ws + WS_O) + ((size_t)b * T + qb * 256) * 2048 + hq * 128;
        att::attn_dense_body(Q, K, V, O, SKV, lds_generic, F.tid);
    }
}
__device__ __forceinline__ void p6_ret_out(Frame& F) {
    unsigned char* ws = F.ws;
    LAS bf16* QT = (LAS bf16*)F.lds;
    LAS float* PT = (LAS float*)(F.lds + 32768);
    LAS bf16* KT = (LAS bf16*)(F.lds + 98304);
    LAS float* RS = (LAS float*)(F.lds + 98304);
    for (int u = F.vcu; u < NB * 4 * 32; u += F.G) {
        int tid = F.tid; asm volatile("" : "+v"(tid));
        const int n = u & 31, h = (u >> 5) & 3, b = u >> 7;
        const float lgf = log_gamma(F, 0, h), lgb = log_gamma(F, 1, h);
        const size_t qrow0 = (size_t)b * T + 128 * n, krow0 = (size_t)b * SKV + LC + 128 * n;
        const bf16* Qg = (const bf16*)(ws + WS_QR) + qrow0 * 512 + h * 128; const bf16* Kg = (const bf16*)(ws + WS_KR) + krow0 * 512 + h * 128;
        const bf16* Vg = (const bf16*)(ws + WS_VR) + krow0 * 1024 + h * 256;
        for (int i = tid; i < 128 * 16; i += 512) { const int r = i & 127, cc = i >> 7;
            const v4u q = *(const v4u*)(Qg + (size_t)r * 512 + 8 * cc), k = *(const v4u*)(Kg + (size_t)r * 512 + 8 * cc);
            const unsigned qq[4] = {q.x, q.y, q.z, q.w}, kk[4] = {k.x, k.y, k.z, k.w};
#pragma unroll
            for (int x = 0; x < 4; ++x) { QT[(8 * cc + 2 * x) * 128 + r] = (bf16)(qq[x] & 0xffffu); QT[(8 * cc + 2 * x + 1) * 128 + r] = (bf16)(qq[x] >> 16);
                KT[(8 * cc + 2 * x) * 128 + r] = (bf16)(kk[x] & 0xffffu); KT[(8 * cc + 2 * x + 1) * 128 + r] = (bf16)(kk[x] >> 16); } }
        __syncthreads();
        {
            const int ti = tid & 31, tj = tid >> 5;
            float s[4][8];
#pragma unroll
            for (int x = 0; x < 4; ++x)
#pragma unroll
                for (int y = 0; y < 8; ++y) s[x][y] = 0.f;
            for (int d = 0; d < 128; ++d) {
                const v2u qr = *(const LAS v2u*)(QT + d * 128 + 4 * ti); const v4u kr = *(const LAS v4u*)(KT + d * 128 + 8 * tj);
                const float qv[4] = {bflo(qr.x), bfhi(qr.x), bflo(qr.y), bfhi(qr.y)};
                const float kv[8] = {bflo(kr.x), bfhi(kr.x), bflo(kr.y), bfhi(kr.y), bflo(kr.z), bfhi(kr.z), bflo(kr.w), bfhi(kr.w)};
#pragma unroll
                for (int x = 0; x < 4; ++x)
#pragma unroll
                    for (int y = 0; y < 8; ++y) s[x][y] += qv[x] * kv[y];
                __builtin_amdgcn_sched_barrier(0);
            }
#pragma unroll
            for (int y = 0; y < 8; ++y) { const int j = 8 * tj + y; f32x4 o;
#pragma unroll
                for (int x = 0; x < 4; ++x) { const int i = 4 * ti + x; const float w = i > j ? __expf(lgf * (float)(i - j)) : (i < j ? __expf(lgb * (float)(j - i)) : 2.0f); o[x] = s[x][y] * w; }
                *(LAS f32x4*)(PT + j * 128 + 4 * ti) = o; }
        }
        __syncthreads();
        {
            const int i2 = (tid & 63) * 2;
            const float f0 = __expf(lgf * (float)(i2 + 1)), f1 = __expf(lgf * (float)(i2 + 2)), b0 = __expf(lgb * (float)(128 - i2)), b1 = __expf(lgb * (float)(127 - i2));
            for (int d = tid >> 6; d < 128; d += 8) { const unsigned w = *(const LAS unsigned*)(QT + d * 128 + i2); const float q0 = bflo(w), q1 = bfhi(w);
                *(LAS unsigned*)(QT + d * 128 + i2) = pk2(q0 * f0, q1 * f1); *(LAS unsigned*)(KT + d * 128 + i2) = pk2(q0 * b0, q1 * b1); }
        }
        __syncthreads();
        const int ib = tid & 15, vb = tid >> 4;
        float o[8][8];
#pragma unroll
        for (int x = 0; x < 8; ++x)
#pragma unroll
            for (int y = 0; y < 8; ++y) o[x][y] = 0.f;
#pragma unroll 2
        for (int j = 0; j < 128; ++j) {
            const f32x4 p0 = *(const LAS f32x4*)(PT + j * 128 + 8 * ib), p1 = *(const LAS f32x4*)(PT + j * 128 + 8 * ib + 4);
            const v4u vr = *(const v4u*)(Vg + (size_t)j * 1024 + 8 * vb);
            const float pv[8] = {p0[0], p0[1], p0[2], p0[3], p1[0], p1[1], p1[2], p1[3]};
            const float vv[8] = {bflo(vr.x), bfhi(vr.x), bflo(vr.y), bfhi(vr.y), bflo(vr.z), bfhi(vr.z), bflo(vr.w), bfhi(vr.w)};
#pragma unroll
            for (int x = 0; x < 8; ++x)
#pragma unroll
                for (int y = 0; y < 8; ++y) o[x][y] += pv[x] * vv[y];
        }
        LAS bf16* STt = (LAS bf16*)(F.lds + 32768);
#pragma unroll 1
        for (int dir = 0; dir < 2; ++dir) {
            __syncthreads();
            const bf16* STg = (const bf16*)(ws + WS_ST) + ((((size_t)(b * 4 + h) * 2 + dir) * 32 + n) * 256) * 128;
            for (int i = tid; i < 256 * 16; i += 512) { const int v = i >> 4, cc = i & 15; const v4u w = *(const v4u*)(STg + (size_t)v * 128 + 8 * cc);
                const unsigned ww[4] = {w.x, w.y, w.z, w.w};
#pragma unroll
                for (int x = 0; x < 4; ++x) { STt[(8 * cc + 2 * x) * 256 + v] = (bf16)(ww[x] & 0xffffu); STt[(8 * cc + 2 * x + 1) * 256 + v] = (bf16)(ww[x] >> 16); } }
            __syncthreads();
            const LAS bf16* QS = dir == 0 ? QT : KT;
#pragma unroll 2
            for (int d = 0; d < 128; ++d) {
                const v4u qr = *(const LAS v4u*)(QS + d * 128 + 8 * ib), sr = *(const LAS v4u*)(STt + d * 256 + 8 * vb);
                const float qv[8] = {bflo(qr.x), bfhi(qr.x), bflo(qr.y), bfhi(qr.y), bflo(qr.z), bfhi(qr.z), bflo(qr.w), bfhi(qr.w)};
                const float sv[8] = {bflo(sr.x), bfhi(sr.x), bflo(sr.y), bfhi(sr.y), bflo(sr.z), bfhi(sr.z), bflo(sr.w), bfhi(sr.w)};
#pragma unroll
                for (int x = 0; x < 8; ++x)
#pragma unroll
                    for (int y = 0; y < 8; ++y) o[x][y] += qv[x] * sv[y];
            }
        }
        __syncthreads();
#pragma unroll
        for (int x = 0; x < 8; ++x) { float s1 = 0.f, s2 = 0.f;
#pragma unroll
            for (int y = 0; y < 8; ++y) { s1 += o[x][y]; s2 += o[x][y] * o[x][y]; }
            RS[((8 * ib + x) * 32 + vb) * 2] = s1; RS[((8 * ib + x) * 32 + vb) * 2 + 1] = s2; }
        __syncthreads();
        const float* gn = inp(F, I_GN) + h * 256 + 8 * vb;
        float gnv[8];
#pragma unroll
        for (int y = 0; y < 8; ++y) gnv[y] = gn[y];
#pragma unroll
        for (int x = 0; x < 8; ++x) { const int i = 8 * ib + x; float s1 = 0.f, s2 = 0.f;
            for (int q = 0; q < 32; ++q) { s1 += RS[(i * 32 + q) * 2]; s2 += RS[(i * 32 + q) * 2 + 1]; }
            const float mu = s1 * (1.0f / 256.0f); const float var = fmaxf(s2 * (1.0f / 256.0f) - mu * mu, 0.f); const float rstd = 1.0f / sqrtf(var + EPS);
            const v4u gr = *(const v4u*)((const bf16*)(ws + WS_GR) + (qrow0 + i) * 1024 + h * 256 + 8 * vb);
            const float gg[8] = {bflo(gr.x), bfhi(gr.x), bflo(gr.y), bfhi(gr.y), bflo(gr.z), bfhi(gr.z), bflo(gr.w), bfhi(gr.w)};
            float y8[8];
#pragma unroll
            for (int y = 0; y < 8; ++y) y8[y] = (o[x][y] - mu) * rstd * gnv[y] * siluf_(gg[y]);
            v4u w; w.x = pk2(y8[0], y8[1]); w.y = pk2(y8[2], y8[3]); w.z = pk2(y8[4], y8[5]); w.w = pk2(y8[6], y8[7]);
            *(v4u*)((bf16*)(ws + WS_O) + (qrow0 + i) * 2048 + 1024 + h * 256 + 8 * vb) = w;
            __builtin_amdgcn_sched_barrier(0); }
        __syncthreads();
    }
}

__device__ __forceinline__ void p10_norm_router(Frame& F) {
    unsigned char* ws = F.ws;
    LAS float* WRT = (LAS float*)F.lds;
    LAS float* C1 = (LAS float*)(F.lds + 131072); LAS float* A2 = C1 + 2048; LAS float* B2 = C1 + 4096;
    const int b = F.vcu & 3, sub = F.vcu >> 2, nsub = F.G >> 2;
    const float* MOD = (const float*)(ws + WS_MOD) + (size_t)b * 12288;
    for (int i = F.tid; i < 2048 * 16; i += 512) { const int k = i >> 4, e = i & 15; WRT[e * 2048 + k] = inp(F, I_WR)[i]; }
    for (int k = F.tid; k < 2048; k += 512) { C1[k] = MOD[4096 + k] * inp(F, I_POST1)[k]; A2[k] = inp(F, I_PRE2)[k] * (1.0f + MOD[8192 + k]); B2[k] = MOD[6144 + k]; }
    __syncthreads();
    const bf16* YO = (const bf16*)(ws + WS_YO); bf16* H2 = (bf16*)(ws + WS_H); float* AFF = (float*)(ws + WS_AFF);
    const int lane = F.lane;
    for (int t = sub * NWAVES + F.wave; t < T; t += nsub * NWAVES) {
        const size_t m = (size_t)b * T + t;
        const f32x4* xr = (const f32x4*)(inp(F, I_X) + m * DM) + lane; const v2u* yr = (const v2u*)(YO + m * DM) + lane;
        f32x4 xv[8], yv[8]; float s = 0.f;
#pragma unroll
        for (int j = 0; j < 8; ++j) { xv[j] = xr[64 * j]; const v2u w = yr[64 * j]; yv[j] = (f32x4){bflo(w.x), bfhi(w.x), bflo(w.y), bfhi(w.y)};
            s += (yv[j].x * yv[j].x + yv[j].y * yv[j].y) + (yv[j].z * yv[j].z + yv[j].w * yv[j].w); }
        const float r1 = 1.0f / sqrtf(wave_sum(s) * (1.0f / DM) + EPS);
        f32x4* orow = (f32x4*)(F.out + m * DM) + lane; float s2 = 0.f;
#pragma unroll
        for (int j = 0; j < 8; ++j) { const f32x4 c1 = *(const LAS f32x4*)(C1 + 4 * (64 * j + lane)); xv[j] = xv[j] + c1 * (yv[j] * r1); orow[64 * j] = xv[j];
            s2 += (xv[j].x * xv[j].x + xv[j].y * xv[j].y) + (xv[j].z * xv[j].z + xv[j].w * xv[j].w); }
        const float r2 = 1.0f / sqrtf(wave_sum(s2) * (1.0f / DM) + EPS);
        v2u* hrow = (v2u*)(H2 + m * DM) + lane;
#pragma unroll
        for (int j = 0; j < 8; ++j) { const f32x4 a2 = *(const LAS f32x4*)(A2 + 4 * (64 * j + lane)), b2 = *(const LAS f32x4*)(B2 + 4 * (64 * j + lane)); xv[j] = xv[j] * r2 * a2 + b2;
            v2u w; w.x = pk2(xv[j].x, xv[j].y); w.y = pk2(xv[j].z, xv[j].w); hrow[64 * j] = w; }
        float lg[16];
#pragma unroll
        for (int e = 0; e < 16; ++e) { float a = 0.f;
#pragma unroll
            for (int j = 0; j < 8; ++j) { const f32x4 w = *(const LAS f32x4*)(WRT + e * 2048 + 4 * (64 * j + lane)); a += (xv[j].x * w.x + xv[j].y * w.y) + (xv[j].z * w.z + xv[j].w * w.w); }
            lg[e] = wave_sum(a); }
        float mx = lg[0];
#pragma unroll
        for (int e = 1; e < 16; ++e) mx = fmaxf(mx, lg[e]);
        float den = 0.f;
#pragma unroll
        for (int e = 0; e < 16; ++e) { lg[e] = expf(lg[e] - mx); den += lg[e]; }
        float mine = 0.f;
#pragma unroll
        for (int e = 0; e < 16; ++e) mine = (lane == e) ? lg[e] : mine;
        if (lane < 16) AFF[((size_t)b * 16 + lane) * T + t] = mine / den;
    }
}

__device__ __forceinline__ void p11_topk(Frame& F) {
    unsigned char* ws = F.ws;
    LAS unsigned* hist = (LAS unsigned*)F.lds;
    LAS unsigned* bc = hist + 256;
    LAS unsigned* wtot = hist + 272;
    LAS int* selrow = (LAS int*)(F.lds + 4096);
    const int tid = F.tid, lane = F.lane, wave = F.wave;
    for (int u = F.vcu; u < NB * NE; u += F.G) {
        const int b = u >> 4, e = u & 15;
        const float* aff = (const float*)(ws + WS_AFF) + ((size_t)b * 16 + e) * T;
        const f32x4 v0 = *(const f32x4*)(aff + 8 * tid), v1 = *(const f32x4*)(aff + 8 * tid + 4);
        const float val[8] = {v0[0], v0[1], v0[2], v0[3], v1[0], v1[1], v1[2], v1[3]};
        unsigned key[8];
#pragma unroll
        for (int i = 0; i < 8; ++i) key[i] = __float_as_uint(val[i]);
        unsigned prefix = 0u, kth = CAP;
#pragma unroll 1
        for (int pass = 0; pass < 4; ++pass) {
            const int shift = 24 - 8 * pass;
            if (tid < 256) hist[tid] = 0u;
            __syncthreads();
#pragma unroll
            for (int i = 0; i < 8; ++i) { const bool in = pass == 0 ? true : ((key[i] >> (shift + 8)) == prefix); if (in) atomicAdd((unsigned*)&hist[(key[i] >> shift) & 255u], 1u); }
            __syncthreads();
            if (tid == 0) { unsigned cum = 0u; int bin = 255; for (; bin > 0; --bin) { const unsigned hcnt = hist[bin]; if (cum + hcnt >= kth) break; cum += hcnt; } bc[0] = (prefix << 8) | (unsigned)bin; bc[1] = kth - cum; }
            __syncthreads();
            prefix = bc[0]; kth = bc[1];
            __syncthreads();
        }
        const unsigned thr = prefix, need = kth;
        unsigned ng = 0u, neq = 0u;
#pragma unroll
        for (int i = 0; i < 8; ++i) { ng += key[i] > thr ? 1u : 0u; neq += key[i] == thr ? 1u : 0u; }
        unsigned sg = ng, se = neq;
#pragma unroll
        for (int o = 1; o < 64; o <<= 1) { const unsigned a = __shfl_up(sg, o), c = __shfl_up(se, o); if (lane >= o) { sg += a; se += c; } }
        if (lane == 63) { wtot[wave * 2] = sg; wtot[wave * 2 + 1] = se; }
        __syncthreads();
        unsigned bg = sg - ng, be = se - neq;
        for (int w = 0; w < wave; ++w) { bg += wtot[w * 2]; be += wtot[w * 2 + 1]; }
        int* rowidx = (int*)(ws + WS_ROWIDX) + e * 2048 + b * CAP; float* topw = (float*)(ws + WS_TOPW) + e * 2048 + b * CAP; int* inv = (int*)(ws + WS_INV);
#pragma unroll
        for (int i = 0; i < 8; ++i) {
            const int t = 8 * tid + i; const bool gt = key[i] > thr, eq = key[i] == thr; const bool sel = gt || (eq && be < need);
            const unsigned slot = bg + (be < need ? be : need);
            if (sel) { rowidx[slot] = b * T + t; topw[slot] = val[i]; selrow[slot] = t; }
            inv[((size_t)b * T + t) * 16 + e] = sel ? (int)(e * 2048 + b * CAP + slot) : -1;
            bg += gt ? 1u : 0u; be += eq ? 1u : 0u;
        }
        __syncthreads();
        const bf16* H2 = (const bf16*)(ws + WS_H); bf16* XG = (bf16*)(ws + WS_XG);
        for (int s = wave; s < CAP; s += NWAVES) {
            const v4u* src = (const v4u*)(H2 + ((size_t)b * T + selrow[s]) * DM) + lane; v4u* dst = (v4u*)(XG + ((size_t)e * 2048 + b * CAP + s) * DM) + lane;
#pragma unroll
            for (int j = 0; j < 4; ++j) dst[64 * j] = src[64 * j];
        }
        __syncthreads();
    }
}

__device__ __forceinline__ void p14_final(Frame& F) {
    unsigned char* ws = F.ws;
    LAS float* C2 = (LAS float*)F.lds;
    const int b = F.vcu & 3, sub = F.vcu >> 2, nsub = F.G >> 2;
    const float* MOD = (const float*)(ws + WS_MOD) + (size_t)b * 12288;
    for (int k = F.tid; k < 2048; k += 512) C2[k] = MOD[10240 + k] * inp(F, I_POST2)[k];
    __syncthreads();
    const bf16* YEXP = (const bf16*)(ws + WS_YEXP); const int* inv = (const int*)(ws + WS_INV); const int lane = F.lane;
    for (int t = sub * NWAVES + F.wave; t < T; t += nsub * NWAVES) {
        const size_t m = (size_t)b * T + t;
        f32x4 acc[8];
#pragma unroll
        for (int j = 0; j < 8; ++j) acc[j] = (f32x4){0.f, 0.f, 0.f, 0.f};
        for (int e = 0; e < 16; ++e) {
            const int slot = __builtin_amdgcn_readfirstlane(inv[m * 16 + e]);
            if (slot >= 0) { const v2u* yr = (const v2u*)(YEXP + (size_t)slot * DM) + lane;
#pragma unroll
                for (int j = 0; j < 8; ++j) { const v2u w = yr[64 * j]; acc[j] += (f32x4){bflo(w.x), bfhi(w.x), bflo(w.y), bfhi(w.y)}; } }
        }
        float s = 0.f;
#pragma unroll
        for (int j = 0; j < 8; ++j) s += (acc[j].x * acc[j].x + acc[j].y * acc[j].y) + (acc[j].z * acc[j].z + acc[j].w * acc[j].w);
        const float r = 1.0f / sqrtf(wave_sum(s) * (1.0f / DM) + EPS);
        f32x4* orow = (f32x4*)(F.out + m * DM) + lane;
#pragma unroll
        for (int j = 0; j < 8; ++j) { const f32x4 c2 = *(const LAS f32x4*)(C2 + 4 * (64 * j + lane)); orow[64 * j] = orow[64 * j] + c2 * (acc[j] * r); }
    }
}

struct Args { const float* in[22]; float* out; unsigned char* ws; int ph_lo, ph_hi; };
__global__ void __launch_bounds__(NWAVES * 64, 2) fwd(Args args) {
    extern __shared__ __attribute__((aligned(16))) unsigned char lds[];
    Frame F;
    F.lds = (LAS unsigned char*)lds;
    F.MISC = (volatile LAS unsigned*)(F.lds + MISC_OFF);
    F.tid = threadIdx.x; F.lane = F.tid & 63; F.wave = __builtin_amdgcn_readfirstlane(F.tid >> 6);
    F.G = gridDim.x; { const int bx = blockIdx.x; F.vcu = (F.G % 8 == 0) ? (bx % 8) * (F.G / 8) + bx / 8 : bx; }
    unsigned char* ws = args.ws; F.ws = ws; F.out = args.out;
    F.ctl = (gu32*)(ws + WS_CTL);
    for (int u = F.tid; u < (LDS_BYTES - LDSCTL_OFF) / 4; u += NWAVES * 64) ((LAS unsigned*)(F.lds + LDSCTL_OFF))[u] = 0u;
    __syncthreads();
    if (F.tid < 22) ((LAS unsigned long long*)(F.lds + LDSCTL_OFF))[F.tid] = (unsigned long long)(uintptr_t)args.in[F.tid];
    __syncthreads();
    XcdBarrier bar; bar.bar = (unsigned*)(F.ctl + CW_BAR); bar.x = 0; bar.st = nullptr;
    if (N_LAUNCHES != N_PHASES) bar = xcd_barrier_post((unsigned*)(F.ctl + CW_BAR), F.MISC + 8);
#define GRID_BAR(seam) do { if (N_LAUNCHES == N_PHASES) { if (F.tid == 0) __hip_atomic_store(F.ctl + CW_TMO, 0xBADBA0u | (unsigned)(seam), RLX_AGENT); } else { xcd_barrier(bar); } } while (0)
    const int lo = args.ph_lo, hi = args.ph_hi;
#ifndef PH_MASK
#define PH_MASK 0x7fff
#endif
#define IN(k) (((PH_MASK >> (k)) & 1) && lo <= (k) && (k) < hi)
#define BOTH(k) (IN(k) && IN((k) + 1))
#define FRESH() do { asm volatile("" : "+v"(F.tid)); F.lane = F.tid & 63; F.wave = __builtin_amdgcn_readfirstlane(F.tid >> 6); asm volatile("" : "+s"(F.vcu), "+s"(F.G)); } while (0)

    if (IN(0)) { FRESH(); p0_prologue(F); if (BOTH(0)) GRID_BAR(0); }
    if (IN(1)) { FRESH(); p1_h(F); if (BOTH(1)) GRID_BAR(1); }
    if (IN(2)) { FRESH();
        pg8::Gemm g{(const bf16*)(ws + WS_H), (const bf16*)(ws + WS_WIN), 2048, 2048, 2048}; pg8::InProjOrder S; S.init(F.G, (int)blockIdx.x);
        pg8::EpiZ E{(bf16*)(ws + WS_QA), (bf16*)(ws + WS_QR), (bf16*)(ws + WS_GR), (bf16*)(ws + WS_GATE), (bf16*)(ws + WS_KA), (bf16*)(ws + WS_VA), (bf16*)(ws + WS_KR), (bf16*)(ws + WS_VR)};
        pg8::gemm_phase<pg8::EpiZ, pg8::InProjOrder, true>(F.lds + RING_OFF, g, S, E, F.tid);
        if (BOTH(2)) GRID_BAR(2);
    }
    if (IN(3)) { FRESH(); p3_rope(F); if (BOTH(3)) GRID_BAR(3); }
    if (IN(4)) { FRESH(); p4_chunk_states(F); if (BOTH(4)) GRID_BAR(4); }
    if (IN(5)) { FRESH(); p5_scan(F); p5_attention(F, (char*)lds); if (BOTH(5)) GRID_BAR(5); }
    if (IN(6)) { FRESH(); p6_ret_out(F); if (BOTH(6)) GRID_BAR(6); }
    if (IN(7)) { FRESH();
        pg8::Gemm g{(const bf16*)(ws + WS_O), (const bf16*)(ws + WS_WOA), 2048, 1024, 1024}; pg8::StaticOrder S; S.init(M, DM, F.G, (int)blockIdx.x);
        pg8::EpiGate<false> E{(bf16*)(ws + WS_Y), (const bf16*)(ws + WS_GATE), 0};
        pg8::gemm_phase<pg8::EpiGate<false>, pg8::StaticOrder, true>(F.lds + RING_OFF, g, S, E, F.tid);
        if (BOTH(7)) GRID_BAR(7);
    }
    if (IN(8)) { FRESH();
        pg8::Gemm g{(const bf16*)(ws + WS_O) + 1024, (const bf16*)(ws + WS_WOR), 2048, 1024, 1024}; pg8::StaticOrder S; S.init(M, DM, F.G, (int)blockIdx.x);
        pg8::EpiGate<true> E{(bf16*)(ws + WS_Y), (const bf16*)(ws + WS_GATE), 2048};
        pg8::gemm_phase<pg8::EpiGate<true>, pg8::StaticOrder, true>(F.lds + RING_OFF, g, S, E, F.tid);
        if (BOTH(8)) GRID_BAR(8);
    }
    if (IN(9)) { FRESH();
        pg8::Gemm g{(const bf16*)(ws + WS_Y), (const bf16*)(ws + WS_WOUT), 2048, 2048, 2048}; pg8::StaticOrder S; S.init(M, DM, F.G, (int)blockIdx.x);
        pg8::EpiPlain E{(bf16*)(ws + WS_YO), 2048};
        pg8::gemm_phase<pg8::EpiPlain, pg8::StaticOrder, true>(F.lds + RING_OFF, g, S, E, F.tid);
        if (BOTH(9)) GRID_BAR(9);
    }
    if (IN(10)) { FRESH(); p10_norm_router(F); if (BOTH(10)) GRID_BAR(10); }
    if (IN(11)) { FRESH(); p11_topk(F); if (BOTH(11)) GRID_BAR(11); }
    if (IN(12)) { FRESH();
        pg8::Gemm g{(const bf16*)(ws + WS_XG), (const bf16*)(ws + WS_WGU), 2048, 2048, 2048}; pg8::ExpertOrder S; S.init(NE, 8, 16, F.G, (int)blockIdx.x);
        pg8::EpiSwiGLU E{(bf16*)(ws + WS_ACT)};
        pg8::gemm_phase<pg8::EpiSwiGLU, pg8::ExpertOrder, true>(F.lds + RING_OFF, g, S, E, F.tid);
        if (BOTH(12)) GRID_BAR(12);
    }
    if (IN(13)) { FRESH();
        pg8::Gemm g{(const bf16*)(ws + WS_ACT), (const bf16*)(ws + WS_WDN), 2048, 2048, 2048}; pg8::ExpertOrder S; S.init(NE, 8, 8, F.G, (int)blockIdx.x);
        pg8::EpiDown E{(bf16*)(ws + WS_YEXP), (const float*)(ws + WS_TOPW)};
        pg8::gemm_phase<pg8::EpiDown, pg8::ExpertOrder, true>(F.lds + RING_OFF, g, S, E, F.tid);
        if (BOTH(13)) GRID_BAR(13);
    }
    if (IN(14)) { FRESH(); p14_final(F); }
#undef IN
#undef BOTH
}

extern "C" void kernel_launch(void* const* d_in, const int* in_sizes, int n_in, void* d_out, int out_size, void* d_ws, size_t ws_size, hipStream_t stream) {
    static int grid = 0;
    if (grid == 0) {
        if (n_in != 22 || out_size != M * DM || ws_size < WS_END) { fprintf(stderr, "kernel_launch: unexpected shapes: n_in %d out %d ws %zu (need %zu)\n", n_in, out_size, ws_size, (size_t)WS_END); grid = -1; return; }
        int dev = 0, cus = 0, per_cu = 0;
        if (hipGetDevice(&dev) != hipSuccess || hipDeviceGetAttribute(&cus, hipDeviceAttributeMultiprocessorCount, dev) != hipSuccess) { grid = -1; return; }
        if (hipFuncSetAttribute((const void*)fwd, hipFuncAttributeMaxDynamicSharedMemorySize, LDS_BYTES) != hipSuccess) { fprintf(stderr, "kernel_launch: hipFuncSetAttribute failed\n"); grid = -1; return; }
        if (hipOccupancyMaxActiveBlocksPerMultiprocessor(&per_cu, (const void*)fwd, NWAVES * 64, LDS_BYTES) != hipSuccess || per_cu < 1) fprintf(stderr, "kernel_launch: occupancy query reports %d\n", per_cu);
        (void)hipGetLastError();
        grid = cus - (cus % 8);
        if (grid < 8) grid = 8;
    }
    if (grid < 0) return;
    if (hipMemsetAsync((char*)d_ws + WS_CTL, 0, CTL_ZERO_BYTES, stream) != hipSuccess) return;
    Args a{};
    for (int i = 0; i < 22; ++i) a.in[i] = (const float*)d_in[i];
    a.out = (float*)d_out; a.ws = (unsigned char*)d_ws;
    if (N_LAUNCHES == 1) { a.ph_lo = 0; a.ph_hi = N_PHASES; hipLaunchKernelGGL(fwd, dim3(grid), dim3(NWAVES * 64), LDS_BYTES, stream, a); }
    else for (int p = 0; p < N_PHASES; ++p) { a.ph_lo = p; a.ph_hi = p + 1; hipLaunchKernelGGL(fwd, dim3(grid), dim3(NWAVES * 64), LDS_BYTES, stream, a); }
    const hipError_t le = hipPeekAtLastError();
    if (le != hipSuccess) fprintf(stderr, "kernel_launch: launch failed: %s\n", hipGetErrorName(le));
}
```

```cpp
#include <hip/hip_runtime.h>
#include <cstdio>
#include <cstdint>

#ifndef MK_N_LAUNCHES
#define MK_N_LAUNCHES 1
#endif

namespace pg8 {
#define PG8_LAS __attribute__((address_space(3)))
typedef unsigned short bf16_t;
typedef short bf16x8 __attribute__((ext_vector_type(8)));
typedef float f32x4 __attribute__((ext_vector_type(4)));
typedef unsigned u32x4 __attribute__((ext_vector_type(4)));
constexpr int BM = 256, BK = 64, HALF = 128, HTB = HALF * BK * 2, STAGE_BYTES = 8 * HTB, NXCD = 8, WGM = 8;

__host__ __device__ __forceinline__ int lds_byte(int r, int c) { const int st = (r >> 4) * 2 + (c >> 5), rr = r & 15, cc = c & 31, ob = rr * 64 + cc * 2; return st * 1024 + (ob ^ (((ob >> 9) & 1) << 5)); }
__host__ __device__ __forceinline__ void stage_rc(int b, int& R, int& C) { const int st = b / 1024, sb = b % 1024, swz = sb ^ (((sb >> 9) & 1) << 5); R = (st >> 1) * 16 + swz / 64; C = (st & 1) * 32 + (swz % 64) / 2; }
__host__ __device__ __forceinline__ int perm32(int rho) { const int n = rho >> 4, i = rho & 15; return 8 * (i >> 2) + 4 * n + (i & 3); }

struct Unit { int pm, pn; };
struct Gemm { const bf16_t* A; const bf16_t* Bt; int lda, ldb, K; };

struct StaticOrder {
    int nM, nN, nwg, G, c;
    __host__ __device__ void init(int M, int N, int G_, int c_) { nM = M / BM; nN = N / BM; nwg = nM * nN; G = G_; c = c_; }
    __host__ __device__ bool next(int i, Unit& u) const {
        const long L = (long)i * G + c; if (L >= nwg) return false;
        int wgid = (int)L; { const int q = nwg / NXCD, r = nwg % NXCD, xcd = wgid % NXCD, off = wgid / NXCD; wgid = (xcd < r ? xcd * (q + 1) : r * (q + 1) + (xcd - r) * q) + off; }
        const int nig = WGM * nN, gid = wgid / nig, fm = gid * WGM, gsz = (nM - fm) < WGM ? (nM - fm) : WGM;
        u.pm = fm + ((wgid % nig) % gsz); u.pn = (wgid % nig) / gsz; return true;
    }
};
struct InProjOrder {
    StaticOrder so; int G, c;
    __host__ __device__ void init(int G_, int c_) { so.init(16384, 8704, G_, c_); G = G_; c = c_; }
    __host__ __device__ bool next(int i, Unit& u) const {
        const long L = (long)i * G + c; if (L < so.nwg) return so.next(i, u);
        const int r = (int)(L - so.nwg); if (r >= 32) return false;
        u.pm = 64 + (r >> 3); u.pn = 26 + (r & 7); return true;
    }
};
struct ExpertOrder {
    int nPm, nPn, per, total, G, c;
    __host__ __device__ void init(int nE, int nPm_, int nPn_, int G_, int c_) { nPm = nPm_; nPn = nPn_; per = nPm * nPn; total = nE * per; G = G_; c = c_; }
    __host__ __device__ bool next(int i, Unit& u) const {
        const long L = (long)i * G + c; if (L >= total) return false;
        const int e = (int)L / per, rem = (int)L % per; u.pm = e * nPm + rem % nPm; u.pn = e * nPn + rem / nPm; return true;
    }
};

__device__ __forceinline__ unsigned cvt_pk_bf16(float lo, float hi) { unsigned r; asm volatile("v_cvt_pk_bf16_f32 %0, %1, %2" : "=v"(r) : "v"(lo), "v"(hi)); return r; }
__device__ __forceinline__ float bflo(unsigned w) { return __uint_as_float(w << 16); }
__device__ __forceinline__ float bfhi(unsigned w) { return __uint_as_float(w & 0xffff0000u); }
__device__ __forceinline__ float sigmoidf_(float x) { return 1.0f / (1.0f + __expf(-x)); }

#define PG8_EPI_LOOP_BEGIN _Pragma("unroll") for (int ai = 0; ai < 2; ++ai) _Pragma("unroll") for (int m = 0; m < 4; ++m) { const int rloc = ai * HALF + wr * 64 + m * 16 + fr;
#define PG8_EPI_LOOP_END }
__device__ __forceinline__ u32x4 pack8(const f32x4& v0, const f32x4& v1) { u32x4 w; w.x = cvt_pk_bf16(v0[0], v0[1]); w.y = cvt_pk_bf16(v0[2], v0[3]); w.z = cvt_pk_bf16(v1[0], v1[1]); w.w = cvt_pk_bf16(v1[2], v1[3]); return w; }

struct EpiZ {
    static constexpr bool PERM = true;
    bf16_t *QA, *QR, *GR, *GATE, *KA, *VA, *KR, *VR;
    __device__ __forceinline__ void operator()(const f32x4 (&acc)[2][2][4][2], const Unit& u, int wr, int wc, int fr, int fq) const {
        const int pn = u.pn, pm = u.pm; bf16_t* base; int ldc, colt;
        if (pn < 4) { base = QA; ldc = 1024; colt = pn * 256; } else if (pn < 6) { base = QR; ldc = 512; colt = (pn - 4) * 256; } else if (pn < 10) { base = GR; ldc = 1024; colt = (pn - 6) * 256; }
        else if (pn < 26) { base = GATE; ldc = 4096; colt = (pn - 10) * 256; } else if (pn == 26) { base = KA; ldc = 256; colt = 0; } else if (pn == 27) { base = VA; ldc = 256; colt = 0; }
        else if (pn < 30) { base = KR; ldc = 512; colt = (pn - 28) * 256; } else { base = VR; ldc = 1024; colt = (pn - 30) * 256; }
        int rowt; if (pn < 26) rowt = pm * 256; else if (pm < 64) rowt = (pm >> 4) * 4352 + 256 + (pm & 15) * 256; else rowt = (pm - 64) * 4352;
        const int col0 = colt + wc * 32 + 8 * fq;
        PG8_EPI_LOOP_BEGIN
            bf16_t* rowp = base + (size_t)(rowt + rloc) * ldc + col0;
#pragma unroll
            for (int bj = 0; bj < 2; ++bj) *(u32x4*)(rowp + bj * HALF) = pack8(acc[ai][bj][m][0], acc[ai][bj][m][1]);
        PG8_EPI_LOOP_END
    }
};
struct EpiPlain {
    static constexpr bool PERM = true;
    bf16_t* O; int ldc;
    __device__ __forceinline__ void operator()(const f32x4 (&acc)[2][2][4][2], const Unit& u, int wr, int wc, int fr, int fq) const {
        const int col0 = u.pn * BM + wc * 32 + 8 * fq;
        PG8_EPI_LOOP_BEGIN
            bf16_t* rowp = O + (size_t)(u.pm * BM + rloc) * ldc + col0;
#pragma unroll
            for (int bj = 0; bj < 2; ++bj) *(u32x4*)(rowp + bj * HALF) = pack8(acc[ai][bj][m][0], acc[ai][bj][m][1]);
        PG8_EPI_LOOP_END
    }
};
template <bool ADD> struct EpiGate {
    static constexpr bool PERM = true;
    bf16_t* Y; const bf16_t* gate; int goff;
    __device__ __forceinline__ void operator()(const f32x4 (&acc)[2][2][4][2], const Unit& u, int wr, int wc, int fr, int fq) const {
        const int col0 = u.pn * BM + wc * 32 + 8 * fq;
        PG8_EPI_LOOP_BEGIN
            const size_t row = (size_t)(u.pm * BM + rloc);
#pragma unroll
            for (int bj = 0; bj < 2; ++bj) {
                const u32x4 g = *(const u32x4*)(gate + row * 4096 + goff + col0 + bj * HALF);
                f32x4 v0 = acc[ai][bj][m][0], v1 = acc[ai][bj][m][1];
                v0[0] *= sigmoidf_(bflo(g.x)); v0[1] *= sigmoidf_(bfhi(g.x)); v0[2] *= sigmoidf_(bflo(g.y)); v0[3] *= sigmoidf_(bfhi(g.y));
                v1[0] *= sigmoidf_(bflo(g.z)); v1[1] *= sigmoidf_(bfhi(g.z)); v1[2] *= sigmoidf_(bflo(g.w)); v1[3] *= sigmoidf_(bfhi(g.w));
                bf16_t* yp = Y + row * 2048 + col0 + bj * HALF;
                if (ADD) { const u32x4 y = *(const u32x4*)yp;
                    v0[0] += bflo(y.x); v0[1] += bfhi(y.x); v0[2] += bflo(y.y); v0[3] += bfhi(y.y); v1[0] += bflo(y.z); v1[1] += bfhi(y.z); v1[2] += bflo(y.w); v1[3] += bfhi(y.w); }
                *(u32x4*)yp = pack8(v0, v1);
            }
        PG8_EPI_LOOP_END
    }
};
struct EpiSwiGLU {
    static constexpr bool PERM = true;
    bf16_t* ACT;
    __device__ __forceinline__ void operator()(const f32x4 (&acc)[2][2][4][2], const Unit& u, int wr, int wc, int fr, int fq) const {
        const int col0 = (u.pn & 15) * 128 + wc * 32 + 8 * fq;
        PG8_EPI_LOOP_BEGIN
            f32x4 v0, v1;
#pragma unroll
            for (int j = 0; j < 4; ++j) { const float a0 = acc[ai][0][m][0][j], a1 = acc[ai][0][m][1][j]; v0[j] = a0 * sigmoidf_(a0) * acc[ai][1][m][0][j]; v1[j] = a1 * sigmoidf_(a1) * acc[ai][1][m][1][j]; }
            *(u32x4*)(ACT + (size_t)(u.pm * BM + rloc) * 2048 + col0) = pack8(v0, v1);
        PG8_EPI_LOOP_END
    }
};
struct EpiDown {
    static constexpr bool PERM = true;
    bf16_t* Y; const float* topw;
    __device__ __forceinline__ void operator()(const f32x4 (&acc)[2][2][4][2], const Unit& u, int wr, int wc, int fr, int fq) const {
        const int col0 = (u.pn & 7) * BM + wc * 32 + 8 * fq;
        PG8_EPI_LOOP_BEGIN
            const size_t row = (size_t)(u.pm * BM + rloc); const float w = topw[row];
#pragma unroll
            for (int bj = 0; bj < 2; ++bj) *(u32x4*)(Y + row * 2048 + col0 + bj * HALF) = pack8(acc[ai][bj][m][0] * w, acc[ai][bj][m][1] * w);
        PG8_EPI_LOOP_END
    }
};

template <class Epi, class Sched, bool ALIGN_EPI>
__device__ __forceinline__ void gemm_phase(PG8_LAS unsigned char* lds, const Gemm g, const Sched& S, const Epi& E, const int tid) {
    const int wid = __builtin_amdgcn_readfirstlane(tid >> 6), lane = tid & 63, wr = wid >> 2, wc = wid & 3, fr = lane & 15, fq = lane >> 4;
    const int K = g.K, nt = K / BK;
    unsigned voffA[2], voffB[2];
#pragma unroll
    for (int i = 0; i < 2; ++i) { int R, C; stage_rc(tid * 16 + i * 8192, R, C); const int Rb = Epi::PERM ? ((R & ~31) + perm32(R & 31)) : R;
        voffA[i] = (unsigned)(R * g.lda + C) * 2u; voffB[i] = (unsigned)(Rb * g.ldb + C) * 2u; }
    const size_t kstep = (size_t)(BK * 2);
    const size_t hA = (size_t)HALF * g.lda * 2, hB = (size_t)HALF * g.ldb * 2;
    const size_t tA = 2 * hA, tB = 2 * hB;
    const unsigned ldsw = (unsigned)wid * 1024u;
    const int aoff = lds_byte(wr * 64 + fr, fq * 8), boff = lds_byte(wc * 32 + fr, fq * 8);
#define PG8_SA(b, h) (((b) * 2 + (h)) * HTB)
#define PG8_SB(b, h) ((4 + (b) * 2 + (h)) * HTB)
#define PG8_STAGE(bufoff, gbase, voff) do { _Pragma("unroll") for (int _i = 0; _i < 2; ++_i) \
        __builtin_amdgcn_global_load_lds((const unsigned*)((const char*)(gbase) + (voff)[_i]), (PG8_LAS unsigned*)(lds + (bufoff) + ldsw + _i * 8192), 16, 0, 0); } while (0)
#define PG8_LDA(dst, b, h) do { _Pragma("unroll") for (int m = 0; m < 4; ++m) _Pragma("unroll") for (int k = 0; k < 2; ++k) dst[m][k] = *(const PG8_LAS bf16x8*)(lds + PG8_SA(b, h) + aoff + m * 2048 + k * 1024); } while (0)
#define PG8_LDB(dst, b, h) do { _Pragma("unroll") for (int n = 0; n < 2; ++n) _Pragma("unroll") for (int k = 0; k < 2; ++k) dst[n][k] = *(const PG8_LAS bf16x8*)(lds + PG8_SB(b, h) + boff + n * 2048 + k * 1024); } while (0)
#define PG8_MMA(ai, bj, At, Bt) do { __builtin_amdgcn_s_setprio(1); _Pragma("unroll") for (int m = 0; m < 4; ++m) _Pragma("unroll") for (int n = 0; n < 2; ++n) _Pragma("unroll") for (int k = 0; k < 2; ++k) \
        acc[ai][bj][m][n] = __builtin_amdgcn_mfma_f32_16x16x32_bf16(Bt[n][k], At[m][k], acc[ai][bj][m][n], 0, 0, 0); __builtin_amdgcn_s_setprio(0); } while (0)
#define PG8_WAIT_V(n) asm volatile("s_waitcnt vmcnt(" #n ")" ::: "memory")
#define PG8_WAIT_L(n) asm volatile("s_waitcnt lgkmcnt(" #n ")" ::: "memory")
#define PG8_BAR __builtin_amdgcn_s_barrier()
#define PG8_SCHED __builtin_amdgcn_sched_barrier(0)
    Unit cur, nxt; int ui = 0;
    if (!S.next(0, cur)) return;
    f32x4 acc[2][2][4][2];
#pragma unroll
    for (int a = 0; a < 2; ++a)
#pragma unroll
        for (int b = 0; b < 2; ++b)
#pragma unroll
            for (int m = 0; m < 4; ++m)
#pragma unroll
                for (int n = 0; n < 2; ++n) acc[a][b][m][n] = (f32x4){0.f, 0.f, 0.f, 0.f};
    bf16x8 At[4][2], B0[2][2], B1[2][2];
    const char* cA = (const char*)g.A + (size_t)cur.pm * tA; const char* cB = (const char*)g.Bt + (size_t)cur.pn * tB;
    PG8_STAGE(PG8_SB(0, 0), cB, voffB); PG8_STAGE(PG8_SB(0, 1), cB + hB, voffB); PG8_STAGE(PG8_SA(0, 0), cA, voffA); PG8_STAGE(PG8_SA(0, 1), cA + hA, voffA);
    if (wr == 1) PG8_BAR;
    PG8_WAIT_V(2); PG8_BAR;
    PG8_STAGE(PG8_SB(1, 0), cB + kstep, voffB); PG8_STAGE(PG8_SA(1, 0), cA + kstep, voffA); PG8_STAGE(PG8_SB(1, 1), cB + hB + kstep, voffB);
    PG8_WAIT_V(6); PG8_BAR;
    for (;;) {
        const bool has_next = S.next(ui + 1, nxt);
        const char* nA = has_next ? (const char*)g.A + (size_t)nxt.pm * tA : cA; const char* nB = has_next ? (const char*)g.Bt + (size_t)nxt.pn * tB : cB;
        for (int t = 0; t < nt; t += 2) {
            const bool last = (t == nt - 2);
            const char* a1 = cA + (size_t)(t + 1) * kstep;
            const char* a2 = last ? nA : cA + (size_t)(t + 2) * kstep; const char* b2 = last ? nB : cB + (size_t)(t + 2) * kstep;
            const char* a3 = a2 + kstep; const char* b3 = b2 + kstep;
            PG8_LDB(B0, 0, 0); PG8_LDB(B1, 0, 1); PG8_SCHED; PG8_LDA(At, 0, 0); PG8_STAGE(PG8_SA(1, 1), a1 + hA, voffA);
            PG8_WAIT_V(8); PG8_WAIT_L(0); PG8_BAR; PG8_MMA(0, 0, At, B0); PG8_MMA(0, 1, At, B1); PG8_BAR; PG8_SCHED;
            PG8_LDA(At, 0, 1); PG8_STAGE(PG8_SB(0, 0), b2, voffB); PG8_STAGE(PG8_SB(0, 1), b2 + hB, voffB); PG8_STAGE(PG8_SA(0, 0), a2, voffA);
            PG8_WAIT_V(8); PG8_WAIT_L(0); PG8_BAR; PG8_MMA(1, 0, At, B0); PG8_MMA(1, 1, At, B1); PG8_BAR; PG8_SCHED;
            PG8_LDB(B0, 1, 0); PG8_LDB(B1, 1, 1); PG8_SCHED; PG8_LDA(At, 1, 0); PG8_STAGE(PG8_SA(0, 1), a2 + hA, voffA);
            PG8_WAIT_V(8); PG8_WAIT_L(0); PG8_BAR; PG8_MMA(0, 0, At, B0); PG8_MMA(0, 1, At, B1); PG8_BAR; PG8_SCHED;
            PG8_LDA(At, 1, 1); PG8_STAGE(PG8_SB(1, 0), b3, voffB); PG8_STAGE(PG8_SB(1, 1), b3 + hB, voffB); PG8_STAGE(PG8_SA(1, 0), a3, voffA);
            PG8_WAIT_V(8); PG8_WAIT_L(0); PG8_BAR; PG8_MMA(1, 0, At, B0); PG8_MMA(1, 1, At, B1); PG8_BAR; PG8_SCHED;
        }
        if constexpr (ALIGN_EPI) { if (wr == 0) PG8_BAR; }
        E(acc, cur, wr, wc, fr, fq);
        if (!has_next) break;
#pragma unroll
        for (int a = 0; a < 2; ++a)
#pragma unroll
            for (int b = 0; b < 2; ++b)
#pragma unroll
                for (int m = 0; m < 4; ++m)
#pragma unroll
                    for (int n = 0; n < 2; ++n) acc[a][b][m][n] = (f32x4){0.f, 0.f, 0.f, 0.f};
        cur = nxt; cA = nA; cB = nB; ++ui;
        if constexpr (ALIGN_EPI) { if (wr == 1) PG8_BAR; }
    }
    PG8_WAIT_V(0);
    if constexpr (!ALIGN_EPI) { if (wr == 0) PG8_BAR; }
    PG8_BAR;
#undef PG8_SA
#undef PG8_SB
#undef PG8_STAGE
#undef PG8_LDA
#undef PG8_LDB
#undef PG8_MMA
#undef PG8_WAIT_V
#undef PG8_WAIT_L
#undef PG8_BAR
#undef PG8_SCHED
}
}

namespace att {
typedef unsigned short bf16;
constexpr int D = 128, NW = 8, QBLK = 32, KVBLK = 64;
constexpr float SCALE = 0.088388347648318440f;
constexpr float THR = 8.f;
constexpr int LDQ = 1024, LDK = 256, LDO = 2048;
constexpr size_t SHM_V = KVBLK * D * 2, SHM_K = KVBLK * D * 2, SHM_ATTN = 2 * SHM_V + 2 * SHM_K + NW * 64 * 4;
using bf16x8 = __attribute__((ext_vector_type(8))) short;
using s16x4  = __attribute__((ext_vector_type(4))) short;
using f32x16 = __attribute__((ext_vector_type(16))) float;
using u32x4  = __attribute__((ext_vector_type(4))) unsigned;
#define KSWZ(row, colB) ((row) * 256 + ((colB) ^ (((row) & 7) << 4)))
#define SBAR() __builtin_amdgcn_sched_barrier(0)
__device__ __forceinline__ int crow(int r, int hi) { return (r & 3) + 8 * (r >> 2) + 4 * hi; }
__device__ __forceinline__ unsigned cvtpk(float lo, float hi) { unsigned r; asm volatile("v_cvt_pk_bf16_f32 %0, %1, %2" : "=v"(r) : "v"(lo), "v"(hi)); return r; }
__device__ __forceinline__ void partialSM(f32x16& p0, f32x16& p1, float& m_reg, float& mn, float& alpha) {
  constexpr float C = SCALE * 1.4426950408889634f;
  float pmax = p0[0]; for (int r = 1; r < 16; ++r) pmax = fmaxf(pmax, p0[r]); for (int r = 0; r < 16; ++r) pmax = fmaxf(pmax, p1[r]);
  { auto rr = __builtin_amdgcn_permlane32_swap(__float_as_uint(pmax), __float_as_uint(pmax), false, false);
    pmax = fmaxf(__uint_as_float(rr[0]), __uint_as_float(rr[1])); }
  if (__builtin_expect(__all(pmax - m_reg <= THR / SCALE), 1)) { mn = m_reg; alpha = 1.f; }
  else { mn = fmaxf(m_reg, pmax); alpha = __builtin_amdgcn_exp2f((m_reg - mn) * C); m_reg = mn; }
  float mnC = -mn * C;
  for (int r = 0; r < 16; ++r) p0[r] = fmaf(p0[r], C, mnC); for (int r = 0; r < 16; ++r) p1[r] = fmaf(p1[r], C, mnC);
  for (int r = 0; r < 16; ++r) p0[r] = __builtin_amdgcn_exp2f(p0[r]);
}
__device__ __forceinline__ void finishSM(f32x16& p0, f32x16& p1, float alpha, float& l_reg, bf16x8& pa0, bf16x8& pa1, bf16x8& pa2, bf16x8& pa3) {
  for (int r = 0; r < 16; ++r) p1[r] = __builtin_amdgcn_exp2f(p1[r]);
  float ps = 0; for (int r = 0; r < 16; ++r) ps += p0[r]; for (int r = 0; r < 16; ++r) ps += p1[r];
  { auto rr = __builtin_amdgcn_permlane32_swap(__float_as_uint(ps), __float_as_uint(ps), false, false);
    ps = __uint_as_float(rr[0]) + __uint_as_float(rr[1]); }
  l_reg = l_reg * alpha + ps;
#define PK4(P, BASE, OUT) do { unsigned a0 = cvtpk(P[BASE + 0], P[BASE + 1]), a1 = cvtpk(P[BASE + 2], P[BASE + 3]);   \
    unsigned b0 = cvtpk(P[BASE + 4], P[BASE + 5]), b1 = cvtpk(P[BASE + 6], P[BASE + 7]);                              \
    auto r0 = __builtin_amdgcn_permlane32_swap(a0, b0, false, false); auto r1 = __builtin_amdgcn_permlane32_swap(a1, b1, false, false); \
    u32x4 w = {r0[0], r1[0], r0[1], r1[1]}; OUT = *reinterpret_cast<bf16x8*>(&w); } while (0)
  PK4(p0, 0, pa0); PK4(p0, 8, pa1); PK4(p1, 0, pa2); PK4(p1, 8, pa3);
#undef PK4
}
__device__ __forceinline__ void qkt(f32x16& p0, f32x16& p1, const bf16* Ks, const bf16x8* qr, int r32, int hi) {
  p0 = f32x16{}; p1 = f32x16{};
  for (int d0 = 0; d0 < 8; ++d0) { int cb = (d0 * 16 + hi * 8) * 2;
    bf16x8 b0 = *reinterpret_cast<const bf16x8*>((const char*)Ks + KSWZ(r32, cb));
    bf16x8 b1 = *reinterpret_cast<const bf16x8*>((const char*)Ks + KSWZ(32 + r32, cb));
    p0 = __builtin_amdgcn_mfma_f32_32x32x16_bf16(b0, qr[d0], p0, 0, 0, 0);
    p1 = __builtin_amdgcn_mfma_f32_32x32x16_bf16(b1, qr[d0], p1, 0, 0, 0); }
}
__device__ __forceinline__ int v_st(int k, int c) { const int kk = (k & ~0xC) | ((k & 4) << 1) | ((k & 8) >> 1); return ((kk >> 3) * 4 + (c >> 5)) * 512 + ((kk & 7) * 32 + (c & 31)) * 2; }
__device__ __forceinline__ int v_rd_base(int lane) { return ((lane & 3) << 3) | (((lane >> 2) & 3) << 6) | (((lane >> 4) & 1) << 5) | (((lane >> 5) & 1) << 8); }
constexpr int v_rd_off(int d0, int ks, int half) { return d0 * 512 + ks * 4096 + half * 2048; }
template <int OFF> __device__ __forceinline__ s16x4 tr_read(int vb) {
  s16x4 r; asm volatile("ds_read_b64_tr_b16 %0, %1 offset:%2" : "=&v"(r) : "v"(vb), "i"(OFF) : "memory"); return r;
}
template <int D0> __device__ __forceinline__ void pv_one(f32x16& od, int vb, bf16x8 pa0, bf16x8 pa1, bf16x8 pa2, bf16x8 pa3) {
  const s16x4 l0 = tr_read<v_rd_off(D0, 0, 0)>(vb), h0 = tr_read<v_rd_off(D0, 0, 1)>(vb), l1 = tr_read<v_rd_off(D0, 1, 0)>(vb), h1 = tr_read<v_rd_off(D0, 1, 1)>(vb);
  const s16x4 l2 = tr_read<v_rd_off(D0, 2, 0)>(vb), h2 = tr_read<v_rd_off(D0, 2, 1)>(vb), l3 = tr_read<v_rd_off(D0, 3, 0)>(vb), h3 = tr_read<v_rd_off(D0, 3, 1)>(vb);
  asm volatile("s_waitcnt lgkmcnt(0)" ::: "memory"); SBAR();
#define PK(L, H) (bf16x8){L[0], L[1], L[2], L[3], H[0], H[1], H[2], H[3]}
  od = __builtin_amdgcn_mfma_f32_32x32x16_bf16(pa0, PK(l0, h0), od, 0, 0, 0);
  od = __builtin_amdgcn_mfma_f32_32x32x16_bf16(pa1, PK(l1, h1), od, 0, 0, 0);
  od = __builtin_amdgcn_mfma_f32_32x32x16_bf16(pa2, PK(l2, h2), od, 0, 0, 0);
  od = __builtin_amdgcn_mfma_f32_32x32x16_bf16(pa3, PK(l3, h3), od, 0, 0, 0);
#undef PK
}
__device__ __forceinline__ void pv_d0(f32x16* o, int vb, bf16x8 pa0, bf16x8 pa1, bf16x8 pa2, bf16x8 pa3) {
  pv_one<0>(o[0], vb, pa0, pa1, pa2, pa3); pv_one<1>(o[1], vb, pa0, pa1, pa2, pa3); pv_one<2>(o[2], vb, pa0, pa1, pa2, pa3); pv_one<3>(o[3], vb, pa0, pa1, pa2, pa3);
}
__device__ __forceinline__ void attn_dense_body(const bf16* __restrict__ Qb, const bf16* __restrict__ Kh, const bf16* __restrict__ Vh, bf16* __restrict__ Ob, int seq, char* lds, const int tid) {
  const int wid = tid >> 6, lane = tid & 63, r32 = lane & 31, hi = lane >> 5;
  bf16* V_lds = (bf16*)lds; bf16* K_lds = (bf16*)(lds + 2 * SHM_V);
  float* ws = (float*)(lds + 2 * SHM_V + 2 * SHM_K) + wid * 64; float* li_l = ws; float* al_l = ws + 32;
  float m_reg = -1e30f, l_reg = 0; f32x16 o[4] = {}; bf16x8 qr[8];
  const bf16* Qw = Qb + (long)(wid * QBLK + r32) * LDQ + hi * 8;
#pragma unroll
  for (int d0 = 0; d0 < 8; ++d0) qr[d0] = *reinterpret_cast<const bf16x8*>(Qw + d0 * 16);
  const int sr = tid >> 4, sc = (tid & 15) * 8, vst0 = v_st(sr, sc), vst1 = v_st(32 + sr, sc);
  const int vb0 = (int)(uintptr_t)V_lds + v_rd_base(lane);
  struct { bf16x8 vs0, vs1, ks0, ks1; } sr_[2];
#define LD8(p) (*reinterpret_cast<const bf16x8*>(p))
#define SLOAD(i, k0) do { sr_[i].vs0 = LD8(&Vh[(long)((k0) + sr) * LDK + sc]); sr_[i].vs1 = LD8(&Vh[(long)((k0) + 32 + sr) * LDK + sc]); \
    sr_[i].ks0 = LD8(&Kh[(long)((k0) + sr) * LDK + sc]); sr_[i].ks1 = LD8(&Kh[(long)((k0) + 32 + sr) * LDK + sc]); } while (0)
#define SWRITE(b, i) do { *(bf16x8*)((char*)V_lds + (b) * SHM_V + vst0) = sr_[i].vs0;          \
    *(bf16x8*)((char*)V_lds + (b) * SHM_V + vst1) = sr_[i].vs1; int kc = sc * 2;               \
    *(bf16x8*)((char*)K_lds + (b) * SHM_K + KSWZ(sr, kc)) = sr_[i].ks0;                       \
    *(bf16x8*)((char*)K_lds + (b) * SHM_K + KSWZ(32 + sr, kc)) = sr_[i].ks1; } while (0)
#define SWAIT() asm volatile("s_waitcnt vmcnt(4)" ::: "memory")
#define RESC(a) do { if (__any((a) < 1.f)) { if (hi == 0) al_l[r32] = (a); asm volatile("s_waitcnt lgkmcnt(0)" ::: "memory"); \
    for (int d = 0; d < 4; ++d) for (int r = 0; r < 16; ++r) o[d][r] *= al_l[crow(r, hi)]; } } while (0)
  f32x16 pA0, pA1, pB0, pB1; float mnA, mnB, alA, alB; bf16x8 pa0, pa1, pa2, pa3; const int NT = seq / KVBLK;
  constexpr int SE = 0, SO = 1;
  SLOAD(SE, 0); asm volatile("s_waitcnt vmcnt(0)" ::: "memory"); SWRITE(0, SE); __syncthreads();
  qkt(pA0, pA1, K_lds, qr, r32, hi); partialSM(pA0, pA1, m_reg, mnA, alA);
  SLOAD(SO, KVBLK); if (2 < NT) SLOAD(SE, 2 * KVBLK);
  SWAIT(); SWRITE(1, SO); __syncthreads();
  for (int j = 1; j + 1 < NT; j += 2) {
    SBAR(); qkt(pB0, pB1, (bf16*)((char*)K_lds + SHM_K), qr, r32, hi);
    finishSM(pA0, pA1, alA, l_reg, pa0, pa1, pa2, pa3); SBAR();
    SLOAD(SO, (j + 2) * KVBLK); SBAR();
    pv_d0(o, vb0, pa0, pa1, pa2, pa3); partialSM(pB0, pB1, m_reg, mnB, alB);
    __syncthreads(); SWAIT(); SWRITE(0, SE);
    RESC(alB); __syncthreads();
    SBAR(); qkt(pA0, pA1, K_lds, qr, r32, hi);
    finishSM(pB0, pB1, alB, l_reg, pa0, pa1, pa2, pa3); SBAR();
    if (j + 3 < NT) SLOAD(SE, (j + 3) * KVBLK); SBAR();
    pv_d0(o, vb0 + (int)SHM_V, pa0, pa1, pa2, pa3); partialSM(pA0, pA1, m_reg, mnA, alA);
    __syncthreads(); SWAIT(); SWRITE(1, SO);
    RESC(alA); __syncthreads();
  }
  SBAR(); qkt(pB0, pB1, (bf16*)((char*)K_lds + SHM_K), qr, r32, hi);
  finishSM(pA0, pA1, alA, l_reg, pa0, pa1, pa2, pa3); SBAR();
  pv_d0(o, vb0, pa0, pa1, pa2, pa3); partialSM(pB0, pB1, m_reg, mnB, alB);
  __syncthreads(); RESC(alB);
  finishSM(pB0, pB1, alB, l_reg, pa0, pa1, pa2, pa3); SBAR();
  pv_d0(o, vb0 + (int)SHM_V, pa0, pa1, pa2, pa3);
  if (hi == 0) li_l[r32] = l_reg; asm volatile("s_waitcnt lgkmcnt(0)" ::: "memory");
  float rli[16];
#pragma unroll
  for (int r = 0; r < 16; ++r) rli[r] = __builtin_amdgcn_rcpf(li_l[crow(r, hi)]);
  bf16* Ow = Ob + (long)(wid * QBLK) * LDO;
#pragma unroll
  for (int r = 0; r < 16; ++r) { int orow = crow(r, hi);
#pragma unroll
    for (int d0 = 0; d0 < 4; d0 += 1) { const unsigned w = cvtpk(o[d0][r] * rli[r], 0.f); Ow[(long)orow * LDO + d0 * 32 + r32] = (bf16)(w & 0xffffu); } }
  __syncthreads();
#undef LD8
#undef SLOAD
#undef SWRITE
#undef SWAIT
#undef RESC
}
}

constexpr int NWAVES = 8;
constexpr int N_LAUNCHES = MK_N_LAUNCHES;
constexpr int N_PHASES = 15;
constexpr int DM = 2048, NB = 4, T = 4096, LC = 256, M = NB * T, MC = NB * LC, SKV = LC + T;
constexpr int NE = 16, FFD = 2048, CAP = 512;
constexpr float EPS = 1e-6f;

constexpr size_t MiB = 1u << 20;
constexpr size_t WS_CTL = 0, CTL_ZERO_BYTES = 1 * MiB;
constexpr size_t WS_ROPE = 1 * MiB;
constexpr size_t WS_MOD = WS_ROPE + 64 * 1024;
constexpr size_t WS_AFF = 2 * MiB;
constexpr size_t WS_ROWIDX = 3 * MiB;
constexpr size_t WS_TOPW = WS_ROWIDX + 256 * 1024;
constexpr size_t WS_INV = 4 * MiB;
constexpr size_t WS_MODP = 5 * MiB;
constexpr size_t WS_WIN = 8 * MiB;
constexpr size_t WS_WOA = 42 * MiB, WS_WOR = 46 * MiB, WS_WOUT = 50 * MiB;
constexpr size_t WS_WGU = 58 * MiB;
constexpr size_t WS_WDN = 314 * MiB;
constexpr size_t WS_H = 442 * MiB;
constexpr size_t WS_QA = 510 * MiB, WS_QR = 542 * MiB, WS_GR = 558 * MiB, WS_GATE = 590 * MiB;
constexpr size_t WS_KA = 718 * MiB, WS_VA = WS_KA + (size_t)NB * SKV * 256 * 2, WS_KR = 735 * MiB, WS_VR = 752 * MiB;
constexpr size_t WS_ACT = 510 * MiB, WS_YEXP = 638 * MiB;
constexpr size_t WS_U = 786 * MiB;
constexpr size_t WS_ST = 854 * MiB;
constexpr size_t WS_YO = 786 * MiB;
constexpr size_t WS_Y = 854 * MiB;
constexpr size_t WS_XG = 786 * MiB;
constexpr size_t WS_O = 918 * MiB;
constexpr size_t WS_END = 982 * MiB;
static_assert(WS_VA + (size_t)NB * SKV * 256 * 2 <= WS_KR && WS_KR + (size_t)NB * SKV * 512 * 2 <= WS_VR && WS_VR + (size_t)NB * SKV * 1024 * 2 <= WS_U, "z map");
static_assert(WS_XG + (size_t)32768 * 2048 * 2 <= WS_O, "xg map");
constexpr int CW_TMO = 0, CW_CODE = 1, CW_BAR = 4096;

constexpr int RING_OFF = 0, RING_BYTES = 131072;
constexpr int SCRATCH_BYTES = 155648;
constexpr int LDSCTL_OFF = SCRATCH_BYTES, MISC_OFF = LDSCTL_OFF + 320;
constexpr int LDS_BYTES = 156672;
static_assert(MISC_OFF + 128 <= LDS_BYTES, "LDS map");

#define GAS __attribute__((address_space(1)))
#define LAS __attribute__((address_space(3)))
typedef unsigned short bf16;
typedef unsigned v4u __attribute__((ext_vector_type(4)));
typedef unsigned v2u __attribute__((ext_vector_type(2)));
typedef float f32x4 __attribute__((ext_vector_type(4)));
typedef GAS unsigned gu32;
#define RLX_AGENT __ATOMIC_RELAXED, __HIP_MEMORY_SCOPE_AGENT
#define LDS_WAIT() asm volatile("s_waitcnt lgkmcnt(0)" ::: "memory")
#define VM_WAIT() asm volatile("s_waitcnt vmcnt(0)" ::: "memory")
__device__ __forceinline__ unsigned pk2(float lo, float hi) { return pg8::cvt_pk_bf16(lo, hi); }
__device__ __forceinline__ float bflo(unsigned w) { return __uint_as_float(w << 16); }
__device__ __forceinline__ float bfhi(unsigned w) { return __uint_as_float(w & 0xffff0000u); }
__device__ __forceinline__ float bf1(bf16 b) { return __uint_as_float(((unsigned)b) << 16); }
__device__ __forceinline__ float siluf_(float x) { return x / (1.0f + __expf(-x)); }

#define XB_TMO      128
#define XB_XCNT(j)  (256  + 64 * (j))
#define XB_XSUB(j)  (1280 + 64 * (j))
#define XB_XGEN(j)  (2304 + 64 * (j))
#define XB_TOP      3328
#define XB_TOPGEN   3392
#define XCD_BAR_WORDS 3456
#define XB_SPIN_CAP (1u << 18)
__device__ __forceinline__ unsigned xb_ld(unsigned* p)              { return __hip_atomic_load(p, __ATOMIC_RELAXED, __HIP_MEMORY_SCOPE_AGENT); }
__device__ __forceinline__ unsigned xb_add(unsigned* p, unsigned v) { return __hip_atomic_fetch_add(p, v, __ATOMIC_RELAXED, __HIP_MEMORY_SCOPE_AGENT); }
__device__ __forceinline__ unsigned xb_xcc_id() { return (unsigned)__builtin_amdgcn_s_getreg((3 << 11) | 20) & 0xFu; }
#define XB_SPIN(cond, bar) do { unsigned _sp = 0; while (cond) { __builtin_amdgcn_s_sleep(1); \
    if ((++_sp & 255u) == 0u) { if (xb_ld(&(bar)[XB_TMO])) break; if (_sp > XB_SPIN_CAP) { atomicAdd(&(bar)[XB_TMO], 1u); break; } } } } while (0)
struct XcdBarrier { unsigned* bar; unsigned x; volatile LAS unsigned* st; };
__device__ __forceinline__ XcdBarrier xcd_barrier_post(unsigned* bar, volatile LAS unsigned* st) {
    XcdBarrier b; b.bar = bar; b.x = xb_xcc_id(); b.st = st;
    if (threadIdx.x == 0) (void)xb_add(&bar[XB_XCNT(b.x)], 1u);
    return b;
}
__device__ __forceinline__ void xcd_barrier_complete(unsigned* bar, unsigned x, unsigned& nloc, unsigned& nx) {
    const unsigned G = gridDim.x * gridDim.y * gridDim.z;
    unsigned sum, cnt, mine, sp = 0u;
    for (;;) {
        sum = 0u; cnt = 0u; mine = 0u;
#pragma unroll
        for (unsigned j = 0; j < 16; ++j) { const unsigned c = xb_ld(&bar[XB_XCNT(j)]); sum += c; cnt += (c > 0u) ? 1u : 0u; mine = (j == x) ? c : mine; }
        if (sum == G) break;
        __builtin_amdgcn_s_sleep(1);
        if ((++sp & 255u) == 0u) { if (xb_ld(&bar[XB_TMO])) break; if (sp > XB_SPIN_CAP) { atomicAdd(&bar[XB_TMO], 1u); break; } }
    }
    nloc = mine > 0u ? mine : 1u; nx = cnt > 0u ? cnt : 1u;
}
__device__ __forceinline__ void xcd_barrier(const XcdBarrier& b) {
    asm volatile("s_waitcnt vmcnt(0)" ::: "memory");
    __syncthreads();
    if (threadIdx.x == 0) {
        unsigned* bar = b.bar;
        __builtin_amdgcn_s_waitcnt(0);
        unsigned nloc = b.st[0], nx = b.st[1];
        if (nloc == 0u) { xcd_barrier_complete(bar, b.x, nloc, nx); b.st[0] = nloc; b.st[1] = nx; }
        const unsigned old = xb_add(&bar[XB_XSUB(b.x)], 1u);
        const unsigned gen = old / nloc;
        if (old + 1u == (gen + 1u) * nloc) {
            __builtin_amdgcn_fence(__ATOMIC_RELEASE, "agent");
            asm volatile("s_waitcnt vmcnt(0)" ::: "memory");
            const unsigned og = xb_add(&bar[XB_TOP], 1u);
            const unsigned tg = og / nx;
            if (og + 1u == (tg + 1u) * nx) xb_add(&bar[XB_TOPGEN], 1u);
            else XB_SPIN(xb_ld(&bar[XB_TOPGEN]) == tg, bar);
            __builtin_amdgcn_fence(__ATOMIC_ACQUIRE, "agent");
            xb_add(&bar[XB_XGEN(b.x)], 1u);
            asm volatile("s_waitcnt vmcnt(0)" ::: "memory");
        } else {
            XB_SPIN(xb_ld(&bar[XB_XGEN(b.x)]) == gen, bar);
            __builtin_amdgcn_fence(__ATOMIC_ACQUIRE, "agent");
            asm volatile("s_waitcnt vmcnt(0)" ::: "memory");
        }
    }
    __syncthreads();
}

struct Frame {
    LAS unsigned char* lds;
    volatile LAS unsigned* MISC;
    gu32* ctl;
    int tid, lane, wave;
    int vcu, G;
    float* out; unsigned char* ws;
};
enum { I_X = 0, I_C, I_CTX, I_CCTX, I_WMOD, I_BMOD, I_PRE1, I_POST1, I_PRE2, I_POST2, I_WIN, I_QN, I_KN, I_DECAY, I_GN, I_WOA, I_WOR, I_WOUT, I_WR, I_WG, I_WU, I_WD };
__device__ __forceinline__ const float* inp(const Frame& F, int k) {
    const unsigned long long v = ((const LAS unsigned long long*)(F.lds + LDSCTL_OFF))[k];
    const unsigned lo = __builtin_amdgcn_readfirstlane((unsigned)v), hi = __builtin_amdgcn_readfirstlane((unsigned)(v >> 32));
    return (const float*)(const GAS float*)(((unsigned long long)hi << 32) | lo);
}

__device__ __forceinline__ float wave_sum(float v) {
#pragma unroll
    for (int o = 1; o < 64; o <<= 1) v += __shfl_xor(v, o);
    return v;
}

__device__ __forceinline__ void p0_transpose_item(const float* W, int ldw, int k0, int n0, bf16* WT, int ldt, int drow0, LAS float* scr, int lane) {
#pragma unroll 8
    for (int i = 0; i < 32; ++i) { const int kk = 2 * i + (lane >> 5); scr[kk * 33 + (lane & 31)] = W[(size_t)(k0 + kk) * ldw + n0 + (lane & 31)]; }
    LDS_WAIT(); asm volatile("" ::: "memory");
    const int c = lane & 7;
#pragma unroll
    for (int j = 0; j < 4; ++j) { const int n = (lane >> 3) + 8 * j; const LAS float* s = scr + (8 * c) * 33 + n;
        v4u o; o.x = pk2(s[0 * 33], s[1 * 33]); o.y = pk2(s[2 * 33], s[3 * 33]); o.z = pk2(s[4 * 33], s[5 * 33]); o.w = pk2(s[6 * 33], s[7 * 33]);
        *(GAS v4u*)(WT + (size_t)(drow0 + n) * ldt + k0 + 8 * c) = o; }
    LDS_WAIT(); asm volatile("" ::: "memory");
}
__device__ __forceinline__ void p0_prologue(Frame& F) {
    unsigned char* ws = F.ws;
    {
        LAS float* sl = (LAS float*)(F.lds);
        LAS float* red = (LAS float*)(F.lds + 40960);
        for (int i = F.tid; i < 5 * 2048; i += 512) { const int b = i >> 11, k = i & 2047; const float v = b < 4 ? inp(F, I_C)[b * 2048 + k] : inp(F, I_CCTX)[k]; sl[i] = siluf_(v); }
        __syncthreads();
        const int kg = F.tid >> 7, c4 = F.tid & 127;
        for (int u = F.vcu; u < 192; u += F.G) {
            const int kc = u / 24, nc = u % 24;
            f32x4 a0 = {0, 0, 0, 0}, a1 = a0, a2 = a0, a3 = a0, a4 = a0;
            const float* wp = inp(F, I_WMOD) + (size_t)(256 * kc + kg) * 12288 + 512 * nc + 4 * c4;
#pragma unroll 8
            for (int kk = 0; kk < 64; ++kk) {
                const f32x4 w = *(const f32x4*)(wp + (size_t)(4 * kk) * 12288); const int k = 256 * kc + 4 * kk + kg;
                a0 += w * sl[k]; a1 += w * sl[2048 + k]; a2 += w * sl[4096 + k]; a3 += w * sl[6144 + k]; a4 += w * sl[8192 + k];
            }
            *(LAS f32x4*)(red + (kg * 5 + 0) * 512 + 4 * c4) = a0; *(LAS f32x4*)(red + (kg * 5 + 1) * 512 + 4 * c4) = a1; *(LAS f32x4*)(red + (kg * 5 + 2) * 512 + 4 * c4) = a2;
            *(LAS f32x4*)(red + (kg * 5 + 3) * 512 + 4 * c4) = a3; *(LAS f32x4*)(red + (kg * 5 + 4) * 512 + 4 * c4) = a4;
            __syncthreads();
            float* mp = (float*)(ws + WS_MODP) + (size_t)kc * 5 * 12288 + 512 * nc;
            for (int i = F.tid; i < 5 * 512; i += 512) { const int b = i >> 9, n = i & 511; mp[b * 12288 + n] = red[(0 * 5 + b) * 512 + n] + red[(1 * 5 + b) * 512 + n] + red[(2 * 5 + b) * 512 + n] + red[(3 * 5 + b) * 512 + n]; }
            __syncthreads();
        }
    }
    if (F.vcu == F.G - 1) {
        float* tab = (float*)(ws + WS_ROPE);
        for (int i = F.tid; i < 64 * 32; i += 512) { const int p = i >> 5, j = i & 31; const float inv = powf(10000.0f, -(float)j / 32.0f); const float ang = (float)p * inv; tab[2 * i] = cosf(ang); tab[2 * i + 1] = sinf(ang); }
    }
    LAS float* scr = (LAS float*)(F.lds + 81920 + F.wave * 8704);
    const int gw = F.vcu * NWAVES + F.wave, NGW = F.G * NWAVES;
    constexpr int I_IN = 32 * 272, I_OA = 16 * 64, I_OUT = 32 * 64, I_EX = 16 * 2048;
    constexpr int NITEMS = I_IN + 2 * I_OA + I_OUT + 3 * I_EX;
    for (int it = gw; it < NITEMS; it += NGW) {
        int r = it;
        if (r < I_IN) { const int kb = r / 272, nb = r % 272; p0_transpose_item(inp(F, I_WIN), 8704, 64 * kb, 32 * nb, (bf16*)(ws + WS_WIN), 2048, 32 * nb, scr, F.lane); continue; } r -= I_IN;
        if (r < I_OA) { const int kb = r / 64, nb = r % 64; p0_transpose_item(inp(F, I_WOA), 2048, 64 * kb, 32 * nb, (bf16*)(ws + WS_WOA), 1024, 32 * nb, scr, F.lane); continue; } r -= I_OA;
        if (r < I_OA) { const int kb = r / 64, nb = r % 64; p0_transpose_item(inp(F, I_WOR), 2048, 64 * kb, 32 * nb, (bf16*)(ws + WS_WOR), 1024, 32 * nb, scr, F.lane); continue; } r -= I_OA;
        if (r < I_OUT) { const int kb = r / 64, nb = r % 64; p0_transpose_item(inp(F, I_WOUT), 2048, 64 * kb, 32 * nb, (bf16*)(ws + WS_WOUT), 2048, 32 * nb, scr, F.lane); continue; } r -= I_OUT;
        if (r < 2 * I_EX) { const int up = r >= I_EX; if (up) r -= I_EX; const int e = r >> 11, q = r & 2047, kb = q / 64, nb = q % 64, n0 = 32 * nb;
            p0_transpose_item(inp(F, up ? I_WU : I_WG) + (size_t)e * 2048 * 2048, 2048, 64 * kb, n0, (bf16*)(ws + WS_WGU), 2048, e * 4096 + (n0 >> 7) * 256 + up * 128 + (n0 & 127), scr, F.lane); continue; } r -= 2 * I_EX;
        { const int e = r >> 11, q = r & 2047, kb = q / 64, nb = q % 64; p0_transpose_item(inp(F, I_WD) + (size_t)e * 2048 * 2048, 2048, 64 * kb, 32 * nb, (bf16*)(ws + WS_WDN), 2048, e * 2048 + 32 * nb, scr, F.lane); }
    }
}

__device__ __forceinline__ float mod_val(const Frame& F, int b, int n) {
    const float* mp = (const float*)(F.ws + WS_MODP) + (size_t)b * 12288 + n; float s = inp(F, I_BMOD)[n];
#pragma unroll
    for (int kc = 0; kc < 8; ++kc) s += mp[(size_t)kc * 5 * 12288];
    return s;
}
__device__ __forceinline__ void rms_mod_row(const float* xrow, bf16* orow, const LAS float* A, const LAS float* Bv, int lane) {
    const f32x4* xr = (const f32x4*)xrow + lane; f32x4 v[8]; float s = 0.f;
#pragma unroll
    for (int j = 0; j < 8; ++j) { v[j] = xr[64 * j]; s += (v[j].x * v[j].x + v[j].y * v[j].y) + (v[j].z * v[j].z + v[j].w * v[j].w); }
    const float r = 1.0f / sqrtf(wave_sum(s) * (1.0f / DM) + EPS);
    v2u* o8 = (v2u*)orow + lane;
#pragma unroll
    for (int j = 0; j < 8; ++j) { const f32x4 a = *(const LAS f32x4*)(A + 4 * (64 * j + lane)), b = *(const LAS f32x4*)(Bv + 4 * (64 * j + lane)); const f32x4 h = v[j] * r * a + b;
        v2u w; w.x = pk2(h.x, h.y); w.y = pk2(h.z, h.w); o8[64 * j] = w; }
}
__device__ __forceinline__ void p1_h(Frame& F) {
    LAS float* A = (LAS float*)F.lds; LAS float* Bv = A + 2048; LAS float* Ac = A + 4096; LAS float* Bc = A + 6144;
    const int b = F.vcu & 3, sub = F.vcu >> 2, nsub = F.G >> 2;
    for (int k = F.tid; k < 2048; k += 512) { const float g = inp(F, I_PRE1)[k];
        A[k] = g * (1.0f + mod_val(F, b, 2048 + k)); Bv[k] = mod_val(F, b, k); Ac[k] = g * (1.0f + mod_val(F, 4, 2048 + k)); Bc[k] = mod_val(F, 4, k); }
    float* MOD = (float*)(F.ws + WS_MOD);
    for (int i = F.vcu * 512 + F.tid; i < 5 * 12288; i += F.G * 512) MOD[i] = mod_val(F, i / 12288, i % 12288);
    __syncthreads();
    bf16* H = (bf16*)(F.ws + WS_H);
    for (int t = sub * NWAVES + F.wave; t < T; t += nsub * NWAVES) { const size_t m = (size_t)b * T + t; rms_mod_row(inp(F, I_X) + m * DM, H + m * DM, A, Bv, F.lane); }
    for (int r = F.vcu * NWAVES + F.wave; r < MC; r += F.G * NWAVES) rms_mod_row(inp(F, I_CTX) + (size_t)r * DM, H + (size_t)(M + r) * DM, Ac, Bc, F.lane);
}

__device__ __forceinline__ void head_op(bf16* hp, int c, bool active, bool do_norm, const float* g, bool do_scale, bool do_rope, int prow, int pcol, const float* tab) {
    v4u raw = {0u, 0u, 0u, 0u}; if (active) raw = *(const v4u*)(hp + 8 * c);
    float v[8] = {bflo(raw.x), bfhi(raw.x), bflo(raw.y), bfhi(raw.y), bflo(raw.z), bfhi(raw.z), bflo(raw.w), bfhi(raw.w)};
    float ss = 0.f;
#pragma unroll
    for (int i = 0; i < 8; ++i) ss += v[i] * v[i];
    ss += __shfl_xor(ss, 1); ss += __shfl_xor(ss, 2); ss += __shfl_xor(ss, 4); ss += __shfl_xor(ss, 8);
    const float r = 1.0f / sqrtf(ss * (1.0f / 128.0f) + EPS);
#pragma unroll
    for (int i = 0; i < 8; ++i) { float x = v[i]; if (do_norm) x = x * r * g[8 * c + i]; if (do_scale) x *= 0.08838834764831845f; v[i] = x; }
    const int a = c >> 3, p = (c >> 2) & 1, jb = (c & 3) * 8, pos = a ? pcol : prow;
#pragma unroll
    for (int i = 0; i < 8; ++i) { const float pv = __shfl_xor(v[i], 4);
        if (do_rope) { const float cs = tab[(pos * 32 + jb + i) * 2], sn = tab[(pos * 32 + jb + i) * 2 + 1]; v[i] = p ? (v[i] * cs + pv * sn) : (v[i] * cs - pv * sn); } }
    if (active) { v4u o; o.x = pk2(v[0], v[1]); o.y = pk2(v[2], v[3]); o.z = pk2(v[4], v[5]); o.w = pk2(v[6], v[7]); *(v4u*)(hp + 8 * c) = o; }
}
__device__ __forceinline__ void p3_rope(Frame& F) {
    unsigned char* ws = F.ws; const float* tab = (const float*)(ws + WS_ROPE);
    const int gw = F.vcu * NWAVES + F.wave, NGW = F.G * NWAVES, grp = F.lane >> 4, c = F.lane & 15;
    for (int m = gw; m < M; m += NGW) {
        const int b = m >> 12, t = m & 4095, prow = t >> 6, pcol = t & 63; const size_t kvrow = (size_t)b * SKV + LC + t;
#pragma unroll
        for (int s = 0; s < 5; ++s) {
            const int slot = 4 * s + grp; const bool active = slot < 18;
            bf16* hp; bool do_norm = false, do_scale = false; const float* g = inp(F, I_QN);
            if (slot < 8) { hp = (bf16*)(ws + WS_QA) + (size_t)m * 1024 + slot * 128; do_norm = true; }
            else if (slot < 12) { hp = (bf16*)(ws + WS_QR) + (size_t)m * 512 + (slot - 8) * 128; }
            else if (slot < 14) { hp = (bf16*)(ws + WS_KA) + kvrow * 256 + (slot - 12) * 128; do_norm = true; g = inp(F, I_KN); }
            else { hp = (bf16*)(ws + WS_KR) + kvrow * 512 + ((slot - 14) & 3) * 128; do_scale = true; }
            head_op(hp, c, active, do_norm, g, do_scale, true, prow, pcol, tab);
        }
    }
    for (int r = gw; r < MC; r += NGW) {
        const int b = r >> 8, l = r & 255; const size_t kvrow = (size_t)b * SKV + l;
#pragma unroll
        for (int s = 0; s < 2; ++s) {
            const int slot = 4 * s + grp; const bool active = slot < 6;
            bf16* hp; bool do_norm = false, do_scale = false;
            if (slot < 2) { hp = (bf16*)(ws + WS_KA) + kvrow * 256 + slot * 128; do_norm = true; }
            else { hp = (bf16*)(ws + WS_KR) + kvrow * 512 + ((slot - 2) & 3) * 128; do_scale = true; }
            head_op(hp, c, active, do_norm, inp(F, I_KN), do_scale, false, 0, 0, tab);
        }
    }
}

__device__ __forceinline__ float softplusf_(float x) { return x > 20.f ? x : log1pf(expf(x)); }
__device__ __forceinline__ float log_gamma(const Frame& F, int dir, int h) { return -softplusf_(inp(F, I_DECAY)[dir * 4 + h]); }

__device__ __forceinline__ void p4_chunk_states(Frame& F) {
    unsigned char* ws = F.ws;
    LAS bf16* Ks = (LAS bf16*)F.lds;
    LAS bf16* Vs = (LAS bf16*)(F.lds + 32768);
    for (int u = F.vcu; u < NB * 4 * 34; u += F.G) {
        int tid = F.tid; asm volatile("" : "+v"(tid));
        const int td = tid & 15, tv = tid >> 4;
        const int cidx = u % 34, h = (u / 34) & 3, b = u / (34 * 4);
        const float lgf = log_gamma(F, 0, h), lgb = log_gamma(F, 1, h);
        const size_t row0 = (size_t)b * SKV + 128 * cidx;
        const bf16* Kg = (const bf16*)(ws + WS_KR) + row0 * 512 + h * 128; const bf16* Vg = (const bf16*)(ws + WS_VR) + row0 * 1024 + h * 256;
        for (int i = tid; i < 128 * 16; i += 512) { const int j = i >> 4, cc = i & 15; *(LAS v4u*)(Ks + j * 128 + 8 * cc) = *(const v4u*)(Kg + (size_t)j * 512 + 8 * cc); }
        for (int i = tid; i < 128 * 32; i += 512) { const int j = i >> 5, cc = i & 31; *(LAS v4u*)(Vs + j * 256 + 8 * cc) = *(const v4u*)(Vg + (size_t)j * 1024 + 8 * cc); }
        __syncthreads();
        float af[8][8], ab[8][8];
#pragma unroll
        for (int x = 0; x < 8; ++x)
#pragma unroll
            for (int y = 0; y < 8; ++y) { af[x][y] = 0.f; ab[x][y] = 0.f; }
        for (int j = 0; j < 128; ++j) {
            const v4u kr = *(const LAS v4u*)(Ks + j * 128 + 8 * td), vr = *(const LAS v4u*)(Vs + j * 256 + 8 * tv);
            const float wf = __expf(lgf * (float)(127 - j)), wb = __expf(lgb * (float)j);
            const float kk[8] = {bflo(kr.x), bfhi(kr.x), bflo(kr.y), bfhi(kr.y), bflo(kr.z), bfhi(kr.z), bflo(kr.w), bfhi(kr.w)};
            const float vv[8] = {bflo(vr.x), bfhi(vr.x), bflo(vr.y), bfhi(vr.y), bflo(vr.z), bfhi(vr.z), bflo(vr.w), bfhi(vr.w)};
#pragma unroll
            for (int x = 0; x < 8; ++x) { const float vf = vv[x] * wf, vbk = vv[x] * wb;
#pragma unroll
                for (int y = 0; y < 8; ++y) { af[x][y] += vf * kk[y]; ab[x][y] += vbk * kk[y]; } }
        }
        bf16* Uf = (bf16*)(ws + WS_U) + ((((size_t)(b * 4 + h) * 2 + 0) * 34 + cidx) * 256) * 128; bf16* Ub = Uf + (size_t)34 * 256 * 128;
#pragma unroll
        for (int x = 0; x < 8; ++x) { v4u o; o.x = pk2(af[x][0], af[x][1]); o.y = pk2(af[x][2], af[x][3]); o.z = pk2(af[x][4], af[x][5]); o.w = pk2(af[x][6], af[x][7]); *(v4u*)(Uf + (size_t)(8 * tv + x) * 128 + 8 * td) = o;
            o.x = pk2(ab[x][0], ab[x][1]); o.y = pk2(ab[x][2], ab[x][3]); o.z = pk2(ab[x][4], ab[x][5]); o.w = pk2(ab[x][6], ab[x][7]); *(v4u*)(Ub + (size_t)(8 * tv + x) * 128 + 8 * td) = o; }
        __syncthreads();
    }
}
__device__ __forceinline__ void p5_scan(Frame& F) {
    unsigned char* ws = F.ws;
    for (int it = F.vcu * 512 + F.tid; it < 32 * 4096; it += F.G * 512) {
        const int e8 = it & 4095, bhd = it >> 12, dir = bhd & 1, h = (bhd >> 1) & 3;
        const float g = __expf(128.0f * log_gamma(F, dir, h));
        const bf16* U = (const bf16*)(ws + WS_U) + (size_t)bhd * 34 * 32768 + 8 * e8; bf16* ST = (bf16*)(ws + WS_ST) + (size_t)bhd * 32 * 32768 + 8 * e8;
        float s[8];
#pragma unroll
        for (int i = 0; i < 8; ++i) s[i] = 0.f;
        for (int stp = 0; stp < 34; ++stp) {
            const int cidx = dir == 0 ? stp : (stp < 2 ? 1 - stp : 35 - stp);
            if (stp >= 2) { v4u o; o.x = pk2(s[0], s[1]); o.y = pk2(s[2], s[3]); o.z = pk2(s[4], s[5]); o.w = pk2(s[6], s[7]); *(v4u*)(ST + (size_t)(cidx - 2) * 32768) = o; }
            const v4u ur = *(const v4u*)(U + (size_t)cidx * 32768);
            const float uu[8] = {bflo(ur.x), bfhi(ur.x), bflo(ur.y), bfhi(ur.y), bflo(ur.z), bfhi(ur.z), bflo(ur.w), bfhi(ur.w)};
#pragma unroll
            for (int i = 0; i < 8; ++i) s[i] = g * s[i] + uu[i];
        }
    }
}
__device__ __forceinline__ void p5_attention(Frame& F, char* lds_generic) {
    unsigned char* ws = F.ws;
    for (int u = F.vcu; u < NB * 8 * 16; u += F.G) {
        const int qb = u & 15, hq = (u >> 4) & 7, b = u >> 7, kvh = hq >> 2;
        const bf16* Q = (const bf16*)(ws + WS_QA) + ((size_t)b * T + qb * 256) * 1024 + hq * 128;
        const bf16* K = (const bf16*)(ws + WS_KA) + (size_t)b * SKV * 256 + kvh * 128; const bf16* V = (const bf16*)(ws + WS_VA) + (size_t)b * SKV * 256 + kvh * 128;
        bf16* O = (bf16*)(ws + WS_O) + ((size_t)b * T + qb * 256) * 2048 + hq * 128;
        att::attn_dense_body(Q, K, V, O, SKV, lds_generic, F.tid);
    }
}
__device__ __forceinline__ void p6_ret_out(Frame& F) {
    unsigned char* ws = F.ws;
    LAS bf16* QT = (LAS bf16*)F.lds;
    LAS float* PT = (LAS float*)(F.lds + 32768);
    LAS bf16* KT = (LAS bf16*)(F.lds + 98304);
    LAS float* RS = (LAS float*)(F.lds + 98304);
    for (int u = F.vcu; u < NB * 4 * 32; u += F.G) {
        int tid = F.tid; asm volatile("" : "+v"(tid));
        const int n = u & 31, h = (u >> 5) & 3, b = u >> 7;
        const float lgf = log_gamma(F, 0, h), lgb = log_gamma(F, 1, h);
        const size_t qrow0 = (size_t)b * T + 128 * n, krow0 = (size_t)b * SKV + LC + 128 * n;
        const bf16* Qg = (const bf16*)(ws + WS_QR) + qrow0 * 512 + h * 128; const bf16* Kg = (const bf16*)(ws + WS_KR) + krow0 * 512 + h * 128;
        const bf16* Vg = (const bf16*)(ws + WS_VR) + krow0 * 1024 + h * 256;
        for (int i = tid; i < 128 * 16; i += 512) { const int r = i & 127, cc = i >> 7;
            const v4u q = *(const v4u*)(Qg + (size_t)r * 512 + 8 * cc), k = *(const v4u*)(Kg + (size_t)r * 512 + 8 * cc);
            const unsigned qq[4] = {q.x, q.y, q.z, q.w}, kk[4] = {k.x, k.y, k.z, k.w};
#pragma unroll
            for (int x = 0; x < 4; ++x) { QT[(8 * cc + 2 * x) * 128 + r] = (bf16)(qq[x] & 0xffffu); QT[(8 * cc + 2 * x + 1) * 128 + r] = (bf16)(qq[x] >> 16);
                KT[(8 * cc + 2 * x) * 128 + r] = (bf16)(kk[x] & 0xffffu); KT[(8 * cc + 2 * x + 1) * 128 + r] = (bf16)(kk[x] >> 16); } }
        __syncthreads();
        {
            const int ti = tid & 31, tj = tid >> 5;
            float s[4][8];
#pragma unroll
            for (int x = 0; x < 4; ++x)
#pragma unroll
                for (int y = 0; y < 8; ++y) s[x][y] = 0.f;
            for (int d = 0; d < 128; ++d) {
                const v2u qr = *(const LAS v2u*)(QT + d * 128 + 4 * ti); const v4u kr = *(const LAS v4u*)(KT + d * 128 + 8 * tj);
                const float qv[4] = {bflo(qr.x), bfhi(qr.x), bflo(qr.y), bfhi(qr.y)};
                const float kv[8] = {bflo(kr.x), bfhi(kr.x), bflo(kr.y), bfhi(kr.y), bflo(kr.z), bfhi(kr.z), bflo(kr.w), bfhi(kr.w)};
#pragma unroll
                for (int x = 0; x < 4; ++x)
#pragma unroll
                    for (int y = 0; y < 8; ++y) s[x][y] += qv[x] * kv[y];
                __builtin_amdgcn_sched_barrier(0);
            }
#pragma unroll
            for (int y = 0; y < 8; ++y) { const int j = 8 * tj + y; f32x4 o;
#pragma unroll
                for (int x = 0; x < 4; ++x) { const int i = 4 * ti + x; const float w = i > j ? __expf(lgf * (float)(i - j)) : (i < j ? __expf(lgb * (float)(j - i)) : 2.0f); o[x] = s[x][y] * w; }
                *(LAS f32x4*)(PT + j * 128 + 4 * ti) = o; }
        }
        __syncthreads();
        {
            const int i2 = (tid & 63) * 2;
            const float f0 = __expf(lgf * (float)(i2 + 1)), f1 = __expf(lgf * (float)(i2 + 2)), b0 = __expf(lgb * (float)(128 - i2)), b1 = __expf(lgb * (float)(127 - i2));
            for (int d = tid >> 6; d < 128; d += 8) { const unsigned w = *(const LAS unsigned*)(QT + d * 128 + i2); const float q0 = bflo(w), q1 = bfhi(w);
                *(LAS unsigned*)(QT + d * 128 + i2) = pk2(q0 * f0, q1 * f1); *(LAS unsigned*)(KT + d * 128 + i2) = pk2(q0 * b0, q1 * b1); }
        }
        __syncthreads();
        const int ib = tid & 15, vb = tid >> 4;
        float o[8][8];
#pragma unroll
        for (int x = 0; x < 8; ++x)
#pragma unroll
            for (int y = 0; y < 8; ++y) o[x][y] = 0.f;
#pragma unroll 2
        for (int j = 0; j < 128; ++j) {
            const f32x4 p0 = *(const LAS f32x4*)(PT + j * 128 + 8 * ib), p1 = *(const LAS f32x4*)(PT + j * 128 + 8 * ib + 4);
            const v4u vr = *(const v4u*)(Vg + (size_t)j * 1024 + 8 * vb);
            const float pv[8] = {p0[0], p0[1], p0[2], p0[3], p1[0], p1[1], p1[2], p1[3]};
            const float vv[8] = {bflo(vr.x), bfhi(vr.x), bflo(vr.y), bfhi(vr.y), bflo(vr.z), bfhi(vr.z), bflo(vr.w), bfhi(vr.w)};
#pragma unroll
            for (int x = 0; x < 8; ++x)
#pragma unroll
                for (int y = 0; y < 8; ++y) o[x][y] += pv[x] * vv[y];
        }
        LAS bf16* STt = (LAS bf16*)(F.lds + 32768);
#pragma unroll 1
        for (int dir = 0; dir < 2; ++dir) {
            __syncthreads();
            const bf16* STg = (const bf16*)(ws + WS_ST) + ((((size_t)(b * 4 + h) * 2 + dir) * 32 + n) * 256) * 128;
            for (int i = tid; i < 256 * 16; i += 512) { const int v = i >> 4, cc = i & 15; const v4u w = *(const v4u*)(STg + (size_t)v * 128 + 8 * cc);
                const unsigned ww[4] = {w.x, w.y, w.z, w.w};
#pragma unroll
                for (int x = 0; x < 4; ++x) { STt[(8 * cc + 2 * x) * 256 + v] = (bf16)(ww[x] & 0xffffu); STt[(8 * cc + 2 * x + 1) * 256 + v] = (bf16)(ww[x] >> 16); } }
            __syncthreads();
            const LAS bf16* QS = dir == 0 ? QT : KT;
#pragma unroll 2
            for (int d = 0; d < 128; ++d) {
                const v4u qr = *(const LAS v4u*)(QS + d * 128 + 8 * ib), sr = *(const LAS v4u*)(STt + d * 256 + 8 * vb);
                const float qv[8] = {bflo(qr.x), bfhi(qr.x), bflo(qr.y), bfhi(qr.y), bflo(qr.z), bfhi(qr.z), bflo(qr.w), bfhi(qr.w)};
                const float sv[8] = {bflo(sr.x), bfhi(sr.x), bflo(sr.y), bfhi(sr.y), bflo(sr.z), bfhi(sr.z), bflo(sr.w), bfhi(sr.w)};
#pragma unroll
                for (int x = 0; x < 8; ++x)
#pragma unroll
                    for (int y = 0; y < 8; ++y) o[x][y] += qv[x] * sv[y];
            }
        }
        __syncthreads();
#pragma unroll
        for (int x = 0; x < 8; ++x) { float s1 = 0.f, s2 = 0.f;
#pragma unroll
            for (int y = 0; y < 8; ++y) { s1 += o[x][y]; s2 += o[x][y] * o[x][y]; }
            RS[((8 * ib + x) * 32 + vb) * 2] = s1; RS[((8 * ib + x) * 32 + vb) * 2 + 1] = s2; }
        __syncthreads();
        const float* gn = inp(F, I_GN) + h * 256 + 8 * vb;
        float gnv[8];
#pragma unroll
        for (int y = 0; y < 8; ++y) gnv[y] = gn[y];
#pragma unroll
        for (int x = 0; x < 8; ++x) { const int i = 8 * ib + x; float s1 = 0.f, s2 = 0.f;
            for (int q = 0; q < 32; ++q) { s1 += RS[(i * 32 + q) * 2]; s2 += RS[(i * 32 + q) * 2 + 1]; }
            const float mu = s1 * (1.0f / 256.0f); const float var = fmaxf(s2 * (1.0f / 256.0f) - mu * mu, 0.f); const float rstd = 1.0f / sqrtf(var + EPS);
            const v4u gr = *(const v4u*)((const bf16*)(ws + WS_GR) + (qrow0 + i) * 1024 + h * 256 + 8 * vb);
            const float gg[8] = {bflo(gr.x), bfhi(gr.x), bflo(gr.y), bfhi(gr.y), bflo(gr.z), bfhi(gr.z), bflo(gr.w), bfhi(gr.w)};
            float y8[8];
#pragma unroll
            for (int y = 0; y < 8; ++y) y8[y] = (o[x][y] - mu) * rstd * gnv[y] * siluf_(gg[y]);
            v4u w; w.x = pk2(y8[0], y8[1]); w.y = pk2(y8[2], y8[3]); w.z = pk2(y8[4], y8[5]); w.w = pk2(y8[6], y8[7]);
            *(v4u*)((bf16*)(ws + WS_O) + (qrow0 + i) * 2048 + 1024 + h * 256 + 8 * vb) = w;
            __builtin_amdgcn_sched_barrier(0); }
        __syncthreads();
    }
}

__device__ __forceinline__ void p10_norm_router(Frame& F) {
    unsigned char* ws = F.ws;
    LAS float* WRT = (LAS float*)F.lds;
    LAS float* C1 = (LAS float*)(F.lds + 131072); LAS float* A2 = C1 + 2048; LAS float* B2 = C1 + 4096;
    const int b = F.vcu & 3, sub = F.vcu >> 2, nsub = F.G >> 2;
    const float* MOD = (const float*)(ws + WS_MOD) + (size_t)b * 12288;
    for (int i = F.tid; i < 2048 * 16; i += 512) { const int k = i >> 4, e = i & 15; WRT[e * 2048 + k] = inp(F, I_WR)[i]; }
    for (int k = F.tid; k < 2048; k += 512) { C1[k] = MOD[4096 + k] * inp(F, I_POST1)[k]; A2[k] = inp(F, I_PRE2)[k] * (1.0f + MOD[8192 + k]); B2[k] = MOD[6144 + k]; }
    __syncthreads();
    const bf16* YO = (const bf16*)(ws + WS_YO); bf16* H2 = (bf16*)(ws + WS_H); float* AFF = (float*)(ws + WS_AFF);
    const int lane = F.lane;
    for (int t = sub * NWAVES + F.wave; t < T; t += nsub * NWAVES) {
        const size_t m = (size_t)b * T + t;
        const f32x4* xr = (const f32x4*)(inp(F, I_X) + m * DM) + lane; const v2u* yr = (const v2u*)(YO + m * DM) + lane;
        f32x4 xv[8], yv[8]; float s = 0.f;
#pragma unroll
        for (int j = 0; j < 8; ++j) { xv[j] = xr[64 * j]; const v2u w = yr[64 * j]; yv[j] = (f32x4){bflo(w.x), bfhi(w.x), bflo(w.y), bfhi(w.y)};
            s += (yv[j].x * yv[j].x + yv[j].y * yv[j].y) + (yv[j].z * yv[j].z + yv[j].w * yv[j].w); }
        const float r1 = 1.0f / sqrtf(wave_sum(s) * (1.0f / DM) + EPS);
        f32x4* orow = (f32x4*)(F.out + m * DM) + lane; float s2 = 0.f;
#pragma unroll
        for (int j = 0; j < 8; ++j) { const f32x4 c1 = *(const LAS f32x4*)(C1 + 4 * (64 * j + lane)); xv[j] = xv[j] + c1 * (yv[j] * r1); orow[64 * j] = xv[j];
            s2 += (xv[j].x * xv[j].x + xv[j].y * xv[j].y) + (xv[j].z * xv[j].z + xv[j].w * xv[j].w); }
        const float r2 = 1.0f / sqrtf(wave_sum(s2) * (1.0f / DM) + EPS);
        v2u* hrow = (v2u*)(H2 + m * DM) + lane;
#pragma unroll
        for (int j = 0; j < 8; ++j) { const f32x4 a2 = *(const LAS f32x4*)(A2 + 4 * (64 * j + lane)), b2 = *(const LAS f32x4*)(B2 + 4 * (64 * j + lane)); xv[j] = xv[j] * r2 * a2 + b2;
            v2u w; w.x = pk2(xv[j].x, xv[j].y); w.y = pk2(xv[j].z, xv[j].w); hrow[64 * j] = w; }
        float lg[16];
#pragma unroll
        for (int e = 0; e < 16; ++e) { float a = 0.f;
#pragma unroll
            for (int j = 0; j < 8; ++j) { const f32x4 w = *(const LAS f32x4*)(WRT + e * 2048 + 4 * (64 * j + lane)); a += (xv[j].x * w.x + xv[j].y * w.y) + (xv[j].z * w.z + xv[j].w * w.w); }
            lg[e] = wave_sum(a); }
        float mx = lg[0];
#pragma unroll
        for (int e = 1; e < 16; ++e) mx = fmaxf(mx, lg[e]);
        float den = 0.f;
#pragma unroll
        for (int e = 0; e < 16; ++e) { lg[e] = expf(lg[e] - mx); den += lg[e]; }
        float mine = 0.f;
#pragma unroll
        for (int e = 0; e < 16; ++e) mine = (lane == e) ? lg[e] : mine;
        if (lane < 16) AFF[((size_t)b * 16 + lane) * T + t] = mine / den;
    }
}

__device__ __forceinline__ void p11_topk(Frame& F) {
    unsigned char* ws = F.ws;
    LAS unsigned* hist = (LAS unsigned*)F.lds;
    LAS unsigned* bc = hist + 256;
    LAS unsigned* wtot = hist + 272;
    LAS int* selrow = (LAS int*)(F.lds + 4096);
    const int tid = F.tid, lane = F.lane, wave = F.wave;
    for (int u = F.vcu; u < NB * NE; u += F.G) {
        const int b = u >> 4, e = u & 15;
        const float* aff = (const float*)(ws + WS_AFF) + ((size_t)b * 16 + e) * T;
        const f32x4 v0 = *(const f32x4*)(aff + 8 * tid), v1 = *(const f32x4*)(aff + 8 * tid + 4);
        const float val[8] = {v0[0], v0[1], v0[2], v0[3], v1[0], v1[1], v1[2], v1[3]};
        unsigned key[8];
#pragma unroll
        for (int i = 0; i < 8; ++i) key[i] = __float_as_uint(val[i]);
        unsigned prefix = 0u, kth = CAP;
#pragma unroll 1
        for (int pass = 0; pass < 4; ++pass) {
            const int shift = 24 - 8 * pass;
            if (tid < 256) hist[tid] = 0u;
            __syncthreads();
#pragma unroll
            for (int i = 0; i < 8; ++i) { const bool in = pass == 0 ? true : ((key[i] >> (shift + 8)) == prefix); if (in) atomicAdd((unsigned*)&hist[(key[i] >> shift) & 255u], 1u); }
            __syncthreads();
            if (tid == 0) { unsigned cum = 0u; int bin = 255; for (; bin > 0; --bin) { const unsigned hcnt = hist[bin]; if (cum + hcnt >= kth) break; cum += hcnt; } bc[0] = (prefix << 8) | (unsigned)bin; bc[1] = kth - cum; }
            __syncthreads();
            prefix = bc[0]; kth = bc[1];
            __syncthreads();
        }
        const unsigned thr = prefix, need = kth;
        unsigned ng = 0u, neq = 0u;
#pragma unroll
        for (int i = 0; i < 8; ++i) { ng += key[i] > thr ? 1u : 0u; neq += key[i] == thr ? 1u : 0u; }
        unsigned sg = ng, se = neq;
#pragma unroll
        for (int o = 1; o < 64; o <<= 1) { const unsigned a = __shfl_up(sg, o), c = __shfl_up(se, o); if (lane >= o) { sg += a; se += c; } }
        if (lane == 63) { wtot[wave * 2] = sg; wtot[wave * 2 + 1] = se; }
        __syncthreads();
        unsigned bg = sg - ng, be = se - neq;
        for (int w = 0; w < wave; ++w) { bg += wtot[w * 2]; be += wtot[w * 2 + 1]; }
        int* rowidx = (int*)(ws + WS_ROWIDX) + e * 2048 + b * CAP; float* topw = (float*)(ws + WS_TOPW) + e * 2048 + b * CAP; int* inv = (int*)(ws + WS_INV);
#pragma unroll
        for (int i = 0; i < 8; ++i) {
            const int t = 8 * tid + i; const bool gt = key[i] > thr, eq = key[i] == thr; const bool sel = gt || (eq && be < need);
            const unsigned slot = bg + (be < need ? be : need);
            if (sel) { rowidx[slot] = b * T + t; topw[slot] = val[i]; selrow[slot] = t; }
            inv[((size_t)b * T + t) * 16 + e] = sel ? (int)(e * 2048 + b * CAP + slot) : -1;
            bg += gt ? 1u : 0u; be += eq ? 1u : 0u;
        }
        __syncthreads();
        const bf16* H2 = (const bf16*)(ws + WS_H); bf16* XG = (bf16*)(ws + WS_XG);
        for (int s = wave; s < CAP; s += NWAVES) {
            const v4u* src = (const v4u*)(H2 + ((size_t)b * T + selrow[s]) * DM) + lane; v4u* dst = (v4u*)(XG + ((size_t)e * 2048 + b * CAP + s) * DM) + lane;
#pragma unroll
            for (int j = 0; j < 4; ++j) dst[64 * j] = src[64 * j];
        }
        __syncthreads();
    }
}

__device__ __forceinline__ void p14_final(Frame& F) {
    unsigned char* ws = F.ws;
    LAS float* C2 = (LAS float*)F.lds;
    const int b = F.vcu & 3, sub = F.vcu >> 2, nsub = F.G >> 2;
    const float* MOD = (const float*)(ws + WS_MOD) + (size_t)b * 12288;
    for (int k = F.tid; k < 2048; k += 512) C2[k] = MOD[10240 + k] * inp(F, I_POST2)[k];
    __syncthreads();
    const bf16* YEXP = (const bf16*)(ws + WS_YEXP); const int* inv = (const int*)(ws + WS_INV); const int lane = F.lane;
    for (int t = sub * NWAVES + F.wave; t < T; t += nsub * NWAVES) {
        const size_t m = (size_t)b * T + t;
        f32x4 acc[8];
#pragma unroll
        for (int j = 0; j < 8; ++j) acc[j] = (f32x4){0.f, 0.f, 0.f, 0.f};
        for (int e = 0; e < 16; ++e) {
            const int slot = __builtin_amdgcn_readfirstlane(inv[m * 16 + e]);
            if (slot >= 0) { const v2u* yr = (const v2u*)(YEXP + (size_t)slot * DM) + lane;
#pragma unroll
                for (int j = 0; j < 8; ++j) { const v2u w = yr[64 * j]; acc[j] += (f32x4){bflo(w.x), bfhi(w.x), bflo(w.y), bfhi(w.y)}; } }
        }
        float s = 0.f;
#pragma unroll
        for (int j = 0; j < 8; ++j) s += (acc[j].x * acc[j].x + acc[j].y * acc[j].y) + (acc[j].z * acc[j].z + acc[j].w * acc[j].w);
        const float r = 1.0f / sqrtf(wave_sum(s) * (1.0f / DM) + EPS);
        f32x4* orow = (f32x4*)(F.out + m * DM) + lane;
#pragma unroll
        for (int j = 0; j < 8; ++j) { const f32x4 c2 = *(const LAS f32x4*)(C2 + 4 * (64 * j + lane)); orow[64 * j] = orow[64 * j] + c2 * (acc[j] * r); }
    }
}

struct Args { const float* in[22]; float* out; unsigned char* ws; int ph_lo, ph_hi; };
__global__ void __launch_bounds__(NWAVES * 64, 2) fwd(Args args) {
    extern __shared__ __attribute__((aligned(16))) unsigned char lds[];
    Frame F;
    F.lds = (LAS unsigned char*)lds;
    F.MISC = (volatile LAS unsigned*)(F.lds + MISC_OFF);
    F.tid = threadIdx.x; F.lane = F.tid & 63; F.wave = __builtin_amdgcn_readfirstlane(F.tid >> 6);
    F.G = gridDim.x; { const int bx = blockIdx.x; F.vcu = (F.G % 8 == 0) ? (bx % 8) * (F.G / 8) + bx / 8 : bx; }
    unsigned char* ws = args.ws; F.ws = ws; F.out = args.out;
    F.ctl = (gu32*)(ws + WS_CTL);
    for (int u = F.tid; u < (LDS_BYTES - LDSCTL_OFF) / 4; u += NWAVES * 64) ((LAS unsigned*)(F.lds + LDSCTL_OFF))[u] = 0u;
    __syncthreads();
    if (F.tid < 22) ((LAS unsigned long long*)(F.lds + LDSCTL_OFF))[F.tid] = (unsigned long long)(uintptr_t)args.in[F.tid];
    __syncthreads();
    XcdBarrier bar; bar.bar = (unsigned*)(F.ctl + CW_BAR); bar.x = 0; bar.st = nullptr;
    if (N_LAUNCHES != N_PHASES) bar = xcd_barrier_post((unsigned*)(F.ctl + CW_BAR), F.MISC + 8);
#define GRID_BAR(seam) do { if (N_LAUNCHES == N_PHASES) { if (F.tid == 0) __hip_atomic_store(F.ctl + CW_TMO, 0xBADBA0u | (unsigned)(seam), RLX_AGENT); } else { xcd_barrier(bar); } } while (0)
    const int lo = args.ph_lo, hi = args.ph_hi;
#ifndef PH_MASK
#define PH_MASK 0x7fff
#endif
#define IN(k) (((PH_MASK >> (k)) & 1) && lo <= (k) && (k) < hi)
#define BOTH(k) (IN(k) && IN((k) + 1))
#define FRESH() do { asm volatile("" : "+v"(F.tid)); F.lane = F.tid & 63; F.wave = __builtin_amdgcn_readfirstlane(F.tid >> 6); asm volatile("" : "+s"(F.vcu), "+s"(F.G)); } while (0)

    if (IN(0)) { FRESH(); p0_prologue(F); if (BOTH(0)) GRID_BAR(0); }
    if (IN(1)) { FRESH(); p1_h(F); if (BOTH(1)) GRID_BAR(1); }
    if (IN(2)) { FRESH();
        pg8::Gemm g{(const bf16*)(ws + WS_H), (const bf16*)(ws + WS_WIN), 2048, 2048, 2048}; pg8::InProjOrder S; S.init(F.G, (int)blockIdx.x);
        pg8::EpiZ E{(bf16*)(ws + WS_QA), (bf16*)(ws + WS_QR), (bf16*)(ws + WS_GR), (bf16*)(ws + WS_GATE), (bf16*)(ws + WS_KA), (bf16*)(ws + WS_VA), (bf16*)(ws + WS_KR), (bf16*)(ws + WS_VR)};
        pg8::gemm_phase<pg8::EpiZ, pg8::InProjOrder, true>(F.lds + RING_OFF, g, S, E, F.tid);
        if (BOTH(2)) GRID_BAR(2);
    }
    if (IN(3)) { FRESH(); p3_rope(F); if (BOTH(3)) GRID_BAR(3); }
    if (IN(4)) { FRESH(); p4_chunk_states(F); if (BOTH(4)) GRID_BAR(4); }
    if (IN(5)) { FRESH(); p5_scan(F); p5_attention(F, (char*)lds); if (BOTH(5)) GRID_BAR(5); }
    if (IN(6)) { FRESH(); p6_ret_out(F); if (BOTH(6)) GRID_BAR(6); }
    if (IN(7)) { FRESH();
        pg8::Gemm g{(const bf16*)(ws + WS_O), (const bf16*)(ws + WS_WOA), 2048, 1024, 1024}; pg8::StaticOrder S; S.init(M, DM, F.G, (int)blockIdx.x);
        pg8::EpiGate<false> E{(bf16*)(ws + WS_Y), (const bf16*)(ws + WS_GATE), 0};
        pg8::gemm_phase<pg8::EpiGate<false>, pg8::StaticOrder, true>(F.lds + RING_OFF, g, S, E, F.tid);
        if (BOTH(7)) GRID_BAR(7);
    }
    if (IN(8)) { FRESH();
        pg8::Gemm g{(const bf16*)(ws + WS_O) + 1024, (const bf16*)(ws + WS_WOR), 2048, 1024, 1024}; pg8::StaticOrder S; S.init(M, DM, F.G, (int)blockIdx.x);
        pg8::EpiGate<true> E{(bf16*)(ws + WS_Y), (const bf16*)(ws + WS_GATE), 2048};
        pg8::gemm_phase<pg8::EpiGate<true>, pg8::StaticOrder, true>(F.lds + RING_OFF, g, S, E, F.tid);
        if (BOTH(8)) GRID_BAR(8);
    }
    if (IN(9)) { FRESH();
        pg8::Gemm g{(const bf16*)(ws + WS_Y), (const bf16*)(ws + WS_WOUT), 2048, 2048, 2048}; pg8::StaticOrder S; S.init(M, DM, F.G, (int)blockIdx.x);
        pg8::EpiPlain E{(bf16*)(ws + WS_YO), 2048};
        pg8::gemm_phase<pg8::EpiPlain, pg8::StaticOrder, true>(F.lds + RING_OFF, g, S, E, F.tid);
        if (BOTH(9)) GRID_BAR(9);
    }
    if (IN(10)) { FRESH(); p10_norm_router(F); if (BOTH(10)) GRID_BAR(10); }
    if (IN(11)) { FRESH(); p11_topk(F); if (BOTH(11)) GRID_BAR(11); }
    if (IN(12)) { FRESH();
        pg8::Gemm g{(const bf16*)(ws + WS_XG), (const bf16*)(ws + WS_WGU), 2048, 2048, 2048}; pg8::ExpertOrder S; S.init(NE, 8, 16, F.G, (int)blockIdx.x);
        pg8::EpiSwiGLU E{(bf16*)(ws + WS_ACT)};
        pg8::gemm_phase<pg8::EpiSwiGLU, pg8::ExpertOrder, true>(F.lds + RING_OFF, g, S, E, F.tid);
        if (BOTH(12)) GRID_BAR(12);
    }
    if (IN(13)) { FRESH();
        pg8::Gemm g{(const bf16*)(ws + WS_ACT), (const bf16*)(ws + WS_WDN), 2048, 2048, 2048}; pg8::ExpertOrder S; S.init(NE, 8, 8, F.G, (int)blockIdx.x);
        pg8::EpiDown E{(bf16*)(ws + WS_YEXP), (const float*)(ws + WS_TOPW)};
        pg8::gemm_phase<pg8::EpiDown, pg8::ExpertOrder, true>(F.lds + RING_OFF, g, S, E, F.tid);
        if (BOTH(13)) GRID_BAR(13);
    }
    if (IN(14)) { FRESH(); p14_final(F); }
#undef IN
#undef BOTH
}

extern "C" void kernel_launch(void* const* d_in, const int* in_sizes, int n_in, void* d_out, int out_size, void* d_ws, size_t ws_size, hipStream_t stream) {
    static int grid = 0;
    if (grid == 0) {
        if (n_in != 22 || out_size != M * DM || ws_size < WS_END) { fprintf(stderr, "kernel_launch: unexpected shapes: n_in %d out %d ws %zu (need %zu)\n", n_in, out_size, ws_size, (size_t)WS_END); grid = -1; return; }
        int dev = 0, cus = 0, per_cu = 0;
        if (hipGetDevice(&dev) != hipSuccess || hipDeviceGetAttribute(&cus, hipDeviceAttributeMultiprocessorCount, dev) != hipSuccess) { grid = -1; return; }
        if (hipFuncSetAttribute((const void*)fwd, hipFuncAttributeMaxDynamicSharedMemorySize, LDS_BYTES) != hipSuccess) { fprintf(stderr, "kernel_launch: hipFuncSetAttribute failed\n"); grid = -1; return; }
        if (hipOccupancyMaxActiveBlocksPerMultiprocessor(&per_cu, (const void*)fwd, NWAVES * 64, LDS_BYTES) != hipSuccess || per_cu < 1) fprintf(stderr, "kernel_launch: occupancy query reports %d\n", per_cu);
        (void)hipGetLastError();
        grid = cus - (cus % 8);
        if (grid < 8) grid = 8;
    }
    if (grid < 0) return;
    if (hipMemsetAsync((char*)d_ws + WS_CTL, 0, CTL_ZERO_BYTES, stream) != hipSuccess) return;
    Args a{};
    for (int i = 0; i < 22; ++i) a.in[i] = (const float*)d_in[i];
    a.out = (float*)d_out; a.ws = (unsigned char*)d_ws;
    if (N_LAUNCHES == 1) { a.ph_lo = 0; a.ph_hi = N_PHASES; hipLaunchKernelGGL(fwd, dim3(grid), dim3(NWAVES * 64), LDS_BYTES, stream, a); }
    else for (int p = 0; p < N_PHASES; ++p) { a.ph_lo = p; a.ph_hi = p + 1; hipLaunchKernelGGL(fwd, dim3(grid), dim3(NWAVES * 64), LDS_BYTES, stream, a); }
    const hipError_t le = hipPeekAtLastError();
    if (le != hipSuccess) fprintf(stderr, "kernel_launch: launch failed: %s\n", hipGetErrorName(le));
}
```

```cpp
#include <hip/hip_runtime.h>
#include <cstdio>
#include <cstdint>

#ifndef FUSE_ROPE
#define FUSE_ROPE 1
#endif
#ifndef RET_VALU
#define RET_VALU 0
#endif
#ifndef MK_N_LAUNCHES
#define MK_N_LAUNCHES 1
#endif

namespace pg8 {
#define PG8_LAS __attribute__((address_space(3)))
typedef unsigned short bf16_t;
typedef short bf16x8 __attribute__((ext_vector_type(8)));
typedef float f32x4 __attribute__((ext_vector_type(4)));
typedef unsigned u32x4 __attribute__((ext_vector_type(4)));
constexpr int BM = 256, BK = 64, HALF = 128, HTB = HALF * BK * 2, STAGE_BYTES = 8 * HTB, NXCD = 8, WGM = 8;

__host__ __device__ __forceinline__ int lds_byte(int r, int c) { const int st = (r >> 4) * 2 + (c >> 5), rr = r & 15, cc = c & 31, ob = rr * 64 + cc * 2; return st * 1024 + (ob ^ (((ob >> 9) & 1) << 5)); }
__host__ __device__ __forceinline__ void stage_rc(int b, int& R, int& C) { const int st = b / 1024, sb = b % 1024, swz = sb ^ (((sb >> 9) & 1) << 5); R = (st >> 1) * 16 + swz / 64; C = (st & 1) * 32 + (swz % 64) / 2; }
__host__ __device__ __forceinline__ int perm32(int rho) { const int n = rho >> 4, i = rho & 15; return 8 * (i >> 2) + 4 * n + (i & 3); }

struct Unit { int pm, pn; };
struct Gemm { const bf16_t* A; const bf16_t* Bt; int lda, ldb, K; const int* ridx; int scaleA, scaleB; };

struct StaticOrder {
    int nM, nN, nwg, G, c;
    __host__ __device__ void init(int M, int N, int G_, int c_) { nM = M / BM; nN = N / BM; nwg = nM * nN; G = G_; c = c_; }
    __host__ __device__ bool next(int i, Unit& u) const {
        const long L = (long)i * G + c; if (L >= nwg) return false;
        int wgid = (int)L; { const int q = nwg / NXCD, r = nwg % NXCD, xcd = wgid % NXCD, off = wgid / NXCD; wgid = (xcd < r ? xcd * (q + 1) : r * (q + 1) + (xcd - r) * q) + off; }
        const int nig = WGM * nN, gid = wgid / nig, fm = gid * WGM, gsz = (nM - fm) < WGM ? (nM - fm) : WGM;
        u.pm = fm + ((wgid % nig) % gsz); u.pn = (wgid % nig) / gsz; return true;
    }
};
struct InProjOrder {
    StaticOrder so; int G, c;
    __host__ __device__ void init(int G_, int c_) { so.init(16384, 8704, G_, c_); G = G_; c = c_; }
    __host__ __device__ bool unit_of(long L, Unit& u) const {
        if (L < so.nwg) { StaticOrder t = so; t.G = 1; t.c = 0; return t.next((int)L, u); }
        const int r = (int)(L - so.nwg); if (r >= 32) return false;
        u.pm = 64 + (r >> 3); u.pn = 26 + (r & 7); return true;
    }
    __host__ __device__ bool next(int i, Unit& u) const { return unit_of((long)i * G + c, u); }
};
struct InProjDynOrder {
    static constexpr bool DYNAMIC = true;
    StaticOrder so; unsigned* ctr; int x, mode, total;
    __device__ void init(int c_, unsigned* ctr_, int mode_) { mode = mode_; so.init(16384, mode_ ? 4096 : 4608, 1, 0); x = c_ & 7; ctr = ctr_ + 64 * x; total = so.nwg + (mode_ ? 0 : 32); }
    __device__ __forceinline__ int pull() const { return (int)__hip_atomic_fetch_add(ctr, 1u, __ATOMIC_RELAXED, __HIP_MEMORY_SCOPE_AGENT); }
    __device__ __forceinline__ bool unit(int q, Unit& u) const {
        const long L = (long)q * 8 + x; if (L >= total) return false;
        if (L < so.nwg) { so.next((int)L, u); if (mode == 0 && u.pn >= 10) u.pn += 16; return true; }
        const int r = (int)(L - so.nwg); u.pm = 64 + (r >> 3); u.pn = 26 + (r & 7); return true;
    }
};
struct ExpertOrder {
    int nPm, nPn, per, total, G, c;
    __host__ __device__ void init(int nE, int nPm_, int nPn_, int G_, int c_) { nPm = nPm_; nPn = nPn_; per = nPm * nPn; total = nE * per; G = G_; c = c_; }
    __host__ __device__ bool next(int i, Unit& u) const {
        const long L = (long)i * G + c; if (L >= total) return false;
        if (G == 256 && nPm == 8 && (nPn == 16 || nPn == 8)) {
            const int x = c & 7, j = c >> 3, npx = per / 8  , e = i * (32 / npx) + j / npx, s = j % npx;
            u.pm = e * nPm + (x & 1) * 4 + (s & 3); u.pn = e * nPn + (x >> 1) * (nPn / 4) + (s >> 2); return true;
        }
        const int e = (int)L / per, rem = (int)L % per; u.pm = e * nPm + rem % nPm; u.pn = e * nPn + rem / nPm; return true;
    }
};

__device__ __forceinline__ unsigned cvt_pk_bf16(float lo, float hi) { unsigned r; asm volatile("v_cvt_pk_bf16_f32 %0, %1, %2" : "=v"(r) : "v"(lo), "v"(hi)); return r; }
__device__ __forceinline__ float bflo(unsigned w) { return __uint_as_float(w << 16); }
__device__ __forceinline__ float bfhi(unsigned w) { return __uint_as_float(w & 0xffff0000u); }
__device__ __forceinline__ unsigned pk4_fp8(float a, float b, float c, float d) {
    a = __builtin_fminf(__builtin_fmaxf(a, -448.f), 448.f); b = __builtin_fminf(__builtin_fmaxf(b, -448.f), 448.f); c = __builtin_fminf(__builtin_fmaxf(c, -448.f), 448.f); d = __builtin_fminf(__builtin_fmaxf(d, -448.f), 448.f);
    unsigned w = 0u; w = (unsigned)__builtin_amdgcn_cvt_pk_fp8_f32(a, b, (int)w, false); w = (unsigned)__builtin_amdgcn_cvt_pk_fp8_f32(c, d, (int)w, true); return w; }
typedef float f32x2p __attribute__((ext_vector_type(2)));
__device__ __forceinline__ void up4_fp8(unsigned w, float (&o)[4]) { const f32x2p a = __builtin_amdgcn_cvt_pk_f32_fp8((int)w, false), b = __builtin_amdgcn_cvt_pk_f32_fp8((int)w, true); o[0] = a[0]; o[1] = a[1]; o[2] = b[0]; o[3] = b[1]; }
__device__ __forceinline__ float sigmoidf_(float x) { return __builtin_amdgcn_rcpf(1.0f + __expf(-x)); }

#define PG8_EPI_LOOP_BEGIN _Pragma("unroll") for (int ai = 0; ai < 2; ++ai) _Pragma("unroll") for (int m = 0; m < 4; ++m) { const int rloc = ai * HALF + wr * 64 + m * 16 + fr;
#define PG8_EPI_LOOP_END }
__device__ __forceinline__ u32x4 pack8(const f32x4& a0, const f32x4& a1) { const f32x4 v0 = a0 + 0.0f, v1 = a1 + 0.0f; u32x4 w; w.x = cvt_pk_bf16(v0[0], v0[1]); w.y = cvt_pk_bf16(v0[2], v0[3]); w.z = cvt_pk_bf16(v1[0], v1[1]); w.w = cvt_pk_bf16(v1[2], v1[3]); return w; }

struct EpiZ {
    static constexpr bool PERM = true;
    bf16_t *QA, *QR, *GR, *GATE, *KA, *VA, *KR, *VR;
    const float *qn, *kn, *tab; PG8_LAS float* ss;
    int pn_off;
    __device__ __forceinline__ void operator()(const f32x4 (&acc)[2][2][4][2], const Unit& u, int wr, int wc, int fr, int fq) const {
        const int pn = u.pn + pn_off, pm = u.pm; bf16_t* base; int ldc, colt;
        if (pn < 4) { base = QA; ldc = 1024; colt = pn * 256; } else if (pn < 6) { base = QR; ldc = 512; colt = (pn - 4) * 256; } else if (pn < 10) { base = GR; ldc = 1024; colt = (pn - 6) * 256; }
        else if (pn < 26) { base = GATE; ldc = 4096; colt = (pn - 10) * 256; } else if (pn == 26) { base = KA; ldc = 256; colt = 0; } else if (pn == 27) { base = VA; ldc = 256; colt = 0; }
        else if (pn < 30) { base = KR; ldc = 512; colt = (pn - 28) * 256; } else { base = VR; ldc = 1024; colt = (pn - 30) * 256; }
        int rowt; if (pn < 26) rowt = pm * 256; else if (pm < 64) rowt = (pm >> 4) * 4352 + 256 + (pm & 15) * 256; else rowt = (pm - 64) * 4352;
        const bool head = pn < 6 || pn == 26 || pn == 28 || pn == 29;
        if (!head) {
            const int col0 = colt + wc * 32 + 8 * fq;
            PG8_EPI_LOOP_BEGIN
                bf16_t* rowp = base + (size_t)(rowt + rloc) * ldc + col0;
#pragma unroll
                for (int bj = 0; bj < 2; ++bj) *(u32x4*)(rowp + bj * HALF) = pack8(acc[ai][bj][m][0], acc[ai][bj][m][1]);
            PG8_EPI_LOOP_END
            return;
        }
        const bool do_norm = pn < 4 || pn == 26, do_rope = pm < 64; const float kscale = (pn >= 28) ? 0.08838834764831845f : 1.0f;
        const int ah = wc >> 1, j0 = 16 * (wc & 1) + 4 * fq;
        if (do_norm) {
            PG8_EPI_LOOP_BEGIN
#pragma unroll
                for (int bj = 0; bj < 2; ++bj) { const f32x4 x0 = acc[ai][bj][m][0], x1 = acc[ai][bj][m][1];
                    float q = (x0[0] * x0[0] + x0[1] * x0[1]) + (x0[2] * x0[2] + x0[3] * x0[3]) + (x1[0] * x1[0] + x1[1] * x1[1]) + (x1[2] * x1[2] + x1[3] * x1[3]);
                    q += __shfl_xor(q, 16); q += __shfl_xor(q, 32);
                    if (fq == 0) ss[rloc * 8 + bj * 4 + wc] = q; }
            PG8_EPI_LOOP_END
            asm volatile("s_waitcnt lgkmcnt(0)" ::: "memory"); __builtin_amdgcn_s_barrier(); asm volatile("" ::: "memory");
        }
        f32x4 g0 = {kscale, kscale, kscale, kscale}, g1 = g0;
        if (do_norm) { const float* g = (pn < 4) ? qn : kn; g0 = *(const f32x4*)(g + 64 * ah + j0); g1 = *(const f32x4*)(g + 64 * ah + 32 + j0); }
        PG8_EPI_LOOP_BEGIN
            f32x4 cs0 = {1.f, 0.f, 1.f, 0.f}, cs1 = cs0;
            if (do_rope) { const int t = (pm * 256 + rloc) & 4095, pos = ah ? (t & 63) : (t >> 6); const f32x4* tp = (const f32x4*)(tab + (pos * 32 + j0) * 2); cs0 = tp[0]; cs1 = tp[1]; }
            bf16_t* rowp = base + (size_t)(rowt + rloc) * ldc + colt + 64 * ah + j0;
            __builtin_amdgcn_sched_barrier(0);
#pragma unroll
            for (int bj = 0; bj < 2; ++bj) { float r = 1.0f;
                if (do_norm) { const f32x4 p = *(const PG8_LAS f32x4*)(ss + rloc * 8 + bj * 4); r = 1.0f / sqrtf(((p[0] + p[1]) + (p[2] + p[3])) * (1.0f / 128.0f) + 1e-6f); }
                const f32x4 x0 = acc[ai][bj][m][0] * r * g0, x1 = acc[ai][bj][m][1] * r * g1;
                const float c[4] = {cs0[0], cs0[2], cs1[0], cs1[2]}, sn[4] = {cs0[1], cs0[3], cs1[1], cs1[3]};
                float o0[4], o1[4];
#pragma unroll
                for (int i = 0; i < 4; ++i) { o0[i] = x0[i] * c[i] - x1[i] * sn[i]; o1[i] = x1[i] * c[i] + x0[i] * sn[i]; }
                typedef unsigned u32x2_ __attribute__((ext_vector_type(2)));
                u32x2_ w0, w1; w0.x = cvt_pk_bf16(o0[0], o0[1]); w0.y = cvt_pk_bf16(o0[2], o0[3]); w1.x = cvt_pk_bf16(o1[0], o1[1]); w1.y = cvt_pk_bf16(o1[2], o1[3]);
                *(u32x2_*)(rowp + bj * HALF) = w0; *(u32x2_*)(rowp + bj * HALF + 32) = w1; }
        PG8_EPI_LOOP_END
    }
};
struct EpiPlain {
    static constexpr bool PERM = true;
    bf16_t* O; int ldc;
    __device__ __forceinline__ void operator()(const f32x4 (&acc)[2][2][4][2], const Unit& u, int wr, int wc, int fr, int fq) const {
        const int col0 = u.pn * BM + wc * 32 + 8 * fq;
        PG8_EPI_LOOP_BEGIN
            bf16_t* rowp = O + (size_t)(u.pm * BM + rloc) * ldc + col0;
#pragma unroll
            for (int bj = 0; bj < 2; ++bj) *(u32x4*)(rowp + bj * HALF) = pack8(acc[ai][bj][m][0], acc[ai][bj][m][1]);
        PG8_EPI_LOOP_END
    }
};
struct EpiGate8 {
    static constexpr bool PERM = true;
    unsigned char* G;
    __device__ __forceinline__ void operator()(const f32x4 (&acc)[2][2][4][2], const Unit& u, int wr, int wc, int fr, int fq) const {
        const int col0 = u.pn * BM + wc * 32 + 8 * fq; typedef unsigned u32x2_ __attribute__((ext_vector_type(2)));
        PG8_EPI_LOOP_BEGIN
            unsigned char* rowp = G + (size_t)(u.pm * BM + rloc) * 4096 + col0;
#pragma unroll
            for (int bj = 0; bj < 2; ++bj) { const f32x4 v0 = acc[ai][bj][m][0] * 16.f, v1 = acc[ai][bj][m][1] * 16.f; u32x2_ w; w.x = pk4_fp8(v0[0], v0[1], v0[2], v0[3]); w.y = pk4_fp8(v1[0], v1[1], v1[2], v1[3]);
                *(u32x2_*)(rowp + bj * HALF) = w; }
        PG8_EPI_LOOP_END
    }
};
template <bool ADD> struct EpiGate {
    static constexpr bool PERM = true;
    bf16_t* Y; const bf16_t* gate; int goff;
    __device__ __forceinline__ void operator()(const f32x4 (&acc)[2][2][4][2], const Unit& u, int wr, int wc, int fr, int fq) const {
        const int col0 = u.pn * BM + wc * 32 + 8 * fq;
        PG8_EPI_LOOP_BEGIN
            const size_t row = (size_t)(u.pm * BM + rloc);
#pragma unroll
            for (int bj = 0; bj < 2; ++bj) {
                const u32x4 g = *(const u32x4*)(gate + row * 4096 + goff + col0 + bj * HALF);
                f32x4 v0 = acc[ai][bj][m][0], v1 = acc[ai][bj][m][1];
                v0[0] *= sigmoidf_(bflo(g.x)); v0[1] *= sigmoidf_(bfhi(g.x)); v0[2] *= sigmoidf_(bflo(g.y)); v0[3] *= sigmoidf_(bfhi(g.y));
                v1[0] *= sigmoidf_(bflo(g.z)); v1[1] *= sigmoidf_(bfhi(g.z)); v1[2] *= sigmoidf_(bflo(g.w)); v1[3] *= sigmoidf_(bfhi(g.w));
                bf16_t* yp = Y + row * 2048 + col0 + bj * HALF;
                if (ADD) { const u32x4 y = *(const u32x4*)yp;
                    v0[0] += bflo(y.x); v0[1] += bfhi(y.x); v0[2] += bflo(y.y); v0[3] += bfhi(y.y); v1[0] += bflo(y.z); v1[1] += bfhi(y.z); v1[2] += bflo(y.w); v1[3] += bfhi(y.w); }
                *(u32x4*)yp = pack8(v0, v1);
            }
        PG8_EPI_LOOP_END
    }
};
struct EpiGateMerge {
    static constexpr bool PERM = true, MID = true;
    bf16_t* Y; const unsigned char* gate;
    typedef unsigned u32x2_ __attribute__((ext_vector_type(2)));
    __device__ __forceinline__ void mid(f32x4 (&acc)[2][2][4][2], const Unit& u, int wr, int wc, int fr_, int fq_) const {
        int fr = fr_, fq = fq_; asm volatile("" : "+v"(fr), "+v"(fq));
        const int col0 = u.pn * BM + wc * 32 + 8 * fq;
        u32x2_ ga[2][4][2], gr[2][4][2];
#pragma unroll
        for (int ai = 0; ai < 2; ++ai)
#pragma unroll
            for (int m = 0; m < 4; ++m) { const unsigned char* gp = gate + (size_t)(u.pm * BM + ai * HALF + wr * 64 + m * 16 + fr) * 4096 + col0;
#pragma unroll
                for (int bj = 0; bj < 2; ++bj) { ga[ai][m][bj] = *(const u32x2_*)(gp + bj * HALF); gr[ai][m][bj] = *(const u32x2_*)(gp + 2048 + bj * HALF); } }
#pragma unroll
        for (int ai = 0; ai < 2; ++ai)
#pragma unroll
            for (int m = 0; m < 4; ++m)
#pragma unroll
                for (int bj = 0; bj < 2; ++bj) {
                    float a8[2][4], r8[2][4]; up4_fp8(ga[ai][m][bj].x, a8[0]); up4_fp8(ga[ai][m][bj].y, a8[1]); up4_fp8(gr[ai][m][bj].x, r8[0]); up4_fp8(gr[ai][m][bj].y, r8[1]);
#pragma unroll
                    for (int n = 0; n < 2; ++n)
#pragma unroll
                        for (int i = 0; i < 4; ++i)
                            acc[ai][bj][m][n][i] *= (1.0f + __expf(-0.0625f * r8[n][i])) * __builtin_amdgcn_rcpf(1.0f + __expf(-0.0625f * a8[n][i]));
                }
    }
    __device__ __forceinline__ void operator()(const f32x4 (&acc)[2][2][4][2], const Unit& u, int wr, int wc, int fr, int fq) const {
        const int col0 = u.pn * BM + wc * 32 + 8 * fq;
        PG8_EPI_LOOP_BEGIN
            const size_t row = (size_t)(u.pm * BM + rloc);
#pragma unroll
            for (int bj = 0; bj < 2; ++bj) {
                const u32x2_ g = *(const u32x2_*)(gate + row * 4096 + 2048 + col0 + bj * HALF);
                float g8[2][4]; up4_fp8(g.x, g8[0]); up4_fp8(g.y, g8[1]);
                f32x4 v0 = acc[ai][bj][m][0], v1 = acc[ai][bj][m][1];
#pragma unroll
                for (int i = 0; i < 4; ++i) { v0[i] *= sigmoidf_(0.0625f * g8[0][i]); v1[i] *= sigmoidf_(0.0625f * g8[1][i]); }
                *(u32x4*)(Y + row * 2048 + col0 + bj * HALF) = pack8(v0, v1);
            }
        PG8_EPI_LOOP_END
    }
};
struct EpiSwiGLU {
    static constexpr bool PERM = true;
    bf16_t* ACT;
    __device__ __forceinline__ void operator()(const f32x4 (&acc)[2][2][4][2], const Unit& u, int wr, int wc, int fr, int fq) const {
        const int col0 = (u.pn & 15) * 128 + wc * 32 + 8 * fq;
        PG8_EPI_LOOP_BEGIN
            f32x4 v0, v1;
#pragma unroll
            for (int j = 0; j < 4; ++j) { const float a0 = acc[ai][0][m][0][j], a1 = acc[ai][0][m][1][j]; v0[j] = a0 * sigmoidf_(a0) * acc[ai][1][m][0][j]; v1[j] = a1 * sigmoidf_(a1) * acc[ai][1][m][1][j]; }
            typedef unsigned u32x2_ __attribute__((ext_vector_type(2))); u32x2_ w; w.x = pk4_fp8(v0[0], v0[1], v0[2], v0[3]); w.y = pk4_fp8(v1[0], v1[1], v1[2], v1[3]);
            *(u32x2_*)((unsigned char*)ACT + (size_t)(u.pm * BM + rloc) * 2048 + col0) = w;
        PG8_EPI_LOOP_END
    }
};
struct EpiDown {
    static constexpr bool PERM = true;
    bf16_t* Y; const float* topw;
    __device__ __forceinline__ void operator()(const f32x4 (&acc)[2][2][4][2], const Unit& u, int wr, int wc, int fr, int fq) const {
        const int col0 = (u.pn & 7) * BM + wc * 32 + 8 * fq;
        PG8_EPI_LOOP_BEGIN
            const size_t row = (size_t)(u.pm * BM + rloc); const float w = topw[row];
#pragma unroll
            for (int bj = 0; bj < 2; ++bj) { const f32x4 v0 = acc[ai][bj][m][0] * (w * 128.f), v1 = acc[ai][bj][m][1] * (w * 128.f); typedef unsigned u32x2_ __attribute__((ext_vector_type(2)));
                u32x2_ o; o.x = pk4_fp8(v0[0], v0[1], v0[2], v0[3]); o.y = pk4_fp8(v1[0], v1[1], v1[2], v1[3]); *(u32x2_*)((unsigned char*)Y + row * 2048 + col0 + bj * HALF) = o; }
        PG8_EPI_LOOP_END
    }
};

template <class S, class = void> struct sched_dynamic { static constexpr bool value = false; };
template <class S> struct sched_dynamic<S, decltype((void)S::DYNAMIC)> { static constexpr bool value = S::DYNAMIC; };
template <class E, class = void> struct epi_has_mid { static constexpr bool value = false; };
template <class E> struct epi_has_mid<E, decltype((void)E::MID)> { static constexpr bool value = E::MID; };
typedef int i32x8 __attribute__((ext_vector_type(8)));
typedef int i32x4_ __attribute__((ext_vector_type(4)));
template <class Epi, class Sched, bool ALIGN_EPI, bool GATHER = false, bool F8 = false>
__device__ __forceinline__ void gemm_phase(PG8_LAS unsigned char* lds, const Gemm g, const Sched& S, const Epi& E, const int tid) {
    const int wid = __builtin_amdgcn_readfirstlane(tid >> 6), lane = tid & 63, wr = wid >> 2, wc = wid & 3, fr = lane & 15, fq = lane >> 4;
    constexpr int ESZ = F8 ? 1 : 2;
    const int K = g.K, nt = K * ESZ / (BK * 2);
    const size_t kstep = (size_t)(BK * 2);
    const size_t hA = (size_t)HALF * g.lda * ESZ, hB = (size_t)HALF * g.ldb * ESZ;
    const size_t tA = 2 * hA, tB = 2 * hB;
    unsigned vA0[2], vA1[2], voffB[2]; int Rg[2]; unsigned Cg[2];
#pragma unroll
    for (int i = 0; i < 2; ++i) { int R, C; stage_rc(tid * 16 + i * 8192, R, C); const int Rb = Epi::PERM ? ((R & ~31) + perm32(R & 31)) : R;
        Rg[i] = R; Cg[i] = (unsigned)C * 2u; vA0[i] = (unsigned)(R * g.lda * ESZ) + (unsigned)C * 2u; vA1[i] = vA0[i] + (unsigned)hA; voffB[i] = (unsigned)(Rb * g.ldb * ESZ) + (unsigned)C * 2u; }
    const unsigned ldsw = (unsigned)wid * 1024u;
    const int aoff = lds_byte(wr * 64 + fr, fq * (F8 ? 16 : 8)), boff = lds_byte(wc * 32 + fr, fq * (F8 ? 16 : 8));
    PG8_LAS const int* TBL = (PG8_LAS const int*)(lds + STAGE_BYTES);
#define PG8_SA(b, h) (((b) * 2 + (h)) * HTB)
#define PG8_SB(b, h) ((4 + (b) * 2 + (h)) * HTB)
#define PG8_STAGE(bufoff, gbase, voff) do { _Pragma("unroll") for (int _i = 0; _i < 2; ++_i) \
        __builtin_amdgcn_global_load_lds((const unsigned*)((const char*)(gbase) + (voff)[_i]), (PG8_LAS unsigned*)(lds + (bufoff) + ldsw + _i * 8192), 16, 0, 0); } while (0)
#define PG8_RD16(off) (*(const PG8_LAS i32x4_*)(lds + (off)))
#define PG8_LDA(dst, b, h) do { if constexpr (F8) { _Pragma("unroll") for (int m = 0; m < 4; ++m) dst##8[m] = __builtin_shufflevector(PG8_RD16(PG8_SA(b, h) + aoff + m * 2048), PG8_RD16(PG8_SA(b, h) + aoff + m * 2048 + 16), 0, 1, 2, 3, 4, 5, 6, 7); } \
    else { _Pragma("unroll") for (int m = 0; m < 4; ++m) _Pragma("unroll") for (int k = 0; k < 2; ++k) dst[m][k] = *(const PG8_LAS bf16x8*)(lds + PG8_SA(b, h) + aoff + m * 2048 + k * 1024); } } while (0)
#define PG8_LDB(dst, b, h) do { if constexpr (F8) { _Pragma("unroll") for (int n = 0; n < 2; ++n) dst##8[n] = __builtin_shufflevector(PG8_RD16(PG8_SB(b, h) + boff + n * 2048), PG8_RD16(PG8_SB(b, h) + boff + n * 2048 + 16), 0, 1, 2, 3, 4, 5, 6, 7); } \
    else { _Pragma("unroll") for (int n = 0; n < 2; ++n) _Pragma("unroll") for (int k = 0; k < 2; ++k) dst[n][k] = *(const PG8_LAS bf16x8*)(lds + PG8_SB(b, h) + boff + n * 2048 + k * 1024); } } while (0)
#define PG8_MMA(ai, bj, At, Bt) do { __builtin_amdgcn_s_setprio(1); if constexpr (F8) { _Pragma("unroll") for (int m = 0; m < 4; ++m) _Pragma("unroll") for (int n = 0; n < 2; ++n) \
        asm volatile("v_mfma_scale_f32_16x16x128_f8f6f4 %0, %1, %2, %0, %3, %4 op_sel_hi:[0,0,0]" : "+v"(acc[ai][bj][m][n]) : "v"(Bt##8[n]), "v"(At##8[m]), "v"(sclB), "v"(sclA)); } else { \
        _Pragma("unroll") for (int m = 0; m < 4; ++m) _Pragma("unroll") for (int n = 0; n < 2; ++n) _Pragma("unroll") for (int k = 0; k < 2; ++k) \
        acc[ai][bj][m][n] = __builtin_amdgcn_mfma_f32_16x16x32_bf16(Bt[n][k], At[m][k], acc[ai][bj][m][n], 0, 0, 0); } __builtin_amdgcn_s_setprio(0); } while (0)
#define PG8_WAIT_V(n) asm volatile("s_waitcnt vmcnt(" #n ")" ::: "memory")
#define PG8_WAIT_L(n) asm volatile("s_waitcnt lgkmcnt(" #n ")" ::: "memory")
#define PG8_BAR __builtin_amdgcn_s_barrier()
#define PG8_SCHED __builtin_amdgcn_sched_barrier(0)
    Unit cur, nxt; int ui = 0;
    constexpr bool DYN = sched_dynamic<Sched>::value;
    PG8_LAS volatile int* qslot = (PG8_LAS volatile int*)(lds + STAGE_BYTES + 1024);
    if constexpr (DYN) { if (tid == 0) qslot[0] = S.pull(); __syncthreads(); const int q0 = qslot[0]; if (!S.unit(q0, cur)) return; }
    else { if (!S.next(0, cur)) return; }
    f32x4 acc[2][2][4][2];
#pragma unroll
    for (int a = 0; a < 2; ++a)
#pragma unroll
        for (int b = 0; b < 2; ++b)
#pragma unroll
            for (int m = 0; m < 4; ++m)
#pragma unroll
                for (int n = 0; n < 2; ++n) acc[a][b][m][n] = (f32x4){0.f, 0.f, 0.f, 0.f};
    bf16x8 At[4][2], B0[2][2], B1[2][2]; i32x8 At8[4], B08[2], B18[2];
    const int sclA = g.scaleA, sclB = g.scaleB;
    const char* cA = (const char*)g.A + (GATHER ? (size_t)0 : (size_t)cur.pm * tA); const char* cB = (const char*)g.Bt + (size_t)cur.pn * tB;
    if constexpr (GATHER) {
#pragma unroll
        for (int i = 0; i < 2; ++i) { vA0[i] = (unsigned)g.ridx[cur.pm * 256 + Rg[i]] * (unsigned)(g.lda * ESZ) + Cg[i]; vA1[i] = (unsigned)g.ridx[cur.pm * 256 + 128 + Rg[i]] * (unsigned)(g.lda * ESZ) + Cg[i]; }
    }
    PG8_STAGE(PG8_SB(0, 0), cB, voffB); PG8_STAGE(PG8_SB(0, 1), cB + hB, voffB); PG8_STAGE(PG8_SA(0, 0), cA, vA0); PG8_STAGE(PG8_SA(0, 1), cA, vA1);
    if (wr == 1) PG8_BAR;
    PG8_WAIT_V(2); PG8_BAR;
    PG8_STAGE(PG8_SB(1, 0), cB + kstep, voffB); PG8_STAGE(PG8_SA(1, 0), cA + kstep, vA0); PG8_STAGE(PG8_SB(1, 1), cB + hB + kstep, voffB);
    PG8_WAIT_V(6); PG8_BAR;
    for (;;) {
        bool has_next = false; int pulled = 0;
        if constexpr (DYN) { if (tid == 0) pulled = S.pull(); }
        else has_next = S.next(ui + 1, nxt);
        const char* nA = (has_next && !GATHER) ? (const char*)g.A + (size_t)nxt.pm * tA : cA; const char* nB = has_next ? (const char*)g.Bt + (size_t)nxt.pn * tB : cB;
        unsigned nv0[2] = {vA0[0], vA0[1]}, nv1[2] = {vA1[0], vA1[1]};
        for (int t = 0; t < nt; t += 2) {
            const bool last = (t == nt - 2);
            if constexpr (DYN) {
                if (t == nt / 2 && tid == 0) qslot[0] = pulled;
                if (last) { const int q1 = qslot[0]; has_next = S.unit(q1, nxt);
                    if (has_next) { nA = (const char*)g.A + (size_t)nxt.pm * tA; nB = (const char*)g.Bt + (size_t)nxt.pn * tB; } }
            }
            if constexpr (epi_has_mid<Epi>::value) { if (t == nt / 2) E.mid(acc, cur, wr, wc, fr, fq); }
            if constexpr (GATHER) {
                if (t == nt - 6 && has_next && wid == 0)
                    __builtin_amdgcn_global_load_lds((const unsigned*)(g.ridx + (size_t)nxt.pm * 256 + lane * 4), (PG8_LAS unsigned*)(lds + STAGE_BYTES), 16, 0, 0);
                if (last && has_next) {
#pragma unroll
                    for (int i = 0; i < 2; ++i) { nv0[i] = (unsigned)TBL[Rg[i]] * (unsigned)(g.lda * ESZ) + Cg[i]; nv1[i] = (unsigned)TBL[128 + Rg[i]] * (unsigned)(g.lda * ESZ) + Cg[i]; }
                }
            }
            const char* a1 = cA + (size_t)(t + 1) * kstep;
            const char* a2 = last ? nA : cA + (size_t)(t + 2) * kstep; const char* b2 = last ? nB : cB + (size_t)(t + 2) * kstep;
            const char* a3 = a2 + kstep; const char* b3 = b2 + kstep;
            const unsigned x0[2] = {(GATHER && last) ? nv0[0] : vA0[0], (GATHER && last) ? nv0[1] : vA0[1]}, x1[2] = {(GATHER && last) ? nv1[0] : vA1[0], (GATHER && last) ? nv1[1] : vA1[1]};
            PG8_LDB(B0, 0, 0); PG8_LDB(B1, 0, 1); PG8_SCHED; PG8_LDA(At, 0, 0); PG8_STAGE(PG8_SA(1, 1), a1, vA1);
            PG8_WAIT_V(8); PG8_WAIT_L(0); PG8_BAR; PG8_MMA(0, 0, At, B0); PG8_MMA(0, 1, At, B1); PG8_BAR; PG8_SCHED;
            PG8_LDA(At, 0, 1); PG8_STAGE(PG8_SB(0, 0), b2, voffB); PG8_STAGE(PG8_SB(0, 1), b2 + hB, voffB); PG8_STAGE(PG8_SA(0, 0), a2, x0);
            PG8_WAIT_V(8); PG8_WAIT_L(0); PG8_BAR; PG8_MMA(1, 0, At, B0); PG8_MMA(1, 1, At, B1); PG8_BAR; PG8_SCHED;
            PG8_LDB(B0, 1, 0); PG8_LDB(B1, 1, 1); PG8_SCHED; PG8_LDA(At, 1, 0); PG8_STAGE(PG8_SA(0, 1), a2, x1);
            PG8_WAIT_V(8); PG8_WAIT_L(0); PG8_BAR; PG8_MMA(0, 0, At, B0); PG8_MMA(0, 1, At, B1); PG8_BAR; PG8_SCHED;
            PG8_LDA(At, 1, 1); PG8_STAGE(PG8_SB(1, 0), b3, voffB); PG8_STAGE(PG8_SB(1, 1), b3 + hB, voffB); PG8_STAGE(PG8_SA(1, 0), a3, x0);
            PG8_WAIT_V(8); PG8_WAIT_L(0); PG8_BAR; PG8_MMA(1, 0, At, B0); PG8_MMA(1, 1, At, B1); PG8_BAR; PG8_SCHED;
        }
        if constexpr (ALIGN_EPI) { if (wr == 0) PG8_BAR; }
        if constexpr (F8) asm volatile("s_nop 15\n\ts_nop 15\n\ts_nop 15\n\ts_nop 15\n\ts_nop 15" ::: "memory");
        E(acc, cur, wr, wc, fr, fq);
        if (!has_next) break;
#pragma unroll
        for (int a = 0; a < 2; ++a)
#pragma unroll
            for (int b = 0; b < 2; ++b)
#pragma unroll
                for (int m = 0; m < 4; ++m)
#pragma unroll
                    for (int n = 0; n < 2; ++n) acc[a][b][m][n] = (f32x4){0.f, 0.f, 0.f, 0.f};
        cur = nxt; cA = nA; cB = nB; ++ui;
        if constexpr (GATHER) { vA0[0] = nv0[0]; vA0[1] = nv0[1]; vA1[0] = nv1[0]; vA1[1] = nv1[1]; }
        if constexpr (ALIGN_EPI) { if (wr == 1) PG8_BAR; }
    }
    PG8_WAIT_V(0);
    if constexpr (!ALIGN_EPI) { if (wr == 0) PG8_BAR; }
    PG8_BAR;
#undef PG8_SA
#undef PG8_SB
#undef PG8_STAGE
#undef PG8_LDA
#undef PG8_LDB
#undef PG8_MMA
#undef PG8_RD16
#undef PG8_WAIT_V
#undef PG8_WAIT_L
#undef PG8_BAR
#undef PG8_SCHED
}
}

namespace att {
typedef unsigned short bf16;
constexpr int D = 128, NW = 8, QBLK = 32, KVBLK = 64;
constexpr float SCALE = 0.088388347648318440f;
constexpr float THR = 8.f;
constexpr int LDQ = 1024, LDK = 256, LDO = 2048;
constexpr size_t SHM_V = KVBLK * D * 2, SHM_K = KVBLK * D * 2, SHM_ATTN = 2 * SHM_V + 2 * SHM_K + NW * 64 * 4;
using bf16x8 = __attribute__((ext_vector_type(8))) short;
using s16x4  = __attribute__((ext_vector_type(4))) short;
using f32x16 = __attribute__((ext_vector_type(16))) float;
using u32x4  = __attribute__((ext_vector_type(4))) unsigned;
#define KSWZ(row, colB) ((row) * 256 + ((colB) ^ (((row) & 7) << 4)))
#define SBAR() __builtin_amdgcn_sched_barrier(0)
__device__ __forceinline__ int crow(int r, int hi) { return (r & 3) + 8 * (r >> 2) + 4 * hi; }
__device__ __forceinline__ unsigned cvtpk(float lo, float hi) { unsigned r; asm volatile("v_cvt_pk_bf16_f32 %0, %1, %2" : "=v"(r) : "v"(lo), "v"(hi)); return r; }
__device__ __forceinline__ void partialSM(f32x16& p0, f32x16& p1, float& m_reg, float& mn, float& alpha) {
  constexpr float C = SCALE * 1.4426950408889634f;
  float pmax = p0[0]; for (int r = 1; r < 16; ++r) pmax = fmaxf(pmax, p0[r]); for (int r = 0; r < 16; ++r) pmax = fmaxf(pmax, p1[r]);
  { auto rr = __builtin_amdgcn_permlane32_swap(__float_as_uint(pmax), __float_as_uint(pmax), false, false);
    pmax = fmaxf(__uint_as_float(rr[0]), __uint_as_float(rr[1])); }
  if (__builtin_expect(__all(pmax - m_reg <= THR / SCALE), 1)) { mn = m_reg; alpha = 1.f; }
  else { mn = fmaxf(m_reg, pmax); alpha = __builtin_amdgcn_exp2f((m_reg - mn) * C); m_reg = mn; }
  float mnC = -mn * C;
  for (int r = 0; r < 16; ++r) p0[r] = fmaf(p0[r], C, mnC); for (int r = 0; r < 16; ++r) p1[r] = fmaf(p1[r], C, mnC);
  for (int r = 0; r < 16; ++r) p0[r] = __builtin_amdgcn_exp2f(p0[r]);
}
__device__ __forceinline__ void finishSM(f32x16& p0, f32x16& p1, float alpha, float& l_reg, bf16x8& pa0, bf16x8& pa1, bf16x8& pa2, bf16x8& pa3) {
  for (int r = 0; r < 16; ++r) p1[r] = __builtin_amdgcn_exp2f(p1[r]);
  float ps = 0; for (int r = 0; r < 16; ++r) ps += p0[r]; for (int r = 0; r < 16; ++r) ps += p1[r];
  { auto rr = __builtin_amdgcn_permlane32_swap(__float_as_uint(ps), __float_as_uint(ps), false, false);
    ps = __uint_as_float(rr[0]) + __uint_as_float(rr[1]); }
  l_reg = l_reg * alpha + ps;
#define PK4(P, BASE, OUT) do { unsigned a0 = cvtpk(P[BASE + 0], P[BASE + 1]), a1 = cvtpk(P[BASE + 2], P[BASE + 3]);   \
    unsigned b0 = cvtpk(P[BASE + 4], P[BASE + 5]), b1 = cvtpk(P[BASE + 6], P[BASE + 7]);                              \
    auto r0 = __builtin_amdgcn_permlane32_swap(a0, b0, false, false); auto r1 = __builtin_amdgcn_permlane32_swap(a1, b1, false, false); \
    u32x4 w = {r0[0], r1[0], r0[1], r1[1]}; OUT = *reinterpret_cast<bf16x8*>(&w); } while (0)
  PK4(p0, 0, pa0); PK4(p0, 8, pa1); PK4(p1, 0, pa2); PK4(p1, 8, pa3);
#undef PK4
}
__device__ __forceinline__ void qkt(f32x16& p0, f32x16& p1, const bf16* Ks, const bf16x8* qr, int r32, int hi) {
  p0 = f32x16{}; p1 = f32x16{};
  for (int d0 = 0; d0 < 8; ++d0) { int cb = (d0 * 16 + hi * 8) * 2;
    bf16x8 b0 = *reinterpret_cast<const bf16x8*>((const char*)Ks + KSWZ(r32, cb));
    bf16x8 b1 = *reinterpret_cast<const bf16x8*>((const char*)Ks + KSWZ(32 + r32, cb));
    p0 = __builtin_amdgcn_mfma_f32_32x32x16_bf16(b0, qr[d0], p0, 0, 0, 0);
    p1 = __builtin_amdgcn_mfma_f32_32x32x16_bf16(b1, qr[d0], p1, 0, 0, 0); }
}
__device__ __forceinline__ int v_st(int k, int c) { const int kk = (k & ~0xC) | ((k & 4) << 1) | ((k & 8) >> 1); return ((kk >> 3) * 4 + (c >> 5)) * 512 + ((kk & 7) * 32 + (c & 31)) * 2; }
__device__ __forceinline__ int v_rd_base(int lane) { return ((lane & 3) << 3) | (((lane >> 2) & 3) << 6) | (((lane >> 4) & 1) << 5) | (((lane >> 5) & 1) << 8); }
constexpr int v_rd_off(int d0, int ks, int half) { return d0 * 512 + ks * 4096 + half * 2048; }
template <int OFF> __device__ __forceinline__ s16x4 tr_read(int vb) {
  s16x4 r; asm volatile("ds_read_b64_tr_b16 %0, %1 offset:%2" : "=&v"(r) : "v"(vb), "i"(OFF) : "memory"); return r;
}
template <int D0> __device__ __forceinline__ void pv_one(f32x16& od, int vb, bf16x8 pa0, bf16x8 pa1, bf16x8 pa2, bf16x8 pa3) {
  const s16x4 l0 = tr_read<v_rd_off(D0, 0, 0)>(vb), h0 = tr_read<v_rd_off(D0, 0, 1)>(vb), l1 = tr_read<v_rd_off(D0, 1, 0)>(vb), h1 = tr_read<v_rd_off(D0, 1, 1)>(vb);
  const s16x4 l2 = tr_read<v_rd_off(D0, 2, 0)>(vb), h2 = tr_read<v_rd_off(D0, 2, 1)>(vb), l3 = tr_read<v_rd_off(D0, 3, 0)>(vb), h3 = tr_read<v_rd_off(D0, 3, 1)>(vb);
  asm volatile("s_waitcnt lgkmcnt(0)" ::: "memory"); SBAR();
#define PK(L, H) (bf16x8){L[0], L[1], L[2], L[3], H[0], H[1], H[2], H[3]}
  od = __builtin_amdgcn_mfma_f32_32x32x16_bf16(pa0, PK(l0, h0), od, 0, 0, 0);
  od = __builtin_amdgcn_mfma_f32_32x32x16_bf16(pa1, PK(l1, h1), od, 0, 0, 0);
  od = __builtin_amdgcn_mfma_f32_32x32x16_bf16(pa2, PK(l2, h2), od, 0, 0, 0);
  od = __builtin_amdgcn_mfma_f32_32x32x16_bf16(pa3, PK(l3, h3), od, 0, 0, 0);
#undef PK
}
__device__ __forceinline__ void pv_d0(f32x16* o, int vb, bf16x8 pa0, bf16x8 pa1, bf16x8 pa2, bf16x8 pa3) {
  pv_one<0>(o[0], vb, pa0, pa1, pa2, pa3); pv_one<1>(o[1], vb, pa0, pa1, pa2, pa3); pv_one<2>(o[2], vb, pa0, pa1, pa2, pa3); pv_one<3>(o[3], vb, pa0, pa1, pa2, pa3);
}
__device__ __forceinline__ void attn_dense_body(const bf16* __restrict__ Qb, const bf16* __restrict__ Kh, const bf16* __restrict__ Vh, bf16* __restrict__ Ob, int seq, char* lds, const int tid) {
  const int wid = tid >> 6, lane = tid & 63, r32 = lane & 31, hi = lane >> 5;
  bf16* V_lds = (bf16*)lds; bf16* K_lds = (bf16*)(lds + 2 * SHM_V);
  float* ws = (float*)(lds + 2 * SHM_V + 2 * SHM_K) + wid * 64; float* li_l = ws; float* al_l = ws + 32;
  float m_reg = -1e30f, l_reg = 0; f32x16 o[4] = {}; bf16x8 qr[8];
  const bf16* Qw = Qb + (long)(wid * QBLK + r32) * LDQ + hi * 8;
#pragma unroll
  for (int d0 = 0; d0 < 8; ++d0) qr[d0] = *reinterpret_cast<const bf16x8*>(Qw + d0 * 16);
  const int sr = tid >> 4, sc = (tid & 15) * 8, vst0 = v_st(sr, sc), vst1 = v_st(32 + sr, sc);
  const int vb0 = (int)(uintptr_t)V_lds + v_rd_base(lane);
  struct { bf16x8 vs0, vs1, ks0, ks1; } sr_[2];
#define LD8(p) (*reinterpret_cast<const bf16x8*>(p))
#define SLOAD(i, k0) do { sr_[i].vs0 = LD8(&Vh[(long)((k0) + sr) * LDK + sc]); sr_[i].vs1 = LD8(&Vh[(long)((k0) + 32 + sr) * LDK + sc]); \
    sr_[i].ks0 = LD8(&Kh[(long)((k0) + sr) * LDK + sc]); sr_[i].ks1 = LD8(&Kh[(long)((k0) + 32 + sr) * LDK + sc]); } while (0)
#define SWRITE(b, i) do { *(bf16x8*)((char*)V_lds + (b) * SHM_V + vst0) = sr_[i].vs0;          \
    *(bf16x8*)((char*)V_lds + (b) * SHM_V + vst1) = sr_[i].vs1; int kc = sc * 2;               \
    *(bf16x8*)((char*)K_lds + (b) * SHM_K + KSWZ(sr, kc)) = sr_[i].ks0;                       \
    *(bf16x8*)((char*)K_lds + (b) * SHM_K + KSWZ(32 + sr, kc)) = sr_[i].ks1; } while (0)
#define SWAIT() asm volatile("s_waitcnt vmcnt(4)" ::: "memory")
#define RESC(a) do { if (__any((a) < 1.f)) { if (hi == 0) al_l[r32] = (a); asm volatile("s_waitcnt lgkmcnt(0)" ::: "memory"); \
    for (int d = 0; d < 4; ++d) for (int r = 0; r < 16; ++r) o[d][r] *= al_l[crow(r, hi)]; } } while (0)
  f32x16 pA0, pA1, pB0, pB1; float mnA, mnB, alA, alB; bf16x8 pa0, pa1, pa2, pa3; const int NT = seq / KVBLK;
  constexpr int SE = 0, SO = 1;
  SLOAD(SE, 0); asm volatile("s_waitcnt vmcnt(0)" ::: "memory"); SWRITE(0, SE); __syncthreads();
  qkt(pA0, pA1, K_lds, qr, r32, hi); partialSM(pA0, pA1, m_reg, mnA, alA);
  SLOAD(SO, KVBLK); if (2 < NT) SLOAD(SE, 2 * KVBLK);
  SWAIT(); SWRITE(1, SO); __syncthreads();
  for (int j = 1; j + 1 < NT; j += 2) {
    SBAR(); qkt(pB0, pB1, (bf16*)((char*)K_lds + SHM_K), qr, r32, hi);
    finishSM(pA0, pA1, alA, l_reg, pa0, pa1, pa2, pa3); SBAR();
    SLOAD(SO, (j + 2) * KVBLK); SBAR();
    pv_d0(o, vb0, pa0, pa1, pa2, pa3); partialSM(pB0, pB1, m_reg, mnB, alB);
    __syncthreads(); SWAIT(); SWRITE(0, SE);
    RESC(alB); __syncthreads();
    SBAR(); qkt(pA0, pA1, K_lds, qr, r32, hi);
    finishSM(pB0, pB1, alB, l_reg, pa0, pa1, pa2, pa3); SBAR();
    if (j + 3 < NT) SLOAD(SE, (j + 3) * KVBLK); SBAR();
    pv_d0(o, vb0 + (int)SHM_V, pa0, pa1, pa2, pa3); partialSM(pA0, pA1, m_reg, mnA, alA);
    __syncthreads(); SWAIT(); SWRITE(1, SO);
    RESC(alA); __syncthreads();
  }
  SBAR(); qkt(pB0, pB1, (bf16*)((char*)K_lds + SHM_K), qr, r32, hi);
  finishSM(pA0, pA1, alA, l_reg, pa0, pa1, pa2, pa3); SBAR();
  pv_d0(o, vb0, pa0, pa1, pa2, pa3); partialSM(pB0, pB1, m_reg, mnB, alB);
  __syncthreads(); RESC(alB);
  finishSM(pB0, pB1, alB, l_reg, pa0, pa1, pa2, pa3); SBAR();
  pv_d0(o, vb0 + (int)SHM_V, pa0, pa1, pa2, pa3);
  if (hi == 0) li_l[r32] = l_reg; asm volatile("s_waitcnt lgkmcnt(0)" ::: "memory");
  float rli[16];
#pragma unroll
  for (int r = 0; r < 16; ++r) rli[r] = __builtin_amdgcn_rcpf(li_l[crow(r, hi)]);
  bf16* Ow = Ob + (long)(wid * QBLK) * LDO;
#pragma unroll
  for (int r = 0; r < 16; ++r) { int orow = crow(r, hi);
#pragma unroll
    for (int d0 = 0; d0 < 4; d0 += 1) { const unsigned w = cvtpk(o[d0][r] * rli[r], 0.f); Ow[(long)orow * LDO + d0 * 32 + r32] = (bf16)(w & 0xffffu); } }
  __syncthreads();
#undef LD8
#undef SLOAD
#undef SWRITE
#undef SWAIT
#undef RESC
}
}

constexpr int NWAVES = 8;
constexpr int N_LAUNCHES = MK_N_LAUNCHES;
constexpr int N_PHASES = 15;
constexpr int DM = 2048, NB = 4, T = 4096, LC = 256, M = NB * T, MC = NB * LC, SKV = LC + T;
constexpr int NE = 16, FFD = 2048, CAP = 512;
constexpr float EPS = 1e-6f;

constexpr size_t MiB = 1u << 20;
constexpr size_t WS_CTL = 0, CTL_ZERO_BYTES = 64 * 1024;
constexpr size_t WS_ZROW = 48 * 1024;
constexpr size_t WS_ROPE = 1 * MiB;
constexpr size_t WS_MOD = WS_ROPE + 64 * 1024;
constexpr size_t WS_WRT = WS_ROPE + 512 * 1024;
constexpr size_t WS_AFF = 2 * MiB;
constexpr size_t WS_ROWIDX = 3 * MiB;
constexpr size_t WS_TOPW = WS_ROWIDX + 256 * 1024;
constexpr size_t WS_INV = 4 * MiB;
constexpr size_t WS_MODP = 5 * MiB;
constexpr size_t WS_WIN = 8 * MiB;
constexpr size_t WS_WIN8 = WS_WIN + (size_t)2560 * 4096;
constexpr size_t WS_WOA = 42 * MiB, WS_WOR = 46 * MiB, WS_WOUT = 50 * MiB;
constexpr size_t WS_WGU = 58 * MiB;
constexpr size_t WS_WDN = 314 * MiB;
constexpr size_t WS_H = 442 * MiB;
constexpr size_t WS_QA = 510 * MiB, WS_QR = 542 * MiB, WS_GR = 558 * MiB, WS_GATE = 590 * MiB;
constexpr size_t WS_KA = 718 * MiB, WS_VA = WS_KA + (size_t)NB * SKV * 256 * 2, WS_KR = 735 * MiB, WS_VR = 752 * MiB;
constexpr size_t WS_ACT = 510 * MiB, WS_YEXP = 638 * MiB;
constexpr size_t WS_H8 = 786 * MiB;
constexpr size_t WS_U = 786 * MiB;
constexpr size_t WS_ST = 854 * MiB;
constexpr size_t WS_YO = 786 * MiB;
constexpr size_t WS_Y = 854 * MiB;
constexpr size_t WS_XG = 786 * MiB;
constexpr size_t WS_O = 918 * MiB;
constexpr size_t WS_END = 982 * MiB;
static_assert(WS_VA + (size_t)NB * SKV * 256 * 2 <= WS_KR && WS_KR + (size_t)NB * SKV * 512 * 2 <= WS_VR && WS_VR + (size_t)NB * SKV * 1024 * 2 <= WS_U, "z map");
static_assert(WS_XG + (size_t)32768 * 2048 * 2 <= WS_O, "xg map");
constexpr int CW_TMO = 0, CW_CODE = 1, CW_BAR = 4096, CW_QUEUE = 8192;

constexpr int RING_OFF = 0, RING_BYTES = 131072;
constexpr int SCRATCH_BYTES = 155648;
constexpr int LDSCTL_OFF = SCRATCH_BYTES, MISC_OFF = LDSCTL_OFF + 320;
constexpr int LDS_BYTES = 156672;
static_assert(MISC_OFF + 128 <= LDS_BYTES, "LDS map");

#define GAS __attribute__((address_space(1)))
#define LAS __attribute__((address_space(3)))
typedef unsigned short bf16;
typedef unsigned v4u __attribute__((ext_vector_type(4)));
typedef unsigned v2u __attribute__((ext_vector_type(2)));
typedef float f32x4 __attribute__((ext_vector_type(4)));
typedef GAS unsigned gu32;
#define RLX_AGENT __ATOMIC_RELAXED, __HIP_MEMORY_SCOPE_AGENT
#define LDS_WAIT() asm volatile("s_waitcnt lgkmcnt(0)" ::: "memory")
#define VM_WAIT() asm volatile("s_waitcnt vmcnt(0)" ::: "memory")
__device__ __forceinline__ unsigned pk2(float lo, float hi) { return pg8::cvt_pk_bf16(lo, hi); }
__device__ __forceinline__ float bflo(unsigned w) { return __uint_as_float(w << 16); }
__device__ __forceinline__ float bfhi(unsigned w) { return __uint_as_float(w & 0xffff0000u); }
__device__ __forceinline__ float bf1(bf16 b) { return __uint_as_float(((unsigned)b) << 16); }
__device__ __forceinline__ float siluf_(float x) { return x * __builtin_amdgcn_rcpf(1.0f + __expf(-x)); }

#define XB_TMO      128
#define XB_XCNT(j)  (256  + 64 * (j))
#define XB_XSUB(j)  (1280 + 64 * (j))
#define XB_XGEN(j)  (2304 + 64 * (j))
#define XB_TOP      3328
#define XB_TOPGEN   3392
#define XCD_BAR_WORDS 3456
#define XB_SPIN_CAP (1u << 18)
__device__ __forceinline__ unsigned xb_ld(unsigned* p)              { return __hip_atomic_load(p, __ATOMIC_RELAXED, __HIP_MEMORY_SCOPE_AGENT); }
__device__ __forceinline__ unsigned xb_add(unsigned* p, unsigned v) { return __hip_atomic_fetch_add(p, v, __ATOMIC_RELAXED, __HIP_MEMORY_SCOPE_AGENT); }
__device__ __forceinline__ unsigned xb_xcc_id() { return (unsigned)__builtin_amdgcn_s_getreg((3 << 11) | 20) & 0xFu; }
#define XB_SPIN(cond, bar) do { unsigned _sp = 0; while (cond) { __builtin_amdgcn_s_sleep(1); \
    if ((++_sp & 255u) == 0u) { if (xb_ld(&(bar)[XB_TMO])) break; if (_sp > XB_SPIN_CAP) { atomicAdd(&(bar)[XB_TMO], 1u); break; } } } } while (0)
struct XcdBarrier { unsigned* bar; unsigned x; volatile LAS unsigned* st; };
__device__ __forceinline__ XcdBarrier xcd_barrier_post(unsigned* bar, volatile LAS unsigned* st) {
    XcdBarrier b; b.bar = bar; b.x = xb_xcc_id(); b.st = st;
    if (threadIdx.x == 0) (void)xb_add(&bar[XB_XCNT(b.x)], 1u);
    return b;
}
__device__ __forceinline__ void xcd_barrier_complete(unsigned* bar, unsigned x, unsigned& nloc, unsigned& nx) {
    const unsigned G = gridDim.x * gridDim.y * gridDim.z;
    unsigned sum, cnt, mine, sp = 0u;
    for (;;) {
        sum = 0u; cnt = 0u; mine = 0u;
#pragma unroll
        for (unsigned j = 0; j < 16; ++j) { const unsigned c = xb_ld(&bar[XB_XCNT(j)]); sum += c; cnt += (c > 0u) ? 1u : 0u; mine = (j == x) ? c : mine; }
        if (sum == G) break;
        __builtin_amdgcn_s_sleep(1);
        if ((++sp & 255u) == 0u) { if (xb_ld(&bar[XB_TMO])) break; if (sp > XB_SPIN_CAP) { atomicAdd(&bar[XB_TMO], 1u); break; } }
    }
    nloc = mine > 0u ? mine : 1u; nx = cnt > 0u ? cnt : 1u;
}
__device__ __forceinline__ void xcd_barrier(const XcdBarrier& b) {
    asm volatile("s_waitcnt vmcnt(0)" ::: "memory");
    __syncthreads();
    if (threadIdx.x == 0) {
        unsigned* bar = b.bar;
        __builtin_amdgcn_s_waitcnt(0);
        unsigned nloc = b.st[0], nx = b.st[1];
        if (nloc == 0u) { xcd_barrier_complete(bar, b.x, nloc, nx); b.st[0] = nloc; b.st[1] = nx; }
        const unsigned old = xb_add(&bar[XB_XSUB(b.x)], 1u);
        const unsigned gen = old / nloc;
        if (old + 1u == (gen + 1u) * nloc) {
            __builtin_amdgcn_fence(__ATOMIC_RELEASE, "agent");
            asm volatile("s_waitcnt vmcnt(0)" ::: "memory");
            const unsigned og = xb_add(&bar[XB_TOP], 1u);
            const unsigned tg = og / nx;
            if (og + 1u == (tg + 1u) * nx) xb_add(&bar[XB_TOPGEN], 1u);
            else XB_SPIN(xb_ld(&bar[XB_TOPGEN]) == tg, bar);
            __builtin_amdgcn_fence(__ATOMIC_ACQUIRE, "agent");
            xb_add(&bar[XB_XGEN(b.x)], 1u);
            asm volatile("s_waitcnt vmcnt(0)" ::: "memory");
        } else {
            XB_SPIN(xb_ld(&bar[XB_XGEN(b.x)]) == gen, bar);
            __builtin_amdgcn_fence(__ATOMIC_ACQUIRE, "agent");
            asm volatile("s_waitcnt vmcnt(0)" ::: "memory");
        }
    }
    __syncthreads();
}

struct Frame {
    LAS unsigned char* lds;
    volatile LAS unsigned* MISC;
    gu32* ctl;
    int tid, lane, wave;
    int vcu, G;
    float* out; unsigned char* ws;
};
enum { I_X = 0, I_C, I_CTX, I_CCTX, I_WMOD, I_BMOD, I_PRE1, I_POST1, I_PRE2, I_POST2, I_WIN, I_QN, I_KN, I_DECAY, I_GN, I_WOA, I_WOR, I_WOUT, I_WR, I_WG, I_WU, I_WD };
__device__ __forceinline__ const float* inp(const Frame& F, int k) {
    const unsigned long long v = ((const LAS unsigned long long*)(F.lds + LDSCTL_OFF))[k];
    const unsigned lo = __builtin_amdgcn_readfirstlane((unsigned)v), hi = __builtin_amdgcn_readfirstlane((unsigned)(v >> 32));
    return (const float*)(const GAS float*)(((unsigned long long)hi << 32) | lo);
}

#ifndef PROBE_SUB
#define PROBE_SUB -1
#endif
#define SUBP(F, k) do { if (PROBE_SUB >= 0 && F.tid == 0) { if ((k) == PROBE_SUB) { const unsigned long long t_ = __builtin_amdgcn_s_memrealtime(); F.MISC[16] = (unsigned)t_; F.MISC[17] = (unsigned)(t_ >> 32); } \
    if ((k) == PROBE_SUB + 1) { const unsigned long long t0_ = ((unsigned long long)F.MISC[17] << 32) | F.MISC[16]; const unsigned long long a_ = (((unsigned long long)F.MISC[19] << 32) | F.MISC[18]) + (__builtin_amdgcn_s_memrealtime() - t0_); F.MISC[18] = (unsigned)a_; F.MISC[19] = (unsigned)(a_ >> 32); } } } while (0)
__device__ __forceinline__ float wave_sum(float v) {
#pragma unroll
    for (int o = 1; o < 64; o <<= 1) v += __shfl_xor(v, o);
    return v;
}

constexpr int I_IN = 32 * 272, I_OA = 16 * 64, I_OUT = 32 * 64, I_EX = 16 * 2048;
constexpr int N_SMALL_ITEMS = I_IN + 2 * I_OA + I_OUT, N_COPY_ITEMS = N_SMALL_ITEMS + 3 * I_EX;
struct CopyDesc { const float* src; bf16* dst; int ldw, ldt, hp, f8; };
__device__ __forceinline__ CopyDesc copy_desc(Frame& F, int it) {
    unsigned char* ws = F.ws; int r = it; CopyDesc d;
    d.hp = 0; d.f8 = 0;
    if (r < I_IN) { const int kb = r / 272, nb = r % 272, C0 = 32 * nb; d.src = inp(F, I_WIN) + (size_t)(64 * kb) * 8704 + C0; d.ldw = 8704; d.ldt = 2048;
        const bool headcols = C0 < 1536 || (C0 >= 6656 && C0 < 6912) || (C0 >= 7168 && C0 < 7680);
        if (headcols) { const int c0 = C0 & 127; d.hp = 1; d.dst = (bf16*)(ws + WS_WIN) + (size_t)((C0 & ~127) + 64 * (c0 >> 6) + 4 * ((c0 >> 5) & 1)) * 2048 + 64 * kb; }
        else if (C0 >= 2560 && C0 < 6656) { d.f8 = 1; d.dst = (bf16*)(ws + WS_WIN8 + (size_t)(C0 - 2560) * 2048 + 64 * kb); }
        else d.dst = (bf16*)(ws + WS_WIN) + (size_t)C0 * 2048 + 64 * kb;
        return d; } r -= I_IN;
    if (r < 2 * I_OA) { const int second = r >= I_OA; if (second) r -= I_OA; const int kb = r / 64, nb = r % 64; d.src = inp(F, second ? I_WOR : I_WOA) + (size_t)(64 * kb) * 2048 + 32 * nb; d.ldw = 2048;
        d.dst = (bf16*)(ws + WS_WOA) + (size_t)(32 * nb) * 2048 + second * 1024 + 64 * kb; d.ldt = 2048; return d; } r -= 2 * I_OA;
    if (r < I_OUT) { const int kb = r / 64, nb = r % 64; d.src = inp(F, I_WOUT) + (size_t)(64 * kb) * 2048 + 32 * nb; d.ldw = 2048; d.dst = (bf16*)(ws + WS_WOUT) + (size_t)(32 * nb) * 2048 + 64 * kb; d.ldt = 2048; return d; } r -= I_OUT;
    d.ldw = 2048; d.ldt = 2048;
    if (r < 2 * I_EX) { const int up = r >= I_EX; if (up) r -= I_EX; const int e = r >> 11, q = r & 2047, kb = q / 64, nb = q % 64, n0 = 32 * nb;
        d.src = inp(F, up ? I_WU : I_WG) + (size_t)e * 2048 * 2048 + (size_t)(64 * kb) * 2048 + n0; d.f8 = 1;
        d.dst = (bf16*)(ws + WS_WGU + (size_t)(e * 4096 + (n0 >> 7) * 256 + up * 128 + (n0 & 127)) * 2048 + 64 * kb); return d; } r -= 2 * I_EX;
    { const int e = r >> 11, q = r & 2047, kb = q / 64, nb = q % 64; d.src = inp(F, I_WD) + (size_t)e * 2048 * 2048 + (size_t)(64 * kb) * 2048 + 32 * nb; d.f8 = 1;
      d.dst = (bf16*)(ws + WS_WDN + (size_t)(e * 2048 + 32 * nb) * 2048 + 64 * kb); return d; }
}
template <int NI> __device__ __forceinline__ void copy_items(Frame& F, int it0, int stride, int it_end, LAS float* scr) {
    const int lane = F.lane; f32x4 wv[NI][8]; CopyDesc d[NI];
#pragma unroll
    for (int q = 0; q < NI; ++q) { const int it = it0 + q * stride; if (it < it_end) { d[q] = copy_desc(F, it);
#pragma unroll
            for (int i = 0; i < 8; ++i) wv[q][i] = __builtin_nontemporal_load((const f32x4*)(d[q].src + (size_t)((lane >> 3) + 8 * i) * d[q].ldw + 4 * (lane & 7))); } }
#pragma unroll
    for (int q = 0; q < NI; ++q) { const int it = it0 + q * stride; if (it < it_end) {
#pragma unroll
            for (int i = 0; i < 8; ++i) { LAS float* p = scr + ((lane >> 3) + 8 * i) * 33 + 4 * (lane & 7); p[0] = wv[q][i][0]; p[1] = wv[q][i][1]; p[2] = wv[q][i][2]; p[3] = wv[q][i][3]; }
            LDS_WAIT(); asm volatile("" ::: "memory");
            const int c = lane >> 3;
#pragma unroll
            for (int j = 0; j < 4; ++j) { const int n = (lane & 7) + 8 * j; const LAS float* sp = scr + (8 * c) * 33 + n;
                v4u o; o.x = pk2(sp[0 * 33], sp[1 * 33]); o.y = pk2(sp[2 * 33], sp[3 * 33]); o.z = pk2(sp[4 * 33], sp[5 * 33]); o.w = pk2(sp[6 * 33], sp[7 * 33]);
                const int nr = d[q].hp ? (32 * (n >> 4) + 8 * ((n >> 2) & 3) + (n & 3)) : n;
                if (d[q].f8) { v2u o8; o8.x = pg8::pk4_fp8(sp[0 * 33] * 64.f, sp[1 * 33] * 64.f, sp[2 * 33] * 64.f, sp[3 * 33] * 64.f); o8.y = pg8::pk4_fp8(sp[4 * 33] * 64.f, sp[5 * 33] * 64.f, sp[6 * 33] * 64.f, sp[7 * 33] * 64.f);
                    __builtin_nontemporal_store(o8, (GAS v2u*)((unsigned char*)d[q].dst + (size_t)nr * d[q].ldt + 8 * c)); }
                else __builtin_nontemporal_store(o, (GAS v4u*)(d[q].dst + (size_t)nr * d[q].ldt + 8 * c)); }
            LDS_WAIT(); asm volatile("" ::: "memory"); } }
}
#ifndef CONV_PER_XCD
#define CONV_PER_XCD 10
#endif
constexpr int COPY_CHUNK = 32;
constexpr int N_QUEUE_ITEMS = N_COPY_ITEMS - I_IN;
static_assert(N_QUEUE_ITEMS % COPY_CHUNK == 0, "copy queue");
__device__ __forceinline__ void copy_queue_drain(Frame& F) {
    unsigned* ctr = (unsigned*)(F.ctl + CW_QUEUE + 64 * 8);
    LAS float* scr = (LAS float*)(F.lds + 81920 + F.wave * 8704);
    if (F.tid == 0) F.MISC[24] = __hip_atomic_fetch_add(ctr, 1u, __ATOMIC_RELAXED, __HIP_MEMORY_SCOPE_AGENT);
    __syncthreads();
    unsigned ticket = F.MISC[24];
    while (ticket < (unsigned)(N_QUEUE_ITEMS / COPY_CHUNK)) {
        __syncthreads();
        unsigned nxt = 0u; if (F.tid == 0) nxt = __hip_atomic_fetch_add(ctr, 1u, __ATOMIC_RELAXED, __HIP_MEMORY_SCOPE_AGENT);
        const int base = I_IN + (int)ticket * COPY_CHUNK + F.wave;
        copy_items<4>(F, base, NWAVES, base + 4 * NWAVES, scr);
        if (F.tid == 0) F.MISC[24] = nxt;
        __syncthreads();
        ticket = F.MISC[24];
    }
    __syncthreads();
}
__device__ __forceinline__ void p0_prologue(Frame& F) {
    unsigned char* ws = F.ws;
    SUBP(F, 10);
    {
        LAS float* sl = (LAS float*)(F.lds);
        LAS float* red = (LAS float*)(F.lds + 40960);
        { const float* cp = inp(F, I_C); const float* cc = inp(F, I_CCTX); float v[20];
#pragma unroll
          for (int q = 0; q < 20; ++q) { const int i = F.tid + 512 * q; v[q] = i < 4 * 2048 ? cp[i] : cc[i - 4 * 2048]; }
#pragma unroll
          for (int q = 0; q < 20; ++q) sl[F.tid + 512 * q] = siluf_(v[q]); }
        __syncthreads();
        SUBP(F, 11);
        const int kg = F.tid >> 7, c4 = F.tid & 127;
        for (int u = F.vcu; u < 192; u += F.G) {
            const int kc = u / 24, nc = u % 24;
            f32x4 a0 = {0, 0, 0, 0}, a1 = a0, a2 = a0, a3 = a0, a4 = a0;
            const float* wp = inp(F, I_WMOD) + (size_t)(256 * kc + kg) * 12288 + 512 * nc + 4 * c4;
#pragma unroll 8
            for (int kk = 0; kk < 64; ++kk) {
                const f32x4 w = *(const f32x4*)(wp + (size_t)(4 * kk) * 12288); const int k = 256 * kc + 4 * kk + kg;
                a0 += w * sl[k]; a1 += w * sl[2048 + k]; a2 += w * sl[4096 + k]; a3 += w * sl[6144 + k]; a4 += w * sl[8192 + k];
            }
            *(LAS f32x4*)(red + (kg * 5 + 0) * 512 + 4 * c4) = a0; *(LAS f32x4*)(red + (kg * 5 + 1) * 512 + 4 * c4) = a1; *(LAS f32x4*)(red + (kg * 5 + 2) * 512 + 4 * c4) = a2;
            *(LAS f32x4*)(red + (kg * 5 + 3) * 512 + 4 * c4) = a3; *(LAS f32x4*)(red + (kg * 5 + 4) * 512 + 4 * c4) = a4;
            __syncthreads();
            float* mp = (float*)(ws + WS_MODP) + (size_t)kc * 5 * 12288 + 512 * nc;
            for (int i = F.tid; i < 5 * 512; i += 512) { const int b = i >> 9, n = i & 511; mp[b * 12288 + n] = red[(0 * 5 + b) * 512 + n] + red[(1 * 5 + b) * 512 + n] + red[(2 * 5 + b) * 512 + n] + red[(3 * 5 + b) * 512 + n]; }
            __syncthreads();
        }
    }
    SUBP(F, 12);
    if (F.vcu == F.G - 1) {
        float* tab = (float*)(ws + WS_ROPE);
        for (int i = F.tid; i < 64 * 32; i += 512) { const int p = i >> 5, j = i & 31; const float inv = powf(10000.0f, -(float)j / 32.0f); const float ang = (float)p * inv; tab[2 * i] = cosf(ang); tab[2 * i + 1] = sinf(ang); }
    }
    if (F.vcu == F.G - 2) { float* wt = (float*)(ws + WS_WRT); const float* wr = inp(F, I_WR);
#pragma unroll 1
        for (int i0 = F.tid; i0 < 2048 * 16; i0 += 512 * 16) { float v[16];
#pragma unroll
            for (int q = 0; q < 16; ++q) v[q] = wr[i0 + 512 * q];
#pragma unroll
            for (int q = 0; q < 16; ++q) { const int i = i0 + 512 * q; wt[(i & 15) * 2048 + (i >> 4)] = v[q]; } } }
    SUBP(F, 13);
    LAS float* scr = (LAS float*)(F.lds + 81920 + F.wave * 8704);
    for (int it = F.vcu * NWAVES + F.wave; it < I_IN; it += 4 * F.G * NWAVES) copy_items<4>(F, it, F.G * NWAVES, I_IN, scr);
    if (PROBE_SUB >= 0) { VM_WAIT(); __syncthreads(); }
    SUBP(F, 14);
}
__device__ __forceinline__ float mod_val(const Frame& F, int b, int n) {
    const float* mp = (const float*)(F.ws + WS_MODP) + (size_t)b * 12288 + n; float s = inp(F, I_BMOD)[n];
#pragma unroll
    for (int kc = 0; kc < 8; ++kc) s += mp[(size_t)kc * 5 * 12288];
    return s;
}
__device__ __forceinline__ void rms_mod_row(const float* xrow, bf16* orow, unsigned char* orow8, const LAS float* A, const LAS float* Bv, int lane) {
    const f32x4* xr = (const f32x4*)xrow + lane; f32x4 v[8]; float s = 0.f;
#pragma unroll
    for (int j = 0; j < 8; ++j) { v[j] = xr[64 * j]; s += (v[j].x * v[j].x + v[j].y * v[j].y) + (v[j].z * v[j].z + v[j].w * v[j].w); }
    const float r = 1.0f / sqrtf(wave_sum(s) * (1.0f / DM) + EPS);
    v2u* o8 = (v2u*)orow + lane;
#pragma unroll
    for (int j = 0; j < 8; ++j) { const f32x4 a = *(const LAS f32x4*)(A + 4 * (64 * j + lane)), b = *(const LAS f32x4*)(Bv + 4 * (64 * j + lane)); const f32x4 h = v[j] * r * a + b;
        v2u w; w.x = pk2(h.x, h.y); w.y = pk2(h.z, h.w); o8[64 * j] = w;
        if (orow8) ((unsigned*)orow8 + lane)[64 * j] = pg8::pk4_fp8(h.x * 4.f, h.y * 4.f, h.z * 4.f, h.w * 4.f); }
}
__device__ __forceinline__ void p1_h(Frame& F) {
    LAS float* A = (LAS float*)F.lds; LAS float* Bv = A + 2048; LAS float* Ac = A + 4096; LAS float* Bc = A + 6144;
    const int b = F.vcu & 3, sub = F.vcu >> 2, nsub = F.G >> 2;
#pragma unroll
    for (int k = F.tid; k < 2048; k += 512) { const float g = inp(F, I_PRE1)[k];
        A[k] = g * (1.0f + mod_val(F, b, 2048 + k)); Bv[k] = mod_val(F, b, k); Ac[k] = g * (1.0f + mod_val(F, 4, 2048 + k)); Bc[k] = mod_val(F, 4, k); }
    float* MOD = (float*)(F.ws + WS_MOD);
    for (int i = F.vcu * 512 + F.tid; i < 5 * 12288; i += F.G * 512) MOD[i] = mod_val(F, i / 12288, i % 12288);
    __syncthreads();
    bf16* H = (bf16*)(F.ws + WS_H);
    for (int t = sub * NWAVES + F.wave; t < T; t += nsub * NWAVES) { const size_t m = (size_t)b * T + t; rms_mod_row(inp(F, I_X) + m * DM, H + m * DM, F.ws + WS_H8 + m * DM, A, Bv, F.lane); }
    for (int r = F.vcu * NWAVES + F.wave; r < MC; r += F.G * NWAVES) rms_mod_row(inp(F, I_CTX) + (size_t)r * DM, H + (size_t)(M + r) * DM, nullptr, Ac, Bc, F.lane);
}

__device__ __forceinline__ void head_op(bf16* hp, int c, bool active, bool do_norm, const float* g, bool do_scale, bool do_rope, int prow, int pcol, const LAS float* tab) {
    v4u raw = {0u, 0u, 0u, 0u}; if (active) raw = *(const v4u*)(hp + 8 * c);
    float v[8] = {bflo(raw.x), bfhi(raw.x), bflo(raw.y), bfhi(raw.y), bflo(raw.z), bfhi(raw.z), bflo(raw.w), bfhi(raw.w)};
    float ss = 0.f;
#pragma unroll
    for (int i = 0; i < 8; ++i) ss += v[i] * v[i];
    ss += __shfl_xor(ss, 1); ss += __shfl_xor(ss, 2); ss += __shfl_xor(ss, 4); ss += __shfl_xor(ss, 8);
    const float r = 1.0f / sqrtf(ss * (1.0f / 128.0f) + EPS);
#pragma unroll
    for (int i = 0; i < 8; ++i) { float x = v[i]; if (do_norm) x = x * r * g[8 * c + i]; if (do_scale) x *= 0.08838834764831845f; v[i] = x; }
    const int a = c >> 3, p = (c >> 2) & 1, jb = (c & 3) * 8, pos = a ? pcol : prow;
    const LAS f32x4* tp = (const LAS f32x4*)(tab + (pos * 32 + jb) * 2);
    const f32x4 t0 = tp[0], t1 = tp[1], t2 = tp[2], t3 = tp[3];
    const float cs[8] = {t0[0], t0[2], t1[0], t1[2], t2[0], t2[2], t3[0], t3[2]}, sn[8] = {t0[1], t0[3], t1[1], t1[3], t2[1], t2[3], t3[1], t3[3]};
#pragma unroll
    for (int i = 0; i < 8; ++i) { const float pv = __shfl_xor(v[i], 4);
        if (do_rope) v[i] = p ? (v[i] * cs[i] + pv * sn[i]) : (v[i] * cs[i] - pv * sn[i]); }
    if (active) { v4u o; o.x = pk2(v[0], v[1]); o.y = pk2(v[2], v[3]); o.z = pk2(v[4], v[5]); o.w = pk2(v[6], v[7]); *(v4u*)(hp + 8 * c) = o; }
}
__device__ __forceinline__ void p3_rope(Frame& F) {
    unsigned char* ws = F.ws; LAS float* tab = (LAS float*)F.lds;
    { const f32x4* tg = (const f32x4*)(ws + WS_ROPE);
#pragma unroll
      for (int i = F.tid; i < 64 * 32 * 2 / 4; i += 512) *(LAS f32x4*)(tab + 4 * i) = tg[i]; }
    __syncthreads();
    const int gw = F.vcu * NWAVES + F.wave, NGW = F.G * NWAVES, grp = F.lane >> 4, c = F.lane & 15;
    for (int m = gw; m < M; m += NGW) {
        const int b = m >> 12, t = m & 4095, prow = t >> 6, pcol = t & 63; const size_t kvrow = (size_t)b * SKV + LC + t;
#pragma unroll
        for (int s = 0; s < 5; ++s) {
            const int slot = 4 * s + grp; const bool active = slot < 18;
            bf16* hp; bool do_norm = false, do_scale = false; const float* g = inp(F, I_QN);
            if (slot < 8) { hp = (bf16*)(ws + WS_QA) + (size_t)m * 1024 + slot * 128; do_norm = true; }
            else if (slot < 12) { hp = (bf16*)(ws + WS_QR) + (size_t)m * 512 + (slot - 8) * 128; }
            else if (slot < 14) { hp = (bf16*)(ws + WS_KA) + kvrow * 256 + (slot - 12) * 128; do_norm = true; g = inp(F, I_KN); }
            else { hp = (bf16*)(ws + WS_KR) + kvrow * 512 + ((slot - 14) & 3) * 128; do_scale = true; }
            head_op(hp, c, active, do_norm, g, do_scale, true, prow, pcol, tab);
        }
    }
    for (int r = gw; r < MC; r += NGW) {
        const int b = r >> 8, l = r & 255; const size_t kvrow = (size_t)b * SKV + l;
#pragma unroll
        for (int s = 0; s < 2; ++s) {
            const int slot = 4 * s + grp; const bool active = slot < 6;
            bf16* hp; bool do_norm = false, do_scale = false;
            if (slot < 2) { hp = (bf16*)(ws + WS_KA) + kvrow * 256 + slot * 128; do_norm = true; }
            else { hp = (bf16*)(ws + WS_KR) + kvrow * 512 + ((slot - 2) & 3) * 128; do_scale = true; }
            head_op(hp, c, active, do_norm, inp(F, I_KN), do_scale, false, 0, 0, tab);
        }
    }
}

__device__ __forceinline__ float softplusf_(float x) { return x > 20.f ? x : log1pf(expf(x)); }
__device__ __forceinline__ float log_gamma(const Frame& F, int dir, int h) { return -softplusf_(inp(F, I_DECAY)[dir * 4 + h]); }

__device__ __forceinline__ void p4_chunk_states(Frame& F) {
    unsigned char* ws = F.ws;
    LAS bf16* Ks = (LAS bf16*)F.lds;
    LAS bf16* Vs = (LAS bf16*)(F.lds + 32768);
    for (int u = F.vcu; u < NB * 4 * 34; u += F.G) {
        int tid = F.tid; asm volatile("" : "+v"(tid));
        const int td = tid & 15, tv = tid >> 4;
        const int cidx = u % 34, h = (u / 34) & 3, b = u / (34 * 4);
        const float lgf = log_gamma(F, 0, h), lgb = log_gamma(F, 1, h);
        const size_t row0 = (size_t)b * SKV + 128 * cidx;
        const bf16* Kg = (const bf16*)(ws + WS_KR) + row0 * 512 + h * 128; const bf16* Vg = (const bf16*)(ws + WS_VR) + row0 * 1024 + h * 256;
        for (int i = tid; i < 128 * 16; i += 512) { const int j = i >> 4, cc = i & 15; *(LAS v4u*)(Ks + j * 128 + 8 * cc) = *(const v4u*)(Kg + (size_t)j * 512 + 8 * cc); }
        for (int i = tid; i < 128 * 32; i += 512) { const int j = i >> 5, cc = i & 31; *(LAS v4u*)(Vs + j * 256 + 8 * cc) = *(const v4u*)(Vg + (size_t)j * 1024 + 8 * cc); }
        __syncthreads();
        float af[8][8], ab[8][8];
#pragma unroll
        for (int x = 0; x < 8; ++x)
#pragma unroll
            for (int y = 0; y < 8; ++y) { af[x][y] = 0.f; ab[x][y] = 0.f; }
        for (int j = 0; j < 128; ++j) {
            const v4u kr = *(const LAS v4u*)(Ks + j * 128 + 8 * td), vr = *(const LAS v4u*)(Vs + j * 256 + 8 * tv);
            const float wf = __expf(lgf * (float)(127 - j)), wb = __expf(lgb * (float)j);
            const float kk[8] = {bflo(kr.x), bfhi(kr.x), bflo(kr.y), bfhi(kr.y), bflo(kr.z), bfhi(kr.z), bflo(kr.w), bfhi(kr.w)};
            const float vv[8] = {bflo(vr.x), bfhi(vr.x), bflo(vr.y), bfhi(vr.y), bflo(vr.z), bfhi(vr.z), bflo(vr.w), bfhi(vr.w)};
#pragma unroll
            for (int x = 0; x < 8; ++x) { const float vf = vv[x] * wf, vbk = vv[x] * wb;
#pragma unroll
                for (int y = 0; y < 8; ++y) { af[x][y] += vf * kk[y]; ab[x][y] += vbk * kk[y]; } }
        }
        bf16* Uf = (bf16*)(ws + WS_U) + ((((size_t)(b * 4 + h) * 2 + 0) * 34 + cidx) * 256) * 128; bf16* Ub = Uf + (size_t)34 * 256 * 128;
#pragma unroll
        for (int x = 0; x < 8; ++x) { v4u o; o.x = pk2(af[x][0], af[x][1]); o.y = pk2(af[x][2], af[x][3]); o.z = pk2(af[x][4], af[x][5]); o.w = pk2(af[x][6], af[x][7]); *(v4u*)(Uf + (size_t)(8 * tv + x) * 128 + 8 * td) = o;
            o.x = pk2(ab[x][0], ab[x][1]); o.y = pk2(ab[x][2], ab[x][3]); o.z = pk2(ab[x][4], ab[x][5]); o.w = pk2(ab[x][6], ab[x][7]); *(v4u*)(Ub + (size_t)(8 * tv + x) * 128 + 8 * td) = o; }
        __syncthreads();
    }
}
namespace ret {
using att::bf16x8; using att::s16x4; using att::f32x16; using att::u32x4;
template <int OFF> __device__ __forceinline__ void vfrag_issue(int vb, s16x4& l, s16x4& h) { l = att::tr_read<OFF>(vb); h = att::tr_read<OFF + 2048>(vb); }
__device__ __forceinline__ bf16x8 vfrag_pack(const s16x4& l, const s16x4& h) { return (bf16x8){l[0], l[1], l[2], l[3], h[0], h[1], h[2], h[3]}; }
#define RET_PK4(P, BASE, OUT) do { unsigned a0 = att::cvtpk(P[BASE + 0], P[BASE + 1]), a1 = att::cvtpk(P[BASE + 2], P[BASE + 3]);   \
    unsigned b0 = att::cvtpk(P[BASE + 4], P[BASE + 5]), b1 = att::cvtpk(P[BASE + 6], P[BASE + 7]);                              \
    auto r0 = __builtin_amdgcn_permlane32_swap(a0, b0, false, false); auto r1 = __builtin_amdgcn_permlane32_swap(a1, b1, false, false); \
    att::u32x4 w = {r0[0], r1[0], r0[1], r1[1]}; OUT = *reinterpret_cast<att::bf16x8*>(&w); } while (0)
__device__ __forceinline__ bf16x8 scale8(const bf16x8& q, float w) {
    const u32x4 u = *reinterpret_cast<const u32x4*>(&q); u32x4 o;
    o.x = att::cvtpk(__uint_as_float(u.x << 16) * w, __uint_as_float(u.x & 0xffff0000u) * w); o.y = att::cvtpk(__uint_as_float(u.y << 16) * w, __uint_as_float(u.y & 0xffff0000u) * w);
    o.z = att::cvtpk(__uint_as_float(u.z << 16) * w, __uint_as_float(u.z & 0xffff0000u) * w); o.w = att::cvtpk(__uint_as_float(u.w << 16) * w, __uint_as_float(u.w & 0xffff0000u) * w);
    return *reinterpret_cast<const bf16x8*>(&o);
}
template <int KH, int KS> __device__ __forceinline__ void p4_step(f32x16 (&acc)[2][4], int vbase, int vbv) {
    s16x4 bl, bh, al[4], ah[4];
    vfrag_issue<KH * 32768 + KS * 4096>(vbv, bl, bh);
#define RET_A(dir, db) vfrag_issue<(dir) * 32768 + KH * 16384 + (db) * 512 + KS * 4096>(vbase, al[db], ah[db])
    RET_A(0, 0); RET_A(0, 1); RET_A(0, 2); RET_A(0, 3);
    asm volatile("s_waitcnt lgkmcnt(0)" ::: "memory"); __builtin_amdgcn_sched_barrier(0);
    const bf16x8 B = vfrag_pack(bl, bh);
#pragma unroll
    for (int db = 0; db < 4; ++db) acc[0][db] = __builtin_amdgcn_mfma_f32_32x32x16_bf16(vfrag_pack(al[db], ah[db]), B, acc[0][db], 0, 0, 0);
    __builtin_amdgcn_sched_barrier(0);
    RET_A(1, 0); RET_A(1, 1); RET_A(1, 2); RET_A(1, 3);
#undef RET_A
    asm volatile("s_waitcnt lgkmcnt(0)" ::: "memory"); __builtin_amdgcn_sched_barrier(0);
#pragma unroll
    for (int db = 0; db < 4; ++db) acc[1][db] = __builtin_amdgcn_mfma_f32_32x32x16_bf16(vfrag_pack(al[db], ah[db]), B, acc[1][db], 0, 0, 0);
}
template <int KT, int D0> __device__ __forceinline__ void p6_pv(f32x16& od, int vbv, const bf16x8& pa0, const bf16x8& pa1, const bf16x8& pa2, const bf16x8& pa3) {
    s16x4 l0, h0, l1, h1, l2, h2, l3, h3;
    vfrag_issue<KT * 32768 + D0 * 512 + 0 * 4096>(vbv, l0, h0); vfrag_issue<KT * 32768 + D0 * 512 + 1 * 4096>(vbv, l1, h1);
    vfrag_issue<KT * 32768 + D0 * 512 + 2 * 4096>(vbv, l2, h2); vfrag_issue<KT * 32768 + D0 * 512 + 3 * 4096>(vbv, l3, h3);
    asm volatile("s_waitcnt lgkmcnt(0)" ::: "memory"); __builtin_amdgcn_sched_barrier(0);
    od = __builtin_amdgcn_mfma_f32_32x32x16_bf16(vfrag_pack(l0, h0), pa0, od, 0, 0, 0);
    od = __builtin_amdgcn_mfma_f32_32x32x16_bf16(vfrag_pack(l1, h1), pa1, od, 0, 0, 0);
    od = __builtin_amdgcn_mfma_f32_32x32x16_bf16(vfrag_pack(l2, h2), pa2, od, 0, 0, 0);
    od = __builtin_amdgcn_mfma_f32_32x32x16_bf16(vfrag_pack(l3, h3), pa3, od, 0, 0, 0);
}
}

__device__ __forceinline__ void p4_chunk_states_mfma(Frame& F, char* lds_generic) {
    unsigned char* ws = F.ws;
    const int NU = NB * 4 * 34;
    int tid0 = F.tid; asm volatile("" : "+v"(tid0));
    v4u kreg[4], vreg[8];
#define P4_LOAD(uu) do { const int cidx_ = (uu) % 34, h_ = ((uu) / 34) & 3, b_ = (uu) / (34 * 4); const size_t row0_ = (size_t)b_ * SKV + 128 * cidx_; \
        const bf16* Kg_ = (const bf16*)(ws + WS_KR) + row0_ * 512 + h_ * 128; const bf16* Vg_ = (const bf16*)(ws + WS_VR) + row0_ * 1024 + h_ * 256; \
        _Pragma("unroll") for (int it = 0; it < 4; ++it) { const int i = tid0 + 512 * it; kreg[it] = *(const v4u*)(Kg_ + (size_t)(i >> 4) * 512 + 8 * (i & 15)); } \
        _Pragma("unroll") for (int it = 0; it < 8; ++it) { const int i = tid0 + 512 * it; vreg[it] = *(const v4u*)(Vg_ + (size_t)(i >> 5) * 1024 + 8 * (i & 31)); } } while (0)
    if (F.vcu < NU) P4_LOAD(F.vcu);
    for (int u = F.vcu; u < NU; u += F.G) {
        int tid = F.tid; asm volatile("" : "+v"(tid));
        const int lane = tid & 63, wave = __builtin_amdgcn_readfirstlane(tid >> 6), r32 = lane & 31, hi = lane >> 5;
        const int cidx = u % 34, h = (u / 34) & 3, b = u / (34 * 4);
        const float lgf = log_gamma(F, 0, h), lgb = log_gamma(F, 1, h);
#pragma unroll
        for (int it = 0; it < 4; ++it) { const int i = tid + 512 * it, j = i >> 4, cc = i & 15;
            const v4u k = kreg[it];
            const float wf = __expf(lgf * (float)(127 - j)), wb = __expf(lgb * (float)j);
            const float kk[8] = {bflo(k.x), bfhi(k.x), bflo(k.y), bfhi(k.y), bflo(k.z), bfhi(k.z), bflo(k.w), bfhi(k.w)};
            v4u of, ob; of.x = pk2(kk[0] * wf, kk[1] * wf); of.y = pk2(kk[2] * wf, kk[3] * wf); of.z = pk2(kk[4] * wf, kk[5] * wf); of.w = pk2(kk[6] * wf, kk[7] * wf);
            ob.x = pk2(kk[0] * wb, kk[1] * wb); ob.y = pk2(kk[2] * wb, kk[3] * wb); ob.z = pk2(kk[4] * wb, kk[5] * wb); ob.w = pk2(kk[6] * wb, kk[7] * wb);
            const int off = (j >> 6) * 16384 + att::v_st(j & 63, 8 * cc);
            *(v4u*)(lds_generic + off) = of; *(v4u*)(lds_generic + 32768 + off) = ob; }
#pragma unroll
        for (int it = 0; it < 8; ++it) { const int i = tid + 512 * it, j = i >> 5, cc = i & 31;
            *(v4u*)(lds_generic + 65536 + ((j >> 6) * 2 + (cc >> 4)) * 16384 + att::v_st(j & 63, 8 * (cc & 15))) = vreg[it]; }
        __syncthreads();
        if (u + F.G < NU) P4_LOAD(u + F.G);
        const int vh = wave >> 2, d0v = wave & 3;
        const int vbase = (int)(uintptr_t)lds_generic + att::v_rd_base(lane), vbv = vbase + 65536 + vh * 16384 + d0v * 512;
        att::f32x16 acc[2][4];
#pragma unroll
        for (int dir = 0; dir < 2; ++dir)
#pragma unroll
            for (int db = 0; db < 4; ++db) acc[dir][db] = att::f32x16{};
        ret::p4_step<0, 0>(acc, vbase, vbv); ret::p4_step<0, 1>(acc, vbase, vbv); ret::p4_step<0, 2>(acc, vbase, vbv); ret::p4_step<0, 3>(acc, vbase, vbv);
        ret::p4_step<1, 0>(acc, vbase, vbv); ret::p4_step<1, 1>(acc, vbase, vbv); ret::p4_step<1, 2>(acc, vbase, vbv); ret::p4_step<1, 3>(acc, vbase, vbv);
        const int v = 128 * vh + 32 * d0v + r32;
        __syncthreads();
#pragma unroll
        for (int dir = 0; dir < 2; ++dir)
#pragma unroll
            for (int db = 0; db < 4; ++db)
#pragma unroll
                for (int g4 = 0; g4 < 4; ++g4) { v2u o; o.x = pk2(acc[dir][db][4 * g4] + 0.0f, acc[dir][db][4 * g4 + 1] + 0.0f); o.y = pk2(acc[dir][db][4 * g4 + 2] + 0.0f, acc[dir][db][4 * g4 + 3] + 0.0f);
                    *(v2u*)(lds_generic + (dir * 256 + v) * 272 + (32 * db + 8 * g4 + 4 * hi) * 2) = o; }
        __syncthreads();
        { bf16* Ub = (bf16*)(ws + WS_U) + (((size_t)(b * 4 + h) * 2) * 34 + cidx) * 32768;
#pragma unroll
          for (int it = 0; it < 16; ++it) { const int row = 64 * wave + 4 * it + (lane >> 4), dir = row >> 8, vv = row & 255;
              const v4u w = *(const v4u*)(lds_generic + row * 272 + (lane & 15) * 16);
              *(v4u*)(Ub + (size_t)dir * 34 * 32768 + (size_t)vv * 128 + 8 * (lane & 15)) = w; } }
        __syncthreads();
    }
#undef P4_LOAD
}

__device__ __forceinline__ void p6_ret_out_mfma(Frame& F, char* lds_generic) {
    unsigned char* ws = F.ws;
    float* XS = (float*)(lds_generic + 147456);
    for (int u = F.vcu; u < NB * 4 * 32; u += F.G) {
        int tid = F.tid; asm volatile("" : "+v"(tid));
        const int lane = tid & 63, wave = __builtin_amdgcn_readfirstlane(tid >> 6), r32 = lane & 31, hi = lane >> 5;
        const int n = u & 31, h = (u >> 5) & 3, b = u >> 7;
        const float lgf = log_gamma(F, 0, h), lgb = log_gamma(F, 1, h);
        const size_t qrow0 = (size_t)b * T + 128 * n, krow0 = (size_t)b * SKV + LC + 128 * n;
        const bf16* Qg = (const bf16*)(ws + WS_QR) + qrow0 * 512 + h * 128; const bf16* Kg = (const bf16*)(ws + WS_KR) + krow0 * 512 + h * 128;
        const bf16* Vg = (const bf16*)(ws + WS_VR) + krow0 * 1024 + h * 256;
        const int qb = wave & 3, vh = wave >> 2, iq = 32 * qb + r32;
        SUBP(F, 0);
        v4u kreg[4], vreg[8]; att::bf16x8 qr[8];
#pragma unroll
        for (int it = 0; it < 4; ++it) { const int i = tid + 512 * it, j = i >> 4, cc = i & 15; kreg[it] = *(const v4u*)(Kg + (size_t)j * 512 + 8 * cc); }
#pragma unroll
        for (int it = 0; it < 8; ++it) { const int i = tid + 512 * it, j = i >> 5, cc = i & 31; vreg[it] = *(const v4u*)(Vg + (size_t)j * 1024 + 8 * cc); }
        { const bf16* Qw = Qg + (size_t)iq * 512 + hi * 8;
#pragma unroll
          for (int d0 = 0; d0 < 8; ++d0) qr[d0] = *reinterpret_cast<const att::bf16x8*>(Qw + d0 * 16); }
        {
            const bf16* STu = (const bf16*)(ws + WS_ST) + (((size_t)(b * 4 + h) * 2) * 32 + n) * 32768;
#pragma unroll
            for (int k = 0; k < 16; ++k) { const int idx = wave + 8 * k, dir = idx >> 6, row = 4 * (idx & 63) + (lane >> 4), slot = lane & 15;
                const bf16* src = STu + (size_t)dir * 32 * 32768 + (size_t)row * 128 + 8 * (slot ^ (row & 7));
                __builtin_amdgcn_global_load_lds((const unsigned*)src, (LAS unsigned*)(F.lds + idx * 1024), 16, 0, 0); }
        }
        asm volatile("s_waitcnt vmcnt(0)" ::: "memory");
        __syncthreads();
        SUBP(F, 1);
        att::f32x16 o[4] = {};
        {
            const float wqf = __expf(lgf * (float)(iq + 1)), wqr = __expf(lgb * (float)(128 - iq) - lgf * (float)(iq + 1));
#pragma unroll
            for (int dir = 0; dir < 2; ++dir) {
#pragma unroll
                for (int ds = 0; ds < 8; ++ds) qr[ds] = ret::scale8(qr[ds], dir == 0 ? wqf : wqr);
#pragma unroll
                for (int vblk = 0; vblk < 4; ++vblk) { const int row = 128 * vh + 32 * vblk + r32;
#pragma unroll
                    for (int ds = 0; ds < 8; ++ds) { const att::bf16x8 a = *reinterpret_cast<const att::bf16x8*>(lds_generic + dir * 65536 + row * 256 + (((hi * 8 + ds) * 16) ^ ((row & 7) << 4)));
                        o[vblk] = __builtin_amdgcn_mfma_f32_32x32x16_bf16(a, qr[ds], o[vblk], 0, 0, 0); }
                    __builtin_amdgcn_sched_barrier(0); }
            }
        }
        { const bf16* Qw = Qg + (size_t)iq * 512 + hi * 8;
#pragma unroll
          for (int d0 = 0; d0 < 8; ++d0) qr[d0] = *reinterpret_cast<const att::bf16x8*>(Qw + d0 * 16); }
        __syncthreads();
        SUBP(F, 2);
#pragma unroll
        for (int it = 0; it < 4; ++it) { const int i = tid + 512 * it, j = i >> 4, cc = i & 15; *(v4u*)(lds_generic + KSWZ(j, 16 * cc)) = kreg[it]; }
#pragma unroll
        for (int it = 0; it < 8; ++it) { const int i = tid + 512 * it, j = i >> 5, cc = i & 31;
            *(v4u*)(lds_generic + 32768 + ((j >> 6) * 2 + (cc >> 4)) * 16384 + att::v_st(j & 63, 8 * (cc & 15))) = vreg[it]; }
        __syncthreads();
        SUBP(F, 3);
        att::bf16x8 pa[2][4];
#pragma unroll
        for (int kb = 0; kb < 4; ++kb) {
            att::f32x16 p = att::f32x16{};
#pragma unroll
            for (int d0 = 0; d0 < 8; ++d0) { const int cb = (d0 * 16 + hi * 8) * 2;
                const att::bf16x8 a = *reinterpret_cast<const att::bf16x8*>(lds_generic + KSWZ(32 * kb + r32, cb));
                p = __builtin_amdgcn_mfma_f32_32x32x16_bf16(a, qr[d0], p, 0, 0, 0); }
#pragma unroll
            for (int r = 0; r < 16; ++r) { const int j = 32 * kb + att::crow(r, hi); const float df = (float)(iq - j);
                const float w = df > 0.f ? __expf(lgf * df) : (df < 0.f ? __expf(-lgb * df) : 2.0f); p[r] *= w; }
            if (kb & 1) { RET_PK4(p, 0, pa[kb >> 1][2]); RET_PK4(p, 8, pa[kb >> 1][3]); } else { RET_PK4(p, 0, pa[kb >> 1][0]); RET_PK4(p, 8, pa[kb >> 1][1]); }
        }
        const int vbv = (int)(uintptr_t)lds_generic + att::v_rd_base(lane) + 32768 + vh * 16384;
        ret::p6_pv<0, 0>(o[0], vbv, pa[0][0], pa[0][1], pa[0][2], pa[0][3]); ret::p6_pv<0, 1>(o[1], vbv, pa[0][0], pa[0][1], pa[0][2], pa[0][3]);
        ret::p6_pv<0, 2>(o[2], vbv, pa[0][0], pa[0][1], pa[0][2], pa[0][3]); ret::p6_pv<0, 3>(o[3], vbv, pa[0][0], pa[0][1], pa[0][2], pa[0][3]);
        ret::p6_pv<1, 0>(o[0], vbv, pa[1][0], pa[1][1], pa[1][2], pa[1][3]); ret::p6_pv<1, 1>(o[1], vbv, pa[1][0], pa[1][1], pa[1][2], pa[1][3]);
        ret::p6_pv<1, 2>(o[2], vbv, pa[1][0], pa[1][1], pa[1][2], pa[1][3]); ret::p6_pv<1, 3>(o[3], vbv, pa[1][0], pa[1][1], pa[1][2], pa[1][3]);
        SUBP(F, 4);
        __syncthreads();
        { const bf16* GRt = (const bf16*)(ws + WS_GR) + qrow0 * 1024 + h * 256;
#pragma unroll
          for (int k = 0; k < 8; ++k) { const int pr = wave + 8 * k, row = 2 * pr + (lane >> 5);
              __builtin_amdgcn_global_load_lds((const unsigned*)(GRt + (size_t)row * 1024 + 8 * (lane & 31)), (LAS unsigned*)(F.lds + pr * 1040), 16, 0, 0); } }
        float s1 = 0.f, s2 = 0.f;
#pragma unroll
        for (int vblk = 0; vblk < 4; ++vblk)
#pragma unroll
            for (int r = 0; r < 16; ++r) { s1 += o[vblk][r]; s2 += o[vblk][r] * o[vblk][r]; }
        s1 += __shfl_xor(s1, 32); s2 += __shfl_xor(s2, 32);
        if (hi == 0) { XS[(wave * 32 + r32) * 2] = s1; XS[(wave * 32 + r32) * 2 + 1] = s2; }
        asm volatile("s_waitcnt vmcnt(0)" ::: "memory");
        __syncthreads();
        s1 += XS[((wave ^ 4) * 32 + r32) * 2]; s2 += XS[((wave ^ 4) * 32 + r32) * 2 + 1];
        const float mu = s1 * (1.0f / 256.0f); const float var = fmaxf(s2 * (1.0f / 256.0f) - mu * mu, 0.f); const float rstd = 1.0f / sqrtf(var + EPS);
        const float* gn = inp(F, I_GN) + h * 256 + 128 * vh + 4 * hi;
        const int rowoff = (iq >> 1) * 1040 + (iq & 1) * 512 + (128 * vh + 4 * hi) * 2;
#pragma unroll
        for (int vblk = 0; vblk < 4; ++vblk)
#pragma unroll
            for (int g4 = 0; g4 < 4; ++g4) { const int vo = 32 * vblk + 8 * g4;
                const f32x4 g = *(const f32x4*)(gn + vo); const v2u gr = *(const v2u*)(lds_generic + rowoff + vo * 2);
                const float y0 = (o[vblk][4 * g4] - mu) * rstd * g[0] * siluf_(bflo(gr.x)), y1 = (o[vblk][4 * g4 + 1] - mu) * rstd * g[1] * siluf_(bfhi(gr.x));
                const float y2 = (o[vblk][4 * g4 + 2] - mu) * rstd * g[2] * siluf_(bflo(gr.y)), y3 = (o[vblk][4 * g4 + 3] - mu) * rstd * g[3] * siluf_(bfhi(gr.y));
                v2u w; w.x = pk2(y0, y1); w.y = pk2(y2, y3); *(v2u*)(lds_generic + 69632 + rowoff + vo * 2) = w; }
        __syncthreads();
        { bf16* Ot = (bf16*)(ws + WS_O) + qrow0 * 2048 + 1024 + h * 256;
#pragma unroll
          for (int k = 0; k < 8; ++k) { const int pr = wave + 8 * k, row = 2 * pr + (lane >> 5);
              *(v4u*)(Ot + (size_t)row * 2048 + 8 * (lane & 31)) = *(const v4u*)(lds_generic + 69632 + pr * 1040 + lane * 16); } }
        if (PROBE_SUB >= 0) asm volatile("s_waitcnt vmcnt(0)" ::: "memory");
        __syncthreads();
        SUBP(F, 5);
    }
}

__device__ __forceinline__ void p5_scan(Frame& F) {
    unsigned char* ws = F.ws;
    for (int it = F.vcu * 512 + F.tid; it < 32 * 4096; it += F.G * 512) {
        const int e8 = it & 4095, bhd = it >> 12, dir = bhd & 1, h = (bhd >> 1) & 3;
        const float g = __expf(128.0f * log_gamma(F, dir, h));
        const bf16* U = (const bf16*)(ws + WS_U) + (size_t)bhd * 34 * 32768 + 8 * e8; bf16* ST = (bf16*)(ws + WS_ST) + (size_t)bhd * 32 * 32768 + 8 * ((e8 & ~15) | ((e8 & 1) << 3) | ((e8 & 15) >> 1));
        float s[8];
#pragma unroll
        for (int i = 0; i < 8; ++i) s[i] = 0.f;
#pragma unroll 1
        for (int half = 0; half < 2; ++half) {
            v4u ur[17];
#pragma unroll
            for (int k = 0; k < 17; ++k) { const int stp = 17 * half + k; const int cidx = dir == 0 ? stp : (stp < 2 ? 1 - stp : 35 - stp); ur[k] = *(const v4u*)(U + (size_t)cidx * 32768); }
#pragma unroll
            for (int k = 0; k < 17; ++k) { const int stp = 17 * half + k; const int cidx = dir == 0 ? stp : (stp < 2 ? 1 - stp : 35 - stp);
                if (stp >= 2) { v4u o; o.x = pk2(s[0], s[1]); o.y = pk2(s[2], s[3]); o.z = pk2(s[4], s[5]); o.w = pk2(s[6], s[7]); *(v4u*)(ST + (size_t)(cidx - 2) * 32768) = o; }
                const float uu[8] = {bflo(ur[k].x), bfhi(ur[k].x), bflo(ur[k].y), bfhi(ur[k].y), bflo(ur[k].z), bfhi(ur[k].z), bflo(ur[k].w), bfhi(ur[k].w)};
#pragma unroll
                for (int i = 0; i < 8; ++i) s[i] = g * s[i] + uu[i]; }
        }
    }
}
__device__ __forceinline__ void p5_attention(Frame& F, char* lds_generic) {
    unsigned char* ws = F.ws;
    for (int u = F.vcu; u < NB * 8 * 16; u += F.G) {
        const int qb = u & 15, hq = (u >> 4) & 7, b = u >> 7, kvh = hq >> 2;
        const bf16* Q = (const bf16*)(ws + WS_QA) + ((size_t)b * T + qb * 256) * 1024 + hq * 128;
        const bf16* K = (const bf16*)(ws + WS_KA) + (size_t)b * SKV * 256 + kvh * 128; const bf16* V = (const bf16*)(ws + WS_VA) + (size_t)b * SKV * 256 + kvh * 128;
        bf16* O = (bf16*)(ws + WS_O) + ((size_t)b * T + qb * 256) * 2048 + hq * 128;
        att::attn_dense_body(Q, K, V, O, SKV, lds_generic, F.tid);
    }
}
__device__ __forceinline__ void p6_ret_out(Frame& F) {
    unsigned char* ws = F.ws;
    LAS bf16* QT = (LAS bf16*)F.lds;
    LAS float* PT = (LAS float*)(F.lds + 32768);
    LAS bf16* KT = (LAS bf16*)(F.lds + 98304);
    LAS float* RS = (LAS float*)(F.lds + 98304);
    for (int u = F.vcu; u < NB * 4 * 32; u += F.G) {
        int tid = F.tid; asm volatile("" : "+v"(tid));
        const int n = u & 31, h = (u >> 5) & 3, b = u >> 7;
        const float lgf = log_gamma(F, 0, h), lgb = log_gamma(F, 1, h);
        const size_t qrow0 = (size_t)b * T + 128 * n, krow0 = (size_t)b * SKV + LC + 128 * n;
        const bf16* Qg = (const bf16*)(ws + WS_QR) + qrow0 * 512 + h * 128; const bf16* Kg = (const bf16*)(ws + WS_KR) + krow0 * 512 + h * 128;
        const bf16* Vg = (const bf16*)(ws + WS_VR) + krow0 * 1024 + h * 256;
        for (int i = tid; i < 128 * 16; i += 512) { const int r = i & 127, cc = i >> 7;
            const v4u q = *(const v4u*)(Qg + (size_t)r * 512 + 8 * cc), k = *(const v4u*)(Kg + (size_t)r * 512 + 8 * cc);
            const unsigned qq[4] = {q.x, q.y, q.z, q.w}, kk[4] = {k.x, k.y, k.z, k.w};
#pragma unroll
            for (int x = 0; x < 4; ++x) { QT[(8 * cc + 2 * x) * 128 + r] = (bf16)(qq[x] & 0xffffu); QT[(8 * cc + 2 * x + 1) * 128 + r] = (bf16)(qq[x] >> 16);
                KT[(8 * cc + 2 * x) * 128 + r] = (bf16)(kk[x] & 0xffffu); KT[(8 * cc + 2 * x + 1) * 128 + r] = (bf16)(kk[x] >> 16); } }
        __syncthreads();
        {
            const int ti = tid & 31, tj = tid >> 5;
            float s[4][8];
#pragma unroll
            for (int x = 0; x < 4; ++x)
#pragma unroll
                for (int y = 0; y < 8; ++y) s[x][y] = 0.f;
            for (int d = 0; d < 128; ++d) {
                const v2u qr = *(const LAS v2u*)(QT + d * 128 + 4 * ti); const v4u kr = *(const LAS v4u*)(KT + d * 128 + 8 * tj);
                const float qv[4] = {bflo(qr.x), bfhi(qr.x), bflo(qr.y), bfhi(qr.y)};
                const float kv[8] = {bflo(kr.x), bfhi(kr.x), bflo(kr.y), bfhi(kr.y), bflo(kr.z), bfhi(kr.z), bflo(kr.w), bfhi(kr.w)};
#pragma unroll
                for (int x = 0; x < 4; ++x)
#pragma unroll
                    for (int y = 0; y < 8; ++y) s[x][y] += qv[x] * kv[y];
                __builtin_amdgcn_sched_barrier(0);
            }
#pragma unroll
            for (int y = 0; y < 8; ++y) { const int j = 8 * tj + y; f32x4 o;
#pragma unroll
                for (int x = 0; x < 4; ++x) { const int i = 4 * ti + x; const float w = i > j ? __expf(lgf * (float)(i - j)) : (i < j ? __expf(lgb * (float)(j - i)) : 2.0f); o[x] = s[x][y] * w; }
                *(LAS f32x4*)(PT + j * 128 + 4 * ti) = o; }
        }
        __syncthreads();
        {
            const int i2 = (tid & 63) * 2;
            const float f0 = __expf(lgf * (float)(i2 + 1)), f1 = __expf(lgf * (float)(i2 + 2)), b0 = __expf(lgb * (float)(128 - i2)), b1 = __expf(lgb * (float)(127 - i2));
            for (int d = tid >> 6; d < 128; d += 8) { const unsigned w = *(const LAS unsigned*)(QT + d * 128 + i2); const float q0 = bflo(w), q1 = bfhi(w);
                *(LAS unsigned*)(QT + d * 128 + i2) = pk2(q0 * f0, q1 * f1); *(LAS unsigned*)(KT + d * 128 + i2) = pk2(q0 * b0, q1 * b1); }
        }
        __syncthreads();
        const int ib = tid & 15, vb = tid >> 4;
        float o[8][8];
#pragma unroll
        for (int x = 0; x < 8; ++x)
#pragma unroll
            for (int y = 0; y < 8; ++y) o[x][y] = 0.f;
#pragma unroll 2
        for (int j = 0; j < 128; ++j) {
            const f32x4 p0 = *(const LAS f32x4*)(PT + j * 128 + 8 * ib), p1 = *(const LAS f32x4*)(PT + j * 128 + 8 * ib + 4);
            const v4u vr = *(const v4u*)(Vg + (size_t)j * 1024 + 8 * vb);
            const float pv[8] = {p0[0], p0[1], p0[2], p0[3], p1[0], p1[1], p1[2], p1[3]};
            const float vv[8] = {bflo(vr.x), bfhi(vr.x), bflo(vr.y), bfhi(vr.y), bflo(vr.z), bfhi(vr.z), bflo(vr.w), bfhi(vr.w)};
#pragma unroll
            for (int x = 0; x < 8; ++x)
#pragma unroll
                for (int y = 0; y < 8; ++y) o[x][y] += pv[x] * vv[y];
        }
        LAS bf16* STt = (LAS bf16*)(F.lds + 32768);
#pragma unroll 1
        for (int dir = 0; dir < 2; ++dir) {
            __syncthreads();
            const bf16* STg = (const bf16*)(ws + WS_ST) + ((((size_t)(b * 4 + h) * 2 + dir) * 32 + n) * 256) * 128;
            for (int i = tid; i < 256 * 16; i += 512) { const int v = i >> 4, cc = i & 15; const v4u w = *(const v4u*)(STg + (size_t)v * 128 + 8 * (((cc & 1) << 3) | (cc >> 1)));
                const unsigned ww[4] = {w.x, w.y, w.z, w.w};
#pragma unroll
                for (int x = 0; x < 4; ++x) { STt[(8 * cc + 2 * x) * 256 + v] = (bf16)(ww[x] & 0xffffu); STt[(8 * cc + 2 * x + 1) * 256 + v] = (bf16)(ww[x] >> 16); } }
            __syncthreads();
            const LAS bf16* QS = dir == 0 ? QT : KT;
#pragma unroll 2
            for (int d = 0; d < 128; ++d) {
                const v4u qr = *(const LAS v4u*)(QS + d * 128 + 8 * ib), sr = *(const LAS v4u*)(STt + d * 256 + 8 * vb);
                const float qv[8] = {bflo(qr.x), bfhi(qr.x), bflo(qr.y), bfhi(qr.y), bflo(qr.z), bfhi(qr.z), bflo(qr.w), bfhi(qr.w)};
                const float sv[8] = {bflo(sr.x), bfhi(sr.x), bflo(sr.y), bfhi(sr.y), bflo(sr.z), bfhi(sr.z), bflo(sr.w), bfhi(sr.w)};
#pragma unroll
                for (int x = 0; x < 8; ++x)
#pragma unroll
                    for (int y = 0; y < 8; ++y) o[x][y] += qv[x] * sv[y];
            }
        }
        __syncthreads();
#pragma unroll
        for (int x = 0; x < 8; ++x) { float s1 = 0.f, s2 = 0.f;
#pragma unroll
            for (int y = 0; y < 8; ++y) { s1 += o[x][y]; s2 += o[x][y] * o[x][y]; }
            RS[((8 * ib + x) * 32 + vb) * 2] = s1; RS[((8 * ib + x) * 32 + vb) * 2 + 1] = s2; }
        __syncthreads();
        const float* gn = inp(F, I_GN) + h * 256 + 8 * vb;
        float gnv[8];
#pragma unroll
        for (int y = 0; y < 8; ++y) gnv[y] = gn[y];
#pragma unroll
        for (int x = 0; x < 8; ++x) { const int i = 8 * ib + x; float s1 = 0.f, s2 = 0.f;
            for (int q = 0; q < 32; ++q) { s1 += RS[(i * 32 + q) * 2]; s2 += RS[(i * 32 + q) * 2 + 1]; }
            const float mu = s1 * (1.0f / 256.0f); const float var = fmaxf(s2 * (1.0f / 256.0f) - mu * mu, 0.f); const float rstd = 1.0f / sqrtf(var + EPS);
            const v4u gr = *(const v4u*)((const bf16*)(ws + WS_GR) + (qrow0 + i) * 1024 + h * 256 + 8 * vb);
            const float gg[8] = {bflo(gr.x), bfhi(gr.x), bflo(gr.y), bfhi(gr.y), bflo(gr.z), bfhi(gr.z), bflo(gr.w), bfhi(gr.w)};
            float y8[8];
#pragma unroll
            for (int y = 0; y < 8; ++y) y8[y] = (o[x][y] - mu) * rstd * gnv[y] * siluf_(gg[y]);
            v4u w; w.x = pk2(y8[0], y8[1]); w.y = pk2(y8[2], y8[3]); w.z = pk2(y8[4], y8[5]); w.w = pk2(y8[6], y8[7]);
            *(v4u*)((bf16*)(ws + WS_O) + (qrow0 + i) * 2048 + 1024 + h * 256 + 8 * vb) = w;
            __builtin_amdgcn_sched_barrier(0); }
        __syncthreads();
    }
}

__device__ __forceinline__ float reduce16(float (&v)[16], int lane) {
#define R16_STEP(o, n) do { const bool up = (lane & (o)) != 0; _Pragma("unroll") for (int i = 0; i < (n) / 2; ++i) { const float mine = up ? v[i + (n) / 2] : v[i], other = up ? v[i] : v[i + (n) / 2]; v[i] = mine + __shfl_xor(other, (o)); } } while (0)
    R16_STEP(32, 16); R16_STEP(16, 8); R16_STEP(8, 4); R16_STEP(4, 2);
#undef R16_STEP
    float r = v[0]; r += __shfl_xor(r, 2); r += __shfl_xor(r, 1); return r;
}
__device__ __forceinline__ void p10_norm_router(Frame& F) {
    unsigned char* ws = F.ws;
    LAS float* WRT = (LAS float*)F.lds;
    LAS float* C1 = (LAS float*)(F.lds + 131072); LAS float* A2 = C1 + 2048; LAS float* B2 = C1 + 4096;
    const int b = F.vcu & 3, sub = F.vcu >> 2, nsub = F.G >> 2;
    const float* MOD = (const float*)(ws + WS_MOD) + (size_t)b * 12288;
    { const f32x4* wg = (const f32x4*)(ws + WS_WRT); f32x4 wv[16];
#pragma unroll
      for (int q = 0; q < 16; ++q) wv[q] = wg[F.tid + 512 * q];
#pragma unroll
      for (int q = 0; q < 16; ++q) *(LAS f32x4*)(WRT + 4 * (F.tid + 512 * q)) = wv[q]; }
#pragma unroll
    for (int k = F.tid; k < 2048; k += 512) { C1[k] = MOD[4096 + k] * inp(F, I_POST1)[k]; A2[k] = inp(F, I_PRE2)[k] * (1.0f + MOD[8192 + k]); B2[k] = MOD[6144 + k]; }
    __syncthreads();
    const bf16* YO = (const bf16*)(ws + WS_YO); bf16* H2 = (bf16*)(ws + WS_H); float* AFF = (float*)(ws + WS_AFF);
    const int lane = F.lane; const float* X = inp(F, I_X);
    const int eown = ((lane >> 5) & 1) * 8 + ((lane >> 4) & 1) * 4 + ((lane >> 3) & 1) * 2 + ((lane >> 2) & 1);
    const int tstep = 2 * nsub * NWAVES;
    f32x4 nxa[8], nxb[8];
#define P10_LOAD(tt) do { const int ta_ = (tt), tb_ = ((tt) + nsub * NWAVES < T) ? (tt) + nsub * NWAVES : (tt); const size_t ma_ = (size_t)b * T + ta_, mb_ = (size_t)b * T + tb_; \
        const f32x4* xr0 = (const f32x4*)(X + ma_ * DM) + lane; const f32x4* xr1 = (const f32x4*)(X + mb_ * DM) + lane; \
        _Pragma("unroll") for (int j = 0; j < 8; ++j) { nxa[j] = xr0[64 * j]; nxb[j] = xr1[64 * j]; } } while (0)
    if (sub * NWAVES + F.wave < T) P10_LOAD(sub * NWAVES + F.wave);
    for (int t0 = sub * NWAVES + F.wave; t0 < T; t0 += tstep) {
        int lane = F.lane; asm volatile("" : "+v"(lane));
        const int t1r = t0 + nsub * NWAVES; const bool has1 = t1r < T; const int t1 = has1 ? t1r : t0;
        const size_t m0 = (size_t)b * T + t0, m1 = (size_t)b * T + t1;
        f32x4 xa[8], xb[8]; float sa = 0.f, sb = 0.f;
        {   v2u ya[8], yb[8];
            const v2u* yr0 = (const v2u*)(YO + m0 * DM) + lane; const v2u* yr1 = (const v2u*)(YO + m1 * DM) + lane;
#pragma unroll
            for (int j = 0; j < 8; ++j) { ya[j] = yr0[64 * j]; yb[j] = yr1[64 * j]; }
#pragma unroll
            for (int j = 0; j < 8; ++j) { xa[j] = nxa[j]; xb[j] = nxb[j]; }
            if (t0 + tstep < T) { P10_LOAD(t0 + tstep); asm volatile("" ::: "memory"); }
#pragma unroll
            for (int j = 0; j < 8; ++j) { const float a0 = bflo(ya[j].x), a1 = bfhi(ya[j].x), a2 = bflo(ya[j].y), a3 = bfhi(ya[j].y), b0 = bflo(yb[j].x), b1 = bfhi(yb[j].x), b2 = bflo(yb[j].y), b3 = bfhi(yb[j].y);
                sa += (a0 * a0 + a1 * a1) + (a2 * a2 + a3 * a3); sb += (b0 * b0 + b1 * b1) + (b2 * b2 + b3 * b3); }
            const float ra = 1.0f / sqrtf(wave_sum(sa) * (1.0f / DM) + EPS), rb = 1.0f / sqrtf(wave_sum(sb) * (1.0f / DM) + EPS);
            v2u* o0 = (v2u*)((bf16*)(ws + WS_YO) + m0 * DM) + lane; v2u* o1 = (v2u*)((bf16*)(ws + WS_YO) + m1 * DM) + lane; sa = 0.f; sb = 0.f;
#pragma unroll
            for (int j = 0; j < 8; ++j) { const f32x4 c1 = *(const LAS f32x4*)(C1 + 4 * (64 * j + lane));
                const f32x4 fa = {bflo(ya[j].x), bfhi(ya[j].x), bflo(ya[j].y), bfhi(ya[j].y)}, fb = {bflo(yb[j].x), bfhi(yb[j].x), bflo(yb[j].y), bfhi(yb[j].y)};
                xa[j] = xa[j] + c1 * (fa * ra); xb[j] = xb[j] + c1 * (fb * rb);
                { v2u w; w.x = pk2(xa[j].x, xa[j].y); w.y = pk2(xa[j].z, xa[j].w); o0[64 * j] = w; w.x = pk2(xb[j].x, xb[j].y); w.y = pk2(xb[j].z, xb[j].w); if (has1) o1[64 * j] = w; }
                sa += (xa[j].x * xa[j].x + xa[j].y * xa[j].y) + (xa[j].z * xa[j].z + xa[j].w * xa[j].w); sb += (xb[j].x * xb[j].x + xb[j].y * xb[j].y) + (xb[j].z * xb[j].z + xb[j].w * xb[j].w); }
        }
        const float r2a = 1.0f / sqrtf(wave_sum(sa) * (1.0f / DM) + EPS), r2b = 1.0f / sqrtf(wave_sum(sb) * (1.0f / DM) + EPS);
        unsigned* h0 = (unsigned*)((unsigned char*)H2 + m0 * DM) + lane; unsigned* h1 = (unsigned*)((unsigned char*)H2 + m1 * DM) + lane;
#pragma unroll
        for (int j = 0; j < 8; ++j) { const f32x4 a2 = *(const LAS f32x4*)(A2 + 4 * (64 * j + lane)), b2 = *(const LAS f32x4*)(B2 + 4 * (64 * j + lane)); xa[j] = xa[j] * r2a * a2 + b2; xb[j] = xb[j] * r2b * a2 + b2;
            h0[64 * j] = pg8::pk4_fp8(xa[j].x * 4.f, xa[j].y * 4.f, xa[j].z * 4.f, xa[j].w * 4.f); if (has1) h1[64 * j] = pg8::pk4_fp8(xb[j].x * 4.f, xb[j].y * 4.f, xb[j].z * 4.f, xb[j].w * 4.f); }
        float la[16], lb[16];
        const LAS float* W0 = WRT + 4 * lane; const LAS float* W1; { unsigned wo = (unsigned)(uintptr_t)(WRT + 16384 + 4 * lane); asm volatile("" : "+v"(wo)); W1 = (const LAS float*)(uintptr_t)wo; }
#pragma unroll
        for (int e = 0; e < 16; ++e) { float a = 0.f, c = 0.f;
#pragma unroll
            for (int j = 0; j < 8; ++j) { const f32x4 w = *(const LAS f32x4*)((e < 8 ? W0 : W1) + (e & 7) * 2048 + 256 * j);
                a += (xa[j].x * w.x + xa[j].y * w.y) + (xa[j].z * w.z + xa[j].w * w.w); c += (xb[j].x * w.x + xb[j].y * w.y) + (xb[j].z * w.z + xb[j].w * w.w); }
            la[e] = a; lb[e] = c; __builtin_amdgcn_sched_barrier(0); }
        const float ga = reduce16(la, lane), gb = reduce16(lb, lane);
        float ma = ga, mb = gb;
#pragma unroll
        for (int o = 4; o < 64; o <<= 1) { ma = fmaxf(ma, __shfl_xor(ma, o)); mb = fmaxf(mb, __shfl_xor(mb, o)); }
        const float pa = expf(ga - ma), pb = expf(gb - mb); float da = pa, db = pb;
#pragma unroll
        for (int o = 4; o < 64; o <<= 1) { da += __shfl_xor(da, o); db += __shfl_xor(db, o); }
        if ((lane & 3) == 0) { AFF[((size_t)b * 16 + eown) * T + t0] = pa / da; if (has1) AFF[((size_t)b * 16 + eown) * T + t1] = pb / db; }
    }
}

__device__ __forceinline__ void p11_topk(Frame& F) {
    unsigned char* ws = F.ws;
    LAS unsigned* hist = (LAS unsigned*)F.lds;
    LAS unsigned* bc = hist + 256;
    LAS unsigned* wtot = hist + 272;
    const int tid = F.tid, lane = F.lane, wave = F.wave;
    for (int u = F.vcu; u < NB * NE; u += F.G) {
        const int b = u >> 4, e = u & 15;
        const float* aff = (const float*)(ws + WS_AFF) + ((size_t)b * 16 + e) * T;
        const f32x4 v0 = *(const f32x4*)(aff + 8 * tid), v1 = *(const f32x4*)(aff + 8 * tid + 4);
        const float val[8] = {v0[0], v0[1], v0[2], v0[3], v1[0], v1[1], v1[2], v1[3]};
        unsigned key[8];
#pragma unroll
        for (int i = 0; i < 8; ++i) key[i] = __float_as_uint(val[i]);
        unsigned prefix = 0u, kth = CAP;
#pragma unroll 1
        for (int pass = 0; pass < 4; ++pass) {
            const int shift = 24 - 8 * pass;
            if (tid < 256) hist[tid] = 0u;
            __syncthreads();
#pragma unroll
            for (int i = 0; i < 8; ++i) { const bool in = pass == 0 ? true : ((key[i] >> (shift + 8)) == prefix); if (in) atomicAdd((unsigned*)&hist[(key[i] >> shift) & 255u], 1u); }
            __syncthreads();
            if (wave == 0) {
                const unsigned h0 = hist[4 * lane], h1 = hist[4 * lane + 1], h2 = hist[4 * lane + 2], h3 = hist[4 * lane + 3]; const unsigned sl = h0 + h1 + h2 + h3;
                unsigned suf = sl;
#pragma unroll
                for (int o = 1; o < 64; o <<= 1) { const unsigned a = __shfl_down(suf, o); if (lane + o < 64) suf += a; }
                unsigned cum = suf - sl;
                if (cum < kth && kth <= suf) { int bin; unsigned c2 = cum;
                    if (c2 + h3 >= kth) bin = 4 * lane + 3; else { c2 += h3; if (c2 + h2 >= kth) bin = 4 * lane + 2; else { c2 += h2; if (c2 + h1 >= kth) bin = 4 * lane + 1; else { c2 += h1; bin = 4 * lane; } } }
                    bc[0] = (prefix << 8) | (unsigned)bin; bc[1] = kth - c2; }
            }
            __syncthreads();
            prefix = bc[0]; kth = bc[1];
            __syncthreads();
        }
        const unsigned thr = prefix, need = kth;
        unsigned ng = 0u, neq = 0u;
#pragma unroll
        for (int i = 0; i < 8; ++i) { ng += key[i] > thr ? 1u : 0u; neq += key[i] == thr ? 1u : 0u; }
        unsigned sg = ng, se = neq;
#pragma unroll
        for (int o = 1; o < 64; o <<= 1) { const unsigned a = __shfl_up(sg, o), c = __shfl_up(se, o); if (lane >= o) { sg += a; se += c; } }
        if (lane == 63) { wtot[wave * 2] = sg; wtot[wave * 2 + 1] = se; }
        __syncthreads();
        unsigned bg = sg - ng, be = se - neq;
        for (int w = 0; w < wave; ++w) { bg += wtot[w * 2]; be += wtot[w * 2 + 1]; }
        int* rowidx = (int*)(ws + WS_ROWIDX) + e * 2048 + b * CAP; float* topw = (float*)(ws + WS_TOPW) + e * 2048 + b * CAP; int* inv = (int*)(ws + WS_INV);
#pragma unroll
        for (int i = 0; i < 8; ++i) {
            const int t = 8 * tid + i; const bool gt = key[i] > thr, eq = key[i] == thr; const bool sel = gt || (eq && be < need);
            const unsigned slot = bg + (be < need ? be : need);
            if (sel) { rowidx[slot] = b * T + t; topw[slot] = val[i]; }
            inv[((size_t)b * T + t) * 16 + e] = sel ? (int)(e * 2048 + b * CAP + slot) : -1;
            bg += gt ? 1u : 0u; be += eq ? 1u : 0u;
        }
        __syncthreads();
        __syncthreads();
    }
}

__device__ __forceinline__ void p14_final(Frame& F) {
    unsigned char* ws = F.ws;
    LAS float* C2 = (LAS float*)F.lds;
    const int b = F.vcu & 3, sub = F.vcu >> 2, nsub = F.G >> 2;
    const float* MOD = (const float*)(ws + WS_MOD) + (size_t)b * 12288;
#pragma unroll
    for (int k = F.tid; k < 2048; k += 512) C2[k] = MOD[10240 + k] * inp(F, I_POST2)[k];
    __syncthreads();
    const bf16* YEXP = (const bf16*)(ws + WS_YEXP); const int* inv = (const int*)(ws + WS_INV); const int lane = F.lane;
    const bf16* zrow = (const bf16*)(ws + WS_ZROW);
    const int tstep = nsub * NWAVES; int t = sub * NWAVES + F.wave;
    int slotv = (t < T && lane < 16) ? inv[((size_t)b * T + t) * 16 + lane] : -1;
    for (; t < T; t += tstep) {
        const size_t m = (size_t)b * T + t;
        const int tn = t + tstep; const int nslot = (tn < T && lane < 16) ? inv[((size_t)b * T + tn) * 16 + lane] : -1;
        f32x4* orow = (f32x4*)(F.out + m * DM) + lane; v2u xr[8]; { const v2u* x1r = (const v2u*)((const bf16*)(ws + WS_YO) + m * DM) + lane;
#pragma unroll
        for (int j = 0; j < 8; ++j) xr[j] = x1r[64 * j]; }
        unsigned mask = (unsigned)__ballot(slotv >= 0) & 0xffffu;
        f32x4 acc[8];
#pragma unroll
        for (int j = 0; j < 8; ++j) acc[j] = (f32x4){0.f, 0.f, 0.f, 0.f};
        while (mask != 0u) {
            const unsigned char* rp[4];
#pragma unroll
            for (int q = 0; q < 4; ++q) { if (mask != 0u) { const int e = __builtin_ctz(mask); mask &= mask - 1u; rp[q] = (const unsigned char*)YEXP + (size_t)__builtin_amdgcn_readlane(slotv, e) * DM; } else rp[q] = (const unsigned char*)zrow; }
            unsigned w[4][8];
#pragma unroll
            for (int q = 0; q < 4; ++q)
#pragma unroll
                for (int j = 0; j < 8; ++j) w[q][j] = ((const unsigned*)rp[q] + lane)[64 * j];
#pragma unroll
            for (int q = 0; q < 4; ++q)
#pragma unroll
                for (int j = 0; j < 8; ++j) { float f[4]; pg8::up4_fp8(w[q][j], f); acc[j] += (f32x4){f[0], f[1], f[2], f[3]}; }
        }
        float s = 0.f;
#pragma unroll
        for (int j = 0; j < 8; ++j) s += (acc[j].x * acc[j].x + acc[j].y * acc[j].y) + (acc[j].z * acc[j].z + acc[j].w * acc[j].w);
        const float r = 1.0f / sqrtf(wave_sum(s) * (1.0f / DM) + EPS * 16384.f);
#pragma unroll
        for (int j = 0; j < 8; ++j) { const f32x4 c2 = *(const LAS f32x4*)(C2 + 4 * (64 * j + lane)); const f32x4 x1 = {bflo(xr[j].x), bfhi(xr[j].x), bflo(xr[j].y), bfhi(xr[j].y)}; orow[64 * j] = x1 + c2 * (acc[j] * r); }
        slotv = nslot;
    }
}

struct Args { const float* in[22]; float* out; unsigned char* ws; int ph_lo, ph_hi; };
__global__ void __launch_bounds__(NWAVES * 64, 2) fwd(Args args) {
    extern __shared__ __attribute__((aligned(16))) unsigned char lds[];
    Frame F;
    F.lds = (LAS unsigned char*)lds;
    F.MISC = (volatile LAS unsigned*)(F.lds + MISC_OFF);
    F.tid = threadIdx.x; F.lane = F.tid & 63; F.wave = __builtin_amdgcn_readfirstlane(F.tid >> 6);
    F.G = gridDim.x; { const int bx = blockIdx.x; F.vcu = (F.G % 8 == 0) ? (bx % 8) * (F.G / 8) + bx / 8 : bx; }
    unsigned char* ws = args.ws; F.ws = ws; F.out = args.out;
    F.ctl = (gu32*)(ws + WS_CTL);
    for (int u = F.tid; u < (LDS_BYTES - LDSCTL_OFF) / 4; u += NWAVES * 64) ((LAS unsigned*)(F.lds + LDSCTL_OFF))[u] = 0u;
    __syncthreads();
    if (F.tid < 22) ((LAS unsigned long long*)(F.lds + LDSCTL_OFF))[F.tid] = (unsigned long long)(uintptr_t)args.in[F.tid];
    __syncthreads();
    XcdBarrier bar; bar.bar = (unsigned*)(F.ctl + CW_BAR); bar.x = 0; bar.st = nullptr;
    if (N_LAUNCHES != N_PHASES) bar = xcd_barrier_post((unsigned*)(F.ctl + CW_BAR), F.MISC + 8);
#define GRID_BAR(seam) do { if (N_LAUNCHES == N_PHASES) { if (F.tid == 0) __hip_atomic_store(F.ctl + CW_TMO, 0xBADBA0u | (unsigned)(seam), RLX_AGENT); } else { xcd_barrier(bar); } } while (0)
    const int lo = args.ph_lo, hi = args.ph_hi;
#ifndef PH_MASK
#define PH_MASK 0x7fff
#endif
#define IN(k) (((PH_MASK >> (k)) & 1) && lo <= (k) && (k) < hi)
#define BOTH(k) (IN(k) && IN((k) + 1))
#ifndef PROBE_MASK
#define PROBE_MASK 0
#endif
#ifndef PROBE_AMP
#define PROBE_AMP 4
#endif
#define PB_BEGIN(k) do { if (PROBE_MASK & (1 << (k))) { if (F.tid == 0) { const unsigned long long t = __builtin_amdgcn_s_memrealtime(); F.MISC[16] = (unsigned)t; F.MISC[17] = (unsigned)(t >> 32); } } } while (0)
#define PB_END(k) do { if (PROBE_MASK & (1 << (k))) { if (F.tid == 0) { const unsigned long long t0 = ((unsigned long long)F.MISC[17] << 32) | F.MISC[16]; const unsigned long long d = __builtin_amdgcn_s_memrealtime() - t0; \
        const unsigned long long a = (((unsigned long long)F.MISC[19] << 32) | F.MISC[18]) + d; F.MISC[18] = (unsigned)a; F.MISC[19] = (unsigned)(a >> 32); } } } while (0)
#define FRESH() do { asm volatile("" : "+v"(F.tid)); F.lane = F.tid & 63; F.wave = __builtin_amdgcn_readfirstlane(F.tid >> 6); asm volatile("" : "+s"(F.vcu), "+s"(F.G)); } while (0)

    if (IN(0)) { FRESH(); PB_BEGIN(0); p0_prologue(F); if (BOTH(0)) GRID_BAR(0); PB_END(0); }
    if (IN(1)) { FRESH(); PB_BEGIN(1); p1_h(F); if (BOTH(1)) GRID_BAR(1); PB_END(1); }
    if (IN(2)) { FRESH(); PB_BEGIN(2);
        const bool copier = (F.vcu & 31) < CONV_PER_XCD;
        if (copier) copy_queue_drain(F);
        pg8::EpiZ E{(bf16*)(ws + WS_QA), (bf16*)(ws + WS_QR), (bf16*)(ws + WS_GR), (bf16*)(ws + WS_GATE), (bf16*)(ws + WS_KA), (bf16*)(ws + WS_VA), (bf16*)(ws + WS_KR), (bf16*)(ws + WS_VR),
                     inp(F, I_QN), inp(F, I_KN), (const float*)(ws + WS_ROPE), (LAS float*)(F.lds + pg8::STAGE_BYTES + 2048), 0};
        {
            pg8::Gemm g{(const bf16*)(ws + WS_H), (const bf16*)(ws + WS_WIN), 2048, 2048, 2048, nullptr, 0x7f7f7f7f, 0x7f7f7f7f}; pg8::InProjDynOrder S; S.init((int)blockIdx.x, (unsigned*)(F.ctl + CW_QUEUE), 0);
            pg8::gemm_phase<pg8::EpiZ, pg8::InProjDynOrder, true>(F.lds + RING_OFF, g, S, E, F.tid); }
        FRESH();
        {
            pg8::Gemm g{(const bf16*)(ws + WS_H8), (const bf16*)(ws + WS_WIN8), 2048, 2048, 2048, nullptr, 0x7d7d7d7d, 0x79797979}; pg8::InProjDynOrder S; S.init((int)blockIdx.x, (unsigned*)(F.ctl + CW_QUEUE + 64 * 16), 1);
            pg8::EpiGate8 Eg{ws + WS_GATE};
            pg8::gemm_phase<pg8::EpiGate8, pg8::InProjDynOrder, true, false, true>(F.lds + RING_OFF, g, S, Eg, F.tid); }
        if (!copier) copy_queue_drain(F);
        if (BOTH(2)) GRID_BAR(2); PB_END(2);
    }
    if (IN(3) && FUSE_ROPE == 0) { FRESH(); PB_BEGIN(3); p3_rope(F); if (BOTH(3)) GRID_BAR(3); PB_END(3); }
    if (IN(4)) { FRESH(); PB_BEGIN(4); if (RET_VALU & 1) p4_chunk_states(F); else p4_chunk_states_mfma(F, (char*)lds); if (BOTH(4)) GRID_BAR(4); PB_END(4); }
    if (IN(5)) { FRESH(); PB_BEGIN(5); p5_scan(F); p5_attention(F, (char*)lds); if (BOTH(5)) GRID_BAR(5); PB_END(5); }
    if (IN(6)) { FRESH(); PB_BEGIN(6); if (RET_VALU & 2) p6_ret_out(F); else p6_ret_out_mfma(F, (char*)lds); if (BOTH(6)) GRID_BAR(6); PB_END(6); }
    if (IN(7)) { FRESH(); PB_BEGIN(7);
        pg8::Gemm g{(const bf16*)(ws + WS_O), (const bf16*)(ws + WS_WOA), 2048, 2048, 2048, nullptr, 0x7f7f7f7f, 0x7f7f7f7f}; pg8::StaticOrder S; S.init(M, DM, F.G, (int)blockIdx.x);
        pg8::EpiGateMerge E{(bf16*)(ws + WS_Y), (const unsigned char*)(ws + WS_GATE)};
        pg8::gemm_phase<pg8::EpiGateMerge, pg8::StaticOrder, true>(F.lds + RING_OFF, g, S, E, F.tid);
        if (IN(9)) GRID_BAR(7); PB_END(7);
    }
    if (IN(9)) { FRESH(); PB_BEGIN(9);
        pg8::Gemm g{(const bf16*)(ws + WS_Y), (const bf16*)(ws + WS_WOUT), 2048, 2048, 2048, nullptr, 0x7f7f7f7f, 0x7f7f7f7f}; pg8::StaticOrder S; S.init(M, DM, F.G, (int)blockIdx.x);
        pg8::EpiPlain E{(bf16*)(ws + WS_YO), 2048};
        pg8::gemm_phase<pg8::EpiPlain, pg8::StaticOrder, true>(F.lds + RING_OFF, g, S, E, F.tid);
        if (BOTH(9)) GRID_BAR(9); PB_END(9);
    }
    if (IN(10)) { FRESH(); PB_BEGIN(10); p10_norm_router(F); if (BOTH(10)) GRID_BAR(10); PB_END(10); }
    if (IN(11)) { FRESH(); PB_BEGIN(11); p11_topk(F); if (BOTH(11)) GRID_BAR(11); PB_END(11); }
    if (IN(12)) { FRESH(); PB_BEGIN(12);
        pg8::Gemm g{(const bf16*)(ws + WS_H), (const bf16*)(ws + WS_WGU), 2048, 2048, 2048, (const int*)(ws + WS_ROWIDX), 0x7d7d7d7d, 0x79797979}; pg8::ExpertOrder S; S.init(NE, 8, 16, F.G, (int)blockIdx.x);
        pg8::EpiSwiGLU E{(bf16*)(ws + WS_ACT)};
        pg8::gemm_phase<pg8::EpiSwiGLU, pg8::ExpertOrder, true, true, true>(F.lds + RING_OFF, g, S, E, F.tid);
        if (BOTH(12)) GRID_BAR(12); PB_END(12);
    }
    if (IN(13)) { FRESH(); PB_BEGIN(13);
        pg8::Gemm g{(const bf16*)(ws + WS_ACT), (const bf16*)(ws + WS_WDN), 2048, 2048, 2048, nullptr, 0x7f7f7f7f, 0x79797979}; pg8::ExpertOrder S; S.init(NE, 8, 8, F.G, (int)blockIdx.x);
        pg8::EpiDown E{(bf16*)(ws + WS_YEXP), (const float*)(ws + WS_TOPW)};
        pg8::gemm_phase<pg8::EpiDown, pg8::ExpertOrder, true, false, true>(F.lds + RING_OFF, g, S, E, F.tid);
        if (BOTH(13)) GRID_BAR(13); PB_END(13);
    }
    if (IN(14)) { FRESH(); PB_BEGIN(14); p14_final(F); VM_WAIT(); __syncthreads(); PB_END(14); }
    if ((PROBE_MASK != 0 || PROBE_SUB >= 0) && blockIdx.x == 0 && F.tid == 0) { const unsigned long long a = (((unsigned long long)F.MISC[19] << 32) | F.MISC[18]) * PROBE_AMP; const unsigned long long t0 = __builtin_amdgcn_s_memrealtime();
        while (__builtin_amdgcn_s_memrealtime() - t0 < a) __builtin_amdgcn_s_sleep(8); }
#undef IN
#undef BOTH
}

extern "C" void kernel_launch(void* const* d_in, const int* in_sizes, int n_in, void* d_out, int out_size, void* d_ws, size_t ws_size, hipStream_t stream) {
    static int grid = 0;
    if (grid == 0) {
        if (n_in != 22 || out_size != M * DM || ws_size < WS_END) { fprintf(stderr, "kernel_launch: unexpected shapes: n_in %d out %d ws %zu (need %zu)\n", n_in, out_size, ws_size, (size_t)WS_END); grid = -1; return; }
        int dev = 0, cus = 0, per_cu = 0;
        if (hipGetDevice(&dev) != hipSuccess || hipDeviceGetAttribute(&cus, hipDeviceAttributeMultiprocessorCount, dev) != hipSuccess) { grid = -1; return; }
        if (hipFuncSetAttribute((const void*)fwd, hipFuncAttributeMaxDynamicSharedMemorySize, LDS_BYTES) != hipSuccess) { fprintf(stderr, "kernel_launch: hipFuncSetAttribute failed\n"); grid = -1; return; }
        if (hipOccupancyMaxActiveBlocksPerMultiprocessor(&per_cu, (const void*)fwd, NWAVES * 64, LDS_BYTES) != hipSuccess || per_cu < 1) fprintf(stderr, "kernel_launch: occupancy query reports %d\n", per_cu);
        (void)hipGetLastError();
        grid = cus - (cus % 8);
        if (grid < 8) grid = 8;
    }
    if (grid < 0) return;
    if (hipMemsetAsync((char*)d_ws + WS_CTL, 0, CTL_ZERO_BYTES, stream) != hipSuccess) return;
    Args a{};
    for (int i = 0; i < 22; ++i) a.in[i] = (const float*)d_in[i];
    a.out = (float*)d_out; a.ws = (unsigned char*)d_ws;
    if (N_LAUNCHES == 1) { a.ph_lo = 0; a.ph_hi = N_PHASES; hipLaunchKernelGGL(fwd, dim3(grid), dim3(NWAVES * 64), LDS_BYTES, stream, a); }
    else for (int p = 0; p < N_PHASES; ++p) { a.ph_lo = p; a.ph_hi = p + 1; hipLaunchKernelGGL(fwd, dim3(grid), dim3(NWAVES * 64), LDS_BYTES, stream, a); }
    const hipError_t le = hipPeekAtLastError();
    if (le != hipSuccess) fprintf(stderr, "kernel_launch: launch failed: %s\n", hipGetErrorName(le));
}
```

```cpp
#include <hip/hip_runtime.h>
#include <cstdio>
#include <cstdint>

#ifndef FUSE_ROPE
#define FUSE_ROPE 1
#endif
#ifndef RET_VALU
#define RET_VALU 0
#endif
#ifndef MK_N_LAUNCHES
#define MK_N_LAUNCHES 1
#endif

#ifndef EXP_MAP
#define EXP_MAP 1
#endif
namespace pg8 {
#define PG8_LAS __attribute__((address_space(3)))
typedef unsigned short bf16_t;
typedef short bf16x8 __attribute__((ext_vector_type(8)));
typedef float f32x4 __attribute__((ext_vector_type(4)));
typedef unsigned u32x4 __attribute__((ext_vector_type(4)));
constexpr int BM = 256, BK = 64, HALF = 128, HTB = HALF * BK * 2, STAGE_BYTES = 8 * HTB, NXCD = 8, WGM = 8;

__host__ __device__ __forceinline__ int lds_byte(int r, int c) { const int st = (r >> 4) * 2 + (c >> 5), rr = r & 15, cc = c & 31, ob = rr * 64 + cc * 2; return st * 1024 + (ob ^ (((ob >> 9) & 1) << 5)); }
__host__ __device__ __forceinline__ void stage_rc(int b, int& R, int& C) { const int st = b / 1024, sb = b % 1024, swz = sb ^ (((sb >> 9) & 1) << 5); R = (st >> 1) * 16 + swz / 64; C = (st & 1) * 32 + (swz % 64) / 2; }
__host__ __device__ __forceinline__ int perm32(int rho) { const int n = rho >> 4, i = rho & 15; return 8 * (i >> 2) + 4 * n + (i & 3); }

struct Unit { int pm, pn; int ko = 0; };
struct Gemm { const bf16_t* A; const bf16_t* Bt; int lda, ldb, K; const int* ridx; int scaleA, scaleB; };

struct StaticOrder {
    int nM, nN, nwg, G, c;
    __host__ __device__ void init(int M, int N, int G_, int c_) { nM = M / BM; nN = N / BM; nwg = nM * nN; G = G_; c = c_; }
    __host__ __device__ bool next(int i, Unit& u) const {
        const long L = (long)i * G + c; if (L >= nwg) return false;
        int wgid = (int)L; { const int q = nwg / NXCD, r = nwg % NXCD, xcd = wgid % NXCD, off = wgid / NXCD; wgid = (xcd < r ? xcd * (q + 1) : r * (q + 1) + (xcd - r) * q) + off; }
        const int nig = WGM * nN, gid = wgid / nig, fm = gid * WGM, gsz = (nM - fm) < WGM ? (nM - fm) : WGM;
        u.pm = fm + ((wgid % nig) % gsz); u.pn = (wgid % nig) / gsz; return true;
    }
};
struct PairOrder {
    static constexpr bool KPAIR = true;
    StaticOrder so; int kh;
    __host__ __device__ void init(int M, int N, int Khalf, int G_, int c_) { so.init(M, N, G_, c_); kh = Khalf; }
    __host__ __device__ bool next(int i, Unit& u) const { if (!so.next(i >> 1, u)) return false; u.ko = (i & 1) * kh; return true; }
};
struct InProjOrder {
    StaticOrder so; int G, c;
    __host__ __device__ void init(int G_, int c_) { so.init(16384, 8704, G_, c_); G = G_; c = c_; }
    __host__ __device__ bool unit_of(long L, Unit& u) const {
        if (L < so.nwg) { StaticOrder t = so; t.G = 1; t.c = 0; return t.next((int)L, u); }
        const int r = (int)(L - so.nwg); if (r >= 32) return false;
        u.pm = 64 + (r >> 3); u.pn = 26 + (r & 7); return true;
    }
    __host__ __device__ bool next(int i, Unit& u) const { return unit_of((long)i * G + c, u); }
};
struct InProjDynOrder {
    static constexpr bool DYNAMIC = true;
    StaticOrder so; unsigned* ctr; int x, mode, total;
    __device__ void init(int c_, unsigned* ctr_, int mode_) { mode = mode_; so.init(16384, mode_ ? 4096 : 4608, 1, 0); x = c_ & 7; ctr = ctr_ + 64 * x; total = so.nwg + (mode_ ? 0 : 32); }
    __device__ __forceinline__ int pull() const { return (int)__hip_atomic_fetch_add(ctr, 1u, __ATOMIC_RELAXED, __HIP_MEMORY_SCOPE_AGENT); }
    __device__ __forceinline__ bool unit(int q, Unit& u) const {
        const long L = (long)q * 8 + x; if (L >= total) return false;
        if (L < so.nwg) { so.next((int)L, u); if (mode == 0 && u.pn >= 10) u.pn += 16; return true; }
        const int r = (int)(L - so.nwg); u.pm = 64 + (r >> 3); u.pn = 26 + (r & 7); return true;
    }
};
struct ExpertOrder {
    int nPm, nPn, per, total, G, c;
    __host__ __device__ void init(int nE, int nPm_, int nPn_, int G_, int c_) { nPm = nPm_; nPn = nPn_; per = nPm * nPn; total = nE * per; G = G_; c = c_; }
    __host__ __device__ bool next(int i, Unit& u) const {
        const long L = (long)i * G + c; if (L >= total) return false;
        if (G == 256 && nPm == 8 && (nPn == 16 || nPn == 8)) {
            const int x = c & 7, j = c >> 3;
#if EXP_MAP
            if (nPn == 8) { const int g = i * 8 + x, e = g >> 1; u.pm = e * nPm + (g & 1) * 4 + (j & 3); u.pn = e * nPn + (j >> 2); return true; }
#endif
            const int npx = per / 8  , e = i * (32 / npx) + j / npx, s = j % npx;
            u.pm = e * nPm + (x & 1) * 4 + (s & 3); u.pn = e * nPn + (x >> 1) * (nPn / 4) + (s >> 2); return true;
        }
        const int e = (int)L / per, rem = (int)L % per; u.pm = e * nPm + rem % nPm; u.pn = e * nPn + rem / nPm; return true;
    }
};

__device__ __forceinline__ unsigned cvt_pk_bf16(float lo, float hi) { unsigned r; asm volatile("v_cvt_pk_bf16_f32 %0, %1, %2" : "=v"(r) : "v"(lo), "v"(hi)); return r; }
__device__ __forceinline__ float bflo(unsigned w) { return __uint_as_float(w << 16); }
__device__ __forceinline__ float bfhi(unsigned w) { return __uint_as_float(w & 0xffff0000u); }
__device__ __forceinline__ unsigned pk4_fp8(float a, float b, float c, float d) {
    a = __builtin_fminf(__builtin_fmaxf(a, -448.f), 448.f); b = __builtin_fminf(__builtin_fmaxf(b, -448.f), 448.f); c = __builtin_fminf(__builtin_fmaxf(c, -448.f), 448.f); d = __builtin_fminf(__builtin_fmaxf(d, -448.f), 448.f);
    unsigned w = 0u; w = (unsigned)__builtin_amdgcn_cvt_pk_fp8_f32(a, b, (int)w, false); w = (unsigned)__builtin_amdgcn_cvt_pk_fp8_f32(c, d, (int)w, true); return w; }
typedef float f32x2p __attribute__((ext_vector_type(2)));
__device__ __forceinline__ void up4_fp8(unsigned w, float (&o)[4]) { const f32x2p a = __builtin_amdgcn_cvt_pk_f32_fp8((int)w, false), b = __builtin_amdgcn_cvt_pk_f32_fp8((int)w, true); o[0] = a[0]; o[1] = a[1]; o[2] = b[0]; o[3] = b[1]; }
__device__ __forceinline__ float sigmoidf_(float x) { return __builtin_amdgcn_rcpf(1.0f + __expf(-x)); }

#define PG8_EPI_LOOP_BEGIN _Pragma("unroll") for (int ai = 0; ai < 2; ++ai) _Pragma("unroll") for (int m = 0; m < 4; ++m) { const int rloc = ai * HALF + wr * 64 + m * 16 + fr;
#define PG8_EPI_LOOP_END }
__device__ __forceinline__ u32x4 pack8(const f32x4& a0, const f32x4& a1) { const f32x4 v0 = a0 + 0.0f, v1 = a1 + 0.0f; u32x4 w; w.x = cvt_pk_bf16(v0[0], v0[1]); w.y = cvt_pk_bf16(v0[2], v0[3]); w.z = cvt_pk_bf16(v1[0], v1[1]); w.w = cvt_pk_bf16(v1[2], v1[3]); return w; }

struct EpiZ {
    static constexpr bool PERM = true;
    bf16_t *QA, *QR, *GR, *GATE, *KA, *VA, *KR, *VR;
    const float *qn, *kn, *tab; PG8_LAS float* ss;
    int pn_off;
    __device__ __forceinline__ void operator()(const f32x4 (&acc)[2][2][4][2], const Unit& u, int wr, int wc, int fr, int fq) const {
        const int pn = u.pn + pn_off, pm = u.pm; bf16_t* base; int ldc, colt;
        if (pn < 4) { base = QA; ldc = 1024; colt = pn * 256; } else if (pn < 6) { base = QR; ldc = 512; colt = (pn - 4) * 256; } else if (pn < 10) { base = GR; ldc = 1024; colt = (pn - 6) * 256; }
        else if (pn < 26) { base = GATE; ldc = 4096; colt = (pn - 10) * 256; } else if (pn == 26) { base = KA; ldc = 256; colt = 0; } else if (pn == 27) { base = VA; ldc = 256; colt = 0; }
        else if (pn < 30) { base = KR; ldc = 512; colt = (pn - 28) * 256; } else { base = VR; ldc = 1024; colt = (pn - 30) * 256; }
        int rowt; if (pn < 26) rowt = pm * 256; else if (pm < 64) rowt = (pm >> 4) * 4352 + 256 + (pm & 15) * 256; else rowt = (pm - 64) * 4352;
        const bool head = pn < 6 || pn == 26 || pn == 28 || pn == 29;
        if (!head) {
            const int col0 = colt + wc * 32 + 8 * fq;
            PG8_EPI_LOOP_BEGIN
                bf16_t* rowp = base + (size_t)(rowt + rloc) * ldc + col0;
#pragma unroll
                for (int bj = 0; bj < 2; ++bj) *(u32x4*)(rowp + bj * HALF) = pack8(acc[ai][bj][m][0], acc[ai][bj][m][1]);
            PG8_EPI_LOOP_END
            return;
        }
        const bool do_norm = pn < 4 || pn == 26, do_rope = pm < 64; const float kscale = (pn >= 28) ? 0.08838834764831845f : 1.0f;
        const int ah = wc >> 1, j0 = 16 * (wc & 1) + 4 * fq;
        if (do_norm) {
            PG8_EPI_LOOP_BEGIN
#pragma unroll
                for (int bj = 0; bj < 2; ++bj) { const f32x4 x0 = acc[ai][bj][m][0], x1 = acc[ai][bj][m][1];
                    float q = (x0[0] * x0[0] + x0[1] * x0[1]) + (x0[2] * x0[2] + x0[3] * x0[3]) + (x1[0] * x1[0] + x1[1] * x1[1]) + (x1[2] * x1[2] + x1[3] * x1[3]);
                    q += __shfl_xor(q, 16); q += __shfl_xor(q, 32);
                    if (fq == 0) ss[rloc * 8 + bj * 4 + wc] = q; }
            PG8_EPI_LOOP_END
            asm volatile("s_waitcnt lgkmcnt(0)" ::: "memory"); __builtin_amdgcn_s_barrier(); asm volatile("" ::: "memory");
        }
        f32x4 g0 = {kscale, kscale, kscale, kscale}, g1 = g0;
        if (do_norm) { const float* g = (pn < 4) ? qn : kn; g0 = *(const f32x4*)(g + 64 * ah + j0); g1 = *(const f32x4*)(g + 64 * ah + 32 + j0); }
        f32x4 csq[2][4][2];
#pragma unroll
        for (int ai = 0; ai < 2; ++ai)
#pragma unroll
            for (int m = 0; m < 4; ++m) { csq[ai][m][0] = (f32x4){1.f, 0.f, 1.f, 0.f}; csq[ai][m][1] = csq[ai][m][0];
                if (do_rope) { const int t = (pm * 256 + ai * HALF + wr * 64 + m * 16 + fr) & 4095, pos = ah ? (t & 63) : (t >> 6); const f32x4* tp = (const f32x4*)(tab + (pos * 32 + j0) * 2); csq[ai][m][0] = tp[0]; csq[ai][m][1] = tp[1]; } }
        PG8_EPI_LOOP_BEGIN
            const f32x4 cs0 = csq[ai][m][0], cs1 = csq[ai][m][1];
            bf16_t* rowp = base + (size_t)(rowt + rloc) * ldc + colt + 64 * ah + j0;
            __builtin_amdgcn_sched_barrier(0);
#pragma unroll
            for (int bj = 0; bj < 2; ++bj) { float r = 1.0f;
                if (do_norm) { const f32x4 p = *(const PG8_LAS f32x4*)(ss + rloc * 8 + bj * 4); r = 1.0f / sqrtf(((p[0] + p[1]) + (p[2] + p[3])) * (1.0f / 128.0f) + 1e-6f); }
                const f32x4 x0 = acc[ai][bj][m][0] * r * g0, x1 = acc[ai][bj][m][1] * r * g1;
                const float c[4] = {cs0[0], cs0[2], cs1[0], cs1[2]}, sn[4] = {cs0[1], cs0[3], cs1[1], cs1[3]};
                float o0[4], o1[4];
#pragma unroll
                for (int i = 0; i < 4; ++i) { o0[i] = x0[i] * c[i] - x1[i] * sn[i]; o1[i] = x1[i] * c[i] + x0[i] * sn[i]; }
                typedef unsigned u32x2_ __attribute__((ext_vector_type(2)));
                u32x2_ w0, w1; w0.x = cvt_pk_bf16(o0[0], o0[1]); w0.y = cvt_pk_bf16(o0[2], o0[3]); w1.x = cvt_pk_bf16(o1[0], o1[1]); w1.y = cvt_pk_bf16(o1[2], o1[3]);
                *(u32x2_*)(rowp + bj * HALF) = w0; *(u32x2_*)(rowp + bj * HALF + 32) = w1; }
        PG8_EPI_LOOP_END
    }
};
struct EpiPlain {
    static constexpr bool PERM = true;
    bf16_t* O; int ldc;
    __device__ __forceinline__ void operator()(const f32x4 (&acc)[2][2][4][2], const Unit& u, int wr, int wc, int fr, int fq) const {
        const int col0 = u.pn * BM + wc * 32 + 8 * fq;
        PG8_EPI_LOOP_BEGIN
            bf16_t* rowp = O + (size_t)(u.pm * BM + rloc) * ldc + col0;
#pragma unroll
            for (int bj = 0; bj < 2; ++bj) *(u32x4*)(rowp + bj * HALF) = pack8(acc[ai][bj][m][0], acc[ai][bj][m][1]);
        PG8_EPI_LOOP_END
    }
};
struct EpiGate8 {
    static constexpr bool PERM = true;
    unsigned char* G;
    __device__ __forceinline__ void operator()(const f32x4 (&acc)[2][2][4][2], const Unit& u, int wr, int wc, int fr, int fq) const {
        const int col0 = u.pn * BM + wc * 32 + 8 * fq; typedef unsigned u32x2_ __attribute__((ext_vector_type(2)));
        PG8_EPI_LOOP_BEGIN
            unsigned char* rowp = G + (size_t)(u.pm * BM + rloc) * 4096 + col0;
#pragma unroll
            for (int bj = 0; bj < 2; ++bj) { const f32x4 v0 = acc[ai][bj][m][0] * 16.f, v1 = acc[ai][bj][m][1] * 16.f; u32x2_ w; w.x = pk4_fp8(v0[0], v0[1], v0[2], v0[3]); w.y = pk4_fp8(v1[0], v1[1], v1[2], v1[3]);
                *(u32x2_*)(rowp + bj * HALF) = w; }
        PG8_EPI_LOOP_END
    }
};
template <bool ADD> struct EpiGate {
    static constexpr bool PERM = true;
    bf16_t* Y; const bf16_t* gate; int goff;
    __device__ __forceinline__ void operator()(const f32x4 (&acc)[2][2][4][2], const Unit& u, int wr, int wc, int fr, int fq) const {
        const int col0 = u.pn * BM + wc * 32 + 8 * fq;
        PG8_EPI_LOOP_BEGIN
            const size_t row = (size_t)(u.pm * BM + rloc);
#pragma unroll
            for (int bj = 0; bj < 2; ++bj) {
                const u32x4 g = *(const u32x4*)(gate + row * 4096 + goff + col0 + bj * HALF);
                f32x4 v0 = acc[ai][bj][m][0], v1 = acc[ai][bj][m][1];
                v0[0] *= sigmoidf_(bflo(g.x)); v0[1] *= sigmoidf_(bfhi(g.x)); v0[2] *= sigmoidf_(bflo(g.y)); v0[3] *= sigmoidf_(bfhi(g.y));
                v1[0] *= sigmoidf_(bflo(g.z)); v1[1] *= sigmoidf_(bfhi(g.z)); v1[2] *= sigmoidf_(bflo(g.w)); v1[3] *= sigmoidf_(bfhi(g.w));
                bf16_t* yp = Y + row * 2048 + col0 + bj * HALF;
                if (ADD) { const u32x4 y = *(const u32x4*)yp;
                    v0[0] += bflo(y.x); v0[1] += bfhi(y.x); v0[2] += bflo(y.y); v0[3] += bfhi(y.y); v1[0] += bflo(y.z); v1[1] += bfhi(y.z); v1[2] += bflo(y.w); v1[3] += bfhi(y.w); }
                *(u32x4*)yp = pack8(v0, v1);
            }
        PG8_EPI_LOOP_END
    }
};
struct EpiGatePair {
    static constexpr bool PERM = true, SUBPROBE = true;
    bf16_t* Y; const unsigned char* gate;
    const PG8_LAS float* lut;
    typedef unsigned u32x2_ __attribute__((ext_vector_type(2)));
    template <bool ADD> __device__ __forceinline__ void run(const f32x4 (&acc)[2][2][4][2], const Unit& u, int wr, int wc, int fr, int fq) const {
        const unsigned vg = (unsigned)(fr * 4096 + 8 * fq), vy = (unsigned)(fr * 4096 + 16 * fq);
        const unsigned char* gb = gate + (size_t)(u.pm * BM + wr * 64) * 4096 + (ADD ? 2048 : 0) + u.pn * BM + wc * 32;
        char* yb = (char*)Y + (size_t)(u.pm * BM + wr * 64) * 4096 + (size_t)(u.pn * BM + wc * 32) * 2;
        u32x2_ gq[2][4][2]; u32x4 yq[2][4][2];
#pragma unroll
        for (int ai = 0; ai < 2; ++ai)
#pragma unroll
            for (int m = 0; m < 4; ++m)
#pragma unroll
                for (int bj = 0; bj < 2; ++bj) { gq[ai][m][bj] = *(const u32x2_*)(gb + (size_t)(ai * HALF + m * 16) * 4096 + bj * HALF + vg);
                    if (ADD) yq[ai][m][bj] = *(const u32x4*)(yb + (size_t)(ai * HALF + m * 16) * 4096 + bj * HALF * 2 + vy); }
#pragma unroll
        for (int ai = 0; ai < 2; ++ai)
#pragma unroll
            for (int m = 0; m < 4; ++m)
#pragma unroll
                for (int bj = 0; bj < 2; ++bj) {
                    const unsigned w0 = gq[ai][m][bj].x, w1 = gq[ai][m][bj].y;
                    f32x4 v0 = acc[ai][bj][m][0], v1 = acc[ai][bj][m][1];
                    v0[0] *= lut[w0 & 255u]; v0[1] *= lut[(w0 >> 8) & 255u]; v0[2] *= lut[(w0 >> 16) & 255u]; v0[3] *= lut[w0 >> 24];
                    v1[0] *= lut[w1 & 255u]; v1[1] *= lut[(w1 >> 8) & 255u]; v1[2] *= lut[(w1 >> 16) & 255u]; v1[3] *= lut[w1 >> 24];
                    if (ADD) { const u32x4 y = yq[ai][m][bj];
                        v0[0] += bflo(y.x); v0[1] += bfhi(y.x); v0[2] += bflo(y.y); v0[3] += bfhi(y.y); v1[0] += bflo(y.z); v1[1] += bfhi(y.z); v1[2] += bflo(y.w); v1[3] += bfhi(y.w); }
                    *(u32x4*)(yb + (size_t)(ai * HALF + m * 16) * 4096 + bj * HALF * 2 + vy) = pack8(v0, v1);
                }
    }
    __device__ __forceinline__ void operator()(const f32x4 (&acc)[2][2][4][2], const Unit& u, int wr, int wc, int fr, int fq) const {
        if (u.ko != 0) run<true>(acc, u, wr, wc, fr, fq); else run<false>(acc, u, wr, wc, fr, fq);
    }
};
struct EpiGateMerge {
    static constexpr bool PERM = true, MID = true, SUBPROBE = true;
    bf16_t* Y; const unsigned char* gate;
    const PG8_LAS float* lut;
    typedef unsigned u32x2_ __attribute__((ext_vector_type(2)));
    __device__ __forceinline__ void mid(f32x4 (&acc)[2][2][4][2], const Unit& u, int wr, int wc, int fr_, int fq_) const {
        int fr = fr_, fq = fq_; asm volatile("" : "+v"(fr), "+v"(fq));
        const unsigned vg = (unsigned)(fr * 4096 + 8 * fq);
        const unsigned char* gb = gate + (size_t)(u.pm * BM + wr * 64) * 4096 + u.pn * BM + wc * 32;
        u32x2_ ga[2][4][2], gr[2][4][2];
#pragma unroll
        for (int ai = 0; ai < 2; ++ai)
#pragma unroll
            for (int m = 0; m < 4; ++m)
#pragma unroll
                for (int bj = 0; bj < 2; ++bj) { const unsigned char* gp = gb + (size_t)(ai * HALF + m * 16) * 4096 + bj * HALF + vg; ga[ai][m][bj] = *(const u32x2_*)gp; gr[ai][m][bj] = *(const u32x2_*)(gp + 2048); }
#pragma unroll
        for (int ai = 0; ai < 2; ++ai)
#pragma unroll
            for (int m = 0; m < 4; ++m)
#pragma unroll
                for (int bj = 0; bj < 2; ++bj)
#pragma unroll
                    for (int n = 0; n < 2; ++n) { const unsigned a = n ? ga[ai][m][bj].y : ga[ai][m][bj].x, r = n ? gr[ai][m][bj].y : gr[ai][m][bj].x;
                        acc[ai][bj][m][n][0] *= lut[a & 255u] * lut[256 + (r & 255u)]; acc[ai][bj][m][n][1] *= lut[(a >> 8) & 255u] * lut[256 + ((r >> 8) & 255u)];
                        acc[ai][bj][m][n][2] *= lut[(a >> 16) & 255u] * lut[256 + ((r >> 16) & 255u)]; acc[ai][bj][m][n][3] *= lut[a >> 24] * lut[256 + (r >> 24)]; }
    }
    __device__ __forceinline__ void operator()(const f32x4 (&acc)[2][2][4][2], const Unit& u, int wr, int wc, int fr, int fq) const {
        const unsigned vg = (unsigned)(fr * 4096 + 8 * fq), vy = (unsigned)(fr * 4096 + 16 * fq);
        const unsigned char* gb = gate + (size_t)(u.pm * BM + wr * 64) * 4096 + 2048 + u.pn * BM + wc * 32;
        char* yb = (char*)Y + (size_t)(u.pm * BM + wr * 64) * 4096 + (size_t)(u.pn * BM + wc * 32) * 2;
        u32x2_ gq[2][4][2];
#pragma unroll
        for (int ai = 0; ai < 2; ++ai)
#pragma unroll
            for (int m = 0; m < 4; ++m)
#pragma unroll
                for (int bj = 0; bj < 2; ++bj) gq[ai][m][bj] = *(const u32x2_*)(gb + (size_t)(ai * HALF + m * 16) * 4096 + bj * HALF + vg);
#pragma unroll
        for (int ai = 0; ai < 2; ++ai)
#pragma unroll
            for (int m = 0; m < 4; ++m)
#pragma unroll
                for (int bj = 0; bj < 2; ++bj) {
                    const unsigned w0 = gq[ai][m][bj].x, w1 = gq[ai][m][bj].y;
                    f32x4 v0 = acc[ai][bj][m][0], v1 = acc[ai][bj][m][1];
                    v0[0] *= lut[w0 & 255u]; v0[1] *= lut[(w0 >> 8) & 255u]; v0[2] *= lut[(w0 >> 16) & 255u]; v0[3] *= lut[w0 >> 24];
                    v1[0] *= lut[w1 & 255u]; v1[1] *= lut[(w1 >> 8) & 255u]; v1[2] *= lut[(w1 >> 16) & 255u]; v1[3] *= lut[w1 >> 24];
                    *(u32x4*)(yb + (size_t)(ai * HALF + m * 16) * 4096 + bj * HALF * 2 + vy) = pack8(v0, v1);
                }
    }
};
struct EpiSwiGLU {
    static constexpr bool PERM = true;
    bf16_t* ACT;
    __device__ __forceinline__ void operator()(const f32x4 (&acc)[2][2][4][2], const Unit& u, int wr, int wc, int fr, int fq) const {
        const int col0 = (u.pn & 15) * 128 + wc * 32 + 8 * fq;
        PG8_EPI_LOOP_BEGIN
            f32x4 v0, v1;
#pragma unroll
            for (int j = 0; j < 4; ++j) { const float a0 = acc[ai][0][m][0][j], a1 = acc[ai][0][m][1][j]; v0[j] = a0 * sigmoidf_(a0) * acc[ai][1][m][0][j]; v1[j] = a1 * sigmoidf_(a1) * acc[ai][1][m][1][j]; }
            typedef unsigned u32x2_ __attribute__((ext_vector_type(2))); u32x2_ w; w.x = pk4_fp8(v0[0], v0[1], v0[2], v0[3]); w.y = pk4_fp8(v1[0], v1[1], v1[2], v1[3]);
            *(u32x2_*)((unsigned char*)ACT + (size_t)(u.pm * BM + rloc) * 2048 + col0) = w;
        PG8_EPI_LOOP_END
    }
};
struct EpiDown {
    static constexpr bool PERM = true;
    bf16_t* Y; const float* topw;
    __device__ __forceinline__ void operator()(const f32x4 (&acc)[2][2][4][2], const Unit& u, int wr, int wc, int fr, int fq) const {
        const int col0 = (u.pn & 7) * BM + wc * 32 + 8 * fq;
        float tw[2][4];
#pragma unroll
        for (int ai = 0; ai < 2; ++ai)
#pragma unroll
            for (int m = 0; m < 4; ++m) tw[ai][m] = topw[u.pm * BM + ai * HALF + wr * 64 + m * 16 + fr];
        PG8_EPI_LOOP_BEGIN
            const size_t row = (size_t)(u.pm * BM + rloc); const float w = tw[ai][m];
#pragma unroll
            for (int bj = 0; bj < 2; ++bj) { const f32x4 v0 = acc[ai][bj][m][0] * (w * 128.f), v1 = acc[ai][bj][m][1] * (w * 128.f); typedef unsigned u32x2_ __attribute__((ext_vector_type(2)));
                u32x2_ o; o.x = pk4_fp8(v0[0], v0[1], v0[2], v0[3]); o.y = pk4_fp8(v1[0], v1[1], v1[2], v1[3]); *(u32x2_*)((unsigned char*)Y + row * 2048 + col0 + bj * HALF) = o; }
        PG8_EPI_LOOP_END
    }
};

template <class S, class = void> struct sched_dynamic { static constexpr bool value = false; };
template <class S> struct sched_dynamic<S, decltype((void)S::DYNAMIC)> { static constexpr bool value = S::DYNAMIC; };
template <class S, class = void> struct sched_kpair { static constexpr bool value = false; };
template <class S> struct sched_kpair<S, decltype((void)S::KPAIR)> { static constexpr bool value = S::KPAIR; };
template <class E, class = void> struct epi_subprobe { static constexpr bool value = false; };
template <class E> struct epi_subprobe<E, decltype((void)E::SUBPROBE)> { static constexpr bool value = E::SUBPROBE; };
#ifndef PROBE_SUB
#define PROBE_SUB -1
#endif
#define PG8_SUBP(k) do { if constexpr (epi_subprobe<Epi>::value) { if (PROBE_SUB >= 0 && tid == 0) { volatile PG8_LAS unsigned* M_ = (volatile PG8_LAS unsigned*)(lds + 155968); \
    if ((k) == PROBE_SUB) { const unsigned long long t_ = __builtin_amdgcn_s_memrealtime(); M_[16] = (unsigned)t_; M_[17] = (unsigned)(t_ >> 32); } \
    if ((k) == PROBE_SUB + 1) { const unsigned long long t0_ = ((unsigned long long)M_[17] << 32) | M_[16]; const unsigned long long a_ = (((unsigned long long)M_[19] << 32) | M_[18]) + (__builtin_amdgcn_s_memrealtime() - t0_); M_[18] = (unsigned)a_; M_[19] = (unsigned)(a_ >> 32); } } } } while (0)
template <class E, class = void> struct epi_has_mid { static constexpr bool value = false; };
template <class E> struct epi_has_mid<E, decltype((void)E::MID)> { static constexpr bool value = E::MID; };
typedef int i32x8 __attribute__((ext_vector_type(8)));
typedef int i32x4_ __attribute__((ext_vector_type(4)));
template <class Epi, class Sched, bool ALIGN_EPI, bool GATHER = false, bool F8 = false>
__device__ __forceinline__ void gemm_phase(PG8_LAS unsigned char* lds, const Gemm g, const Sched& S, const Epi& E, const int tid) {
    const int wid = __builtin_amdgcn_readfirstlane(tid >> 6), lane = tid & 63, wr = wid >> 2, wc = wid & 3, fr = lane & 15, fq = lane >> 4;
    constexpr int ESZ = F8 ? 1 : 2;
    const int K = g.K, nt = K * ESZ / (BK * 2);
    const size_t kstep = (size_t)(BK * 2);
    const size_t hA = (size_t)HALF * g.lda * ESZ, hB = (size_t)HALF * g.ldb * ESZ;
    const size_t tA = 2 * hA, tB = 2 * hB;
    unsigned vA0[2], vA1[2], voffB[2]; int Rg[2]; unsigned Cg[2];
#pragma unroll
    for (int i = 0; i < 2; ++i) { int R, C; stage_rc(tid * 16 + i * 8192, R, C); const int Rb = Epi::PERM ? ((R & ~31) + perm32(R & 31)) : R;
        Rg[i] = R; Cg[i] = (unsigned)C * 2u; vA0[i] = (unsigned)(R * g.lda * ESZ) + (unsigned)C * 2u; vA1[i] = vA0[i] + (unsigned)hA; voffB[i] = (unsigned)(Rb * g.ldb * ESZ) + (unsigned)C * 2u; }
    const unsigned ldsw = (unsigned)wid * 1024u;
    const int aoff = lds_byte(wr * 64 + fr, fq * (F8 ? 16 : 8)), boff = lds_byte(wc * 32 + fr, fq * (F8 ? 16 : 8));
    PG8_LAS const int* TBL = (PG8_LAS const int*)(lds + STAGE_BYTES);
#define PG8_SA(b, h) (((b) * 2 + (h)) * HTB)
#define PG8_SB(b, h) ((4 + (b) * 2 + (h)) * HTB)
#define PG8_STAGE(bufoff, gbase, voff) do { _Pragma("unroll") for (int _i = 0; _i < 2; ++_i) \
        __builtin_amdgcn_global_load_lds((const unsigned*)((const char*)(gbase) + (voff)[_i]), (PG8_LAS unsigned*)(lds + (bufoff) + ldsw + _i * 8192), 16, 0, 0); } while (0)
#define PG8_RD16(off) (*(const PG8_LAS i32x4_*)(lds + (off)))
#define PG8_LDA(dst, b, h) do { if constexpr (F8) { _Pragma("unroll") for (int m = 0; m < 4; ++m) dst##8[m] = __builtin_shufflevector(PG8_RD16(PG8_SA(b, h) + aoff + m * 2048), PG8_RD16(PG8_SA(b, h) + aoff + m * 2048 + 16), 0, 1, 2, 3, 4, 5, 6, 7); } \
    else { _Pragma("unroll") for (int m = 0; m < 4; ++m) _Pragma("unroll") for (int k = 0; k < 2; ++k) dst[m][k] = *(const PG8_LAS bf16x8*)(lds + PG8_SA(b, h) + aoff + m * 2048 + k * 1024); } } while (0)
#define PG8_LDB(dst, b, h) do { if constexpr (F8) { _Pragma("unroll") for (int n = 0; n < 2; ++n) dst##8[n] = __builtin_shufflevector(PG8_RD16(PG8_SB(b, h) + boff + n * 2048), PG8_RD16(PG8_SB(b, h) + boff + n * 2048 + 16), 0, 1, 2, 3, 4, 5, 6, 7); } \
    else { _Pragma("unroll") for (int n = 0; n < 2; ++n) _Pragma("unroll") for (int k = 0; k < 2; ++k) dst[n][k] = *(const PG8_LAS bf16x8*)(lds + PG8_SB(b, h) + boff + n * 2048 + k * 1024); } } while (0)
#define PG8_MMA(ai, bj, At, Bt) do { __builtin_amdgcn_s_setprio(1); if constexpr (F8) { _Pragma("unroll") for (int m = 0; m < 4; ++m) _Pragma("unroll") for (int n = 0; n < 2; ++n) \
        asm volatile("v_mfma_scale_f32_16x16x128_f8f6f4 %0, %1, %2, %0, %3, %4 op_sel_hi:[0,0,0]" : "+v"(acc[ai][bj][m][n]) : "v"(Bt##8[n]), "v"(At##8[m]), "v"(sclB), "v"(sclA)); } else { \
        _Pragma("unroll") for (int m = 0; m < 4; ++m) _Pragma("unroll") for (int n = 0; n < 2; ++n) _Pragma("unroll") for (int k = 0; k < 2; ++k) \
        acc[ai][bj][m][n] = __builtin_amdgcn_mfma_f32_16x16x32_bf16(Bt[n][k], At[m][k], acc[ai][bj][m][n], 0, 0, 0); } __builtin_amdgcn_s_setprio(0); } while (0)
#define PG8_WAIT_V(n) asm volatile("s_waitcnt vmcnt(" #n ")" ::: "memory")
#define PG8_WAIT_L(n) asm volatile("s_waitcnt lgkmcnt(" #n ")" ::: "memory")
#define PG8_BAR __builtin_amdgcn_s_barrier()
#define PG8_SCHED __builtin_amdgcn_sched_barrier(0)
    Unit cur, nxt; int ui = 0;
    PG8_SUBP(22);
    constexpr bool DYN = sched_dynamic<Sched>::value;
    PG8_LAS volatile int* qslot = (PG8_LAS volatile int*)(lds + STAGE_BYTES + 1024);
    if constexpr (DYN) { if (tid == 0) qslot[0] = S.pull(); __syncthreads(); const int q0 = qslot[0]; if (!S.unit(q0, cur)) return; }
    else { if (!S.next(0, cur)) return; }
    f32x4 acc[2][2][4][2];
#pragma unroll
    for (int a = 0; a < 2; ++a)
#pragma unroll
        for (int b = 0; b < 2; ++b)
#pragma unroll
            for (int m = 0; m < 4; ++m)
#pragma unroll
                for (int n = 0; n < 2; ++n) acc[a][b][m][n] = (f32x4){0.f, 0.f, 0.f, 0.f};
    bf16x8 At[4][2], B0[2][2], B1[2][2]; i32x8 At8[4], B08[2], B18[2];
    const int sclA = g.scaleA, sclB = g.scaleB;
    const char* cA = (const char*)g.A + (GATHER ? (size_t)0 : (size_t)cur.pm * tA); const char* cB = (const char*)g.Bt + (size_t)cur.pn * tB;
    if constexpr (sched_kpair<Sched>::value) { cA += (size_t)cur.ko * ESZ; cB += (size_t)cur.ko * ESZ; }
    if constexpr (GATHER) {
#pragma unroll
        for (int i = 0; i < 2; ++i) { vA0[i] = (unsigned)g.ridx[cur.pm * 256 + Rg[i]] * (unsigned)(g.lda * ESZ) + Cg[i]; vA1[i] = (unsigned)g.ridx[cur.pm * 256 + 128 + Rg[i]] * (unsigned)(g.lda * ESZ) + Cg[i]; }
    }
    PG8_STAGE(PG8_SB(0, 0), cB, voffB); PG8_STAGE(PG8_SB(0, 1), cB + hB, voffB); PG8_STAGE(PG8_SA(0, 0), cA, vA0); PG8_STAGE(PG8_SA(0, 1), cA, vA1);
    if (wr == 1) PG8_BAR;
    PG8_WAIT_V(2); PG8_BAR;
    PG8_STAGE(PG8_SB(1, 0), cB + kstep, voffB); PG8_STAGE(PG8_SA(1, 0), cA + kstep, vA0); PG8_STAGE(PG8_SB(1, 1), cB + hB + kstep, voffB);
    PG8_WAIT_V(6); PG8_BAR;
    for (;;) {
        bool has_next = false; int pulled = 0;
        if constexpr (DYN) { if (tid == 0) pulled = S.pull(); }
        else has_next = S.next(ui + 1, nxt);
        const char* nA = (has_next && !GATHER) ? (const char*)g.A + (size_t)nxt.pm * tA : cA; const char* nB = has_next ? (const char*)g.Bt + (size_t)nxt.pn * tB : cB;
        if constexpr (sched_kpair<Sched>::value) { if (has_next) { nA += (size_t)nxt.ko * ESZ; nB += (size_t)nxt.ko * ESZ; } }
        unsigned nv0[2] = {vA0[0], vA0[1]}, nv1[2] = {vA1[0], vA1[1]};
        for (int t = 0; t < nt; t += 2) {
            const bool last = (t == nt - 2);
            if constexpr (DYN) {
                if (t == nt / 2 && tid == 0) qslot[0] = pulled;
                if (last) { const int q1 = qslot[0]; has_next = S.unit(q1, nxt);
                    if (has_next) { nA = (const char*)g.A + (size_t)nxt.pm * tA; nB = (const char*)g.Bt + (size_t)nxt.pn * tB; } }
            }
            if constexpr (epi_has_mid<Epi>::value) { if (t == nt / 2) E.mid(acc, cur, wr, wc, fr, fq); }
            if constexpr (GATHER) {
                if (t == nt - 6 && has_next && wid == 0)
                    __builtin_amdgcn_global_load_lds((const unsigned*)(g.ridx + (size_t)nxt.pm * 256 + lane * 4), (PG8_LAS unsigned*)(lds + STAGE_BYTES), 16, 0, 0);
                if (last && has_next) {
#pragma unroll
                    for (int i = 0; i < 2; ++i) { nv0[i] = (unsigned)TBL[Rg[i]] * (unsigned)(g.lda * ESZ) + Cg[i]; nv1[i] = (unsigned)TBL[128 + Rg[i]] * (unsigned)(g.lda * ESZ) + Cg[i]; }
                }
            }
            const char* a1 = cA + (size_t)(t + 1) * kstep;
            const char* a2 = last ? nA : cA + (size_t)(t + 2) * kstep; const char* b2 = last ? nB : cB + (size_t)(t + 2) * kstep;
            const char* a3 = a2 + kstep; const char* b3 = b2 + kstep;
            const unsigned x0[2] = {(GATHER && last) ? nv0[0] : vA0[0], (GATHER && last) ? nv0[1] : vA0[1]}, x1[2] = {(GATHER && last) ? nv1[0] : vA1[0], (GATHER && last) ? nv1[1] : vA1[1]};
            PG8_LDB(B0, 0, 0); PG8_LDB(B1, 0, 1); PG8_SCHED; PG8_LDA(At, 0, 0); PG8_STAGE(PG8_SA(1, 1), a1, vA1);
            PG8_WAIT_V(8); PG8_WAIT_L(0); PG8_BAR; PG8_MMA(0, 0, At, B0); PG8_MMA(0, 1, At, B1); PG8_BAR; PG8_SCHED;
            PG8_LDA(At, 0, 1); PG8_STAGE(PG8_SB(0, 0), b2, voffB); PG8_STAGE(PG8_SB(0, 1), b2 + hB, voffB); PG8_STAGE(PG8_SA(0, 0), a2, x0);
            PG8_WAIT_V(8); PG8_WAIT_L(0); PG8_BAR; PG8_MMA(1, 0, At, B0); PG8_MMA(1, 1, At, B1); PG8_BAR; PG8_SCHED;
            PG8_LDB(B0, 1, 0); PG8_LDB(B1, 1, 1); PG8_SCHED; PG8_LDA(At, 1, 0); PG8_STAGE(PG8_SA(0, 1), a2, x1);
            PG8_WAIT_V(8); PG8_WAIT_L(0); PG8_BAR; PG8_MMA(0, 0, At, B0); PG8_MMA(0, 1, At, B1); PG8_BAR; PG8_SCHED;
            PG8_LDA(At, 1, 1); PG8_STAGE(PG8_SB(1, 0), b3, voffB); PG8_STAGE(PG8_SB(1, 1), b3 + hB, voffB); PG8_STAGE(PG8_SA(1, 0), a3, x0);
            PG8_WAIT_V(8); PG8_WAIT_L(0); PG8_BAR; PG8_MMA(1, 0, At, B0); PG8_MMA(1, 1, At, B1); PG8_BAR; PG8_SCHED;
        }
        if constexpr (ALIGN_EPI) { if (wr == 0) PG8_BAR; }
        if constexpr (F8) asm volatile("s_nop 15\n\ts_nop 15\n\ts_nop 15\n\ts_nop 15\n\ts_nop 15" ::: "memory");
        PG8_SUBP(23); PG8_SUBP(20);
        E(acc, cur, wr, wc, fr, fq);
        PG8_SUBP(21); PG8_SUBP(22);
        if (!has_next) break;
#pragma unroll
        for (int a = 0; a < 2; ++a)
#pragma unroll
            for (int b = 0; b < 2; ++b)
#pragma unroll
                for (int m = 0; m < 4; ++m)
#pragma unroll
                    for (int n = 0; n < 2; ++n) acc[a][b][m][n] = (f32x4){0.f, 0.f, 0.f, 0.f};
        cur = nxt; cA = nA; cB = nB; ++ui;
        if constexpr (GATHER) { vA0[0] = nv0[0]; vA0[1] = nv0[1]; vA1[0] = nv1[0]; vA1[1] = nv1[1]; }
        if constexpr (ALIGN_EPI) { if (wr == 1) PG8_BAR; }
    }
    PG8_WAIT_V(0);
    if constexpr (!ALIGN_EPI) { if (wr == 0) PG8_BAR; }
    PG8_BAR;
#undef PG8_SA
#undef PG8_SB
#undef PG8_STAGE
#undef PG8_LDA
#undef PG8_LDB
#undef PG8_MMA
#undef PG8_RD16
#undef PG8_WAIT_V
#undef PG8_WAIT_L
#undef PG8_BAR
#undef PG8_SCHED
}
}

namespace att {
typedef unsigned short bf16;
constexpr int D = 128, NW = 8, QBLK = 32, KVBLK = 64;
constexpr float SCALE = 0.088388347648318440f;
constexpr float THR = 8.f;
constexpr int LDQ = 1024, LDK = 256, LDO = 2048;
constexpr size_t SHM_V = KVBLK * D * 2, SHM_K = KVBLK * D * 2, SHM_ATTN = 2 * SHM_V + 2 * SHM_K + NW * 64 * 4;
using bf16x8 = __attribute__((ext_vector_type(8))) short;
using s16x4  = __attribute__((ext_vector_type(4))) short;
using f32x16 = __attribute__((ext_vector_type(16))) float;
using u32x4  = __attribute__((ext_vector_type(4))) unsigned;
#define KSWZ(row, colB) ((row) * 256 + ((colB) ^ (((row) & 7) << 4)))
#define SBAR() __builtin_amdgcn_sched_barrier(0)
__device__ __forceinline__ int crow(int r, int hi) { return (r & 3) + 8 * (r >> 2) + 4 * hi; }
__device__ __forceinline__ unsigned cvtpk(float lo, float hi) { unsigned r; asm volatile("v_cvt_pk_bf16_f32 %0, %1, %2" : "=v"(r) : "v"(lo), "v"(hi)); return r; }
__device__ __forceinline__ void partialSM(f32x16& p0, f32x16& p1, float& m_reg, float& mn, float& alpha) {
  constexpr float C = SCALE * 1.4426950408889634f;
  float pmax = p0[0]; for (int r = 1; r < 16; ++r) pmax = fmaxf(pmax, p0[r]); for (int r = 0; r < 16; ++r) pmax = fmaxf(pmax, p1[r]);
  { auto rr = __builtin_amdgcn_permlane32_swap(__float_as_uint(pmax), __float_as_uint(pmax), false, false);
    pmax = fmaxf(__uint_as_float(rr[0]), __uint_as_float(rr[1])); }
  if (__builtin_expect(__all(pmax - m_reg <= THR / SCALE), 1)) { mn = m_reg; alpha = 1.f; }
  else { mn = fmaxf(m_reg, pmax); alpha = __builtin_amdgcn_exp2f((m_reg - mn) * C); m_reg = mn; }
  float mnC = -mn * C;
  for (int r = 0; r < 16; ++r) p0[r] = fmaf(p0[r], C, mnC); for (int r = 0; r < 16; ++r) p1[r] = fmaf(p1[r], C, mnC);
  for (int r = 0; r < 16; ++r) p0[r] = __builtin_amdgcn_exp2f(p0[r]);
}
__device__ __forceinline__ void finishSM(f32x16& p0, f32x16& p1, float alpha, float& l_reg, bf16x8& pa0, bf16x8& pa1, bf16x8& pa2, bf16x8& pa3) {
  for (int r = 0; r < 16; ++r) p1[r] = __builtin_amdgcn_exp2f(p1[r]);
  float ps = 0; for (int r = 0; r < 16; ++r) ps += p0[r]; for (int r = 0; r < 16; ++r) ps += p1[r];
  { auto rr = __builtin_amdgcn_permlane32_swap(__float_as_uint(ps), __float_as_uint(ps), false, false);
    ps = __uint_as_float(rr[0]) + __uint_as_float(rr[1]); }
  l_reg = l_reg * alpha + ps;
#define PK4(P, BASE, OUT) do { unsigned a0 = cvtpk(P[BASE + 0], P[BASE + 1]), a1 = cvtpk(P[BASE + 2], P[BASE + 3]);   \
    unsigned b0 = cvtpk(P[BASE + 4], P[BASE + 5]), b1 = cvtpk(P[BASE + 6], P[BASE + 7]);                              \
    auto r0 = __builtin_amdgcn_permlane32_swap(a0, b0, false, false); auto r1 = __builtin_amdgcn_permlane32_swap(a1, b1, false, false); \
    u32x4 w = {r0[0], r1[0], r0[1], r1[1]}; OUT = *reinterpret_cast<bf16x8*>(&w); } while (0)
  PK4(p0, 0, pa0); PK4(p0, 8, pa1); PK4(p1, 0, pa2); PK4(p1, 8, pa3);
#undef PK4
}
__device__ __forceinline__ void qkt(f32x16& p0, f32x16& p1, const bf16* Ks, const bf16x8* qr, int r32, int hi) {
  p0 = f32x16{}; p1 = f32x16{};
  for (int d0 = 0; d0 < 8; ++d0) { int cb = (d0 * 16 + hi * 8) * 2;
    bf16x8 b0 = *reinterpret_cast<const bf16x8*>((const char*)Ks + KSWZ(r32, cb));
    bf16x8 b1 = *reinterpret_cast<const bf16x8*>((const char*)Ks + KSWZ(32 + r32, cb));
    p0 = __builtin_amdgcn_mfma_f32_32x32x16_bf16(b0, qr[d0], p0, 0, 0, 0);
    p1 = __builtin_amdgcn_mfma_f32_32x32x16_bf16(b1, qr[d0], p1, 0, 0, 0); }
}
__device__ __forceinline__ int v_st(int k, int c) { const int kk = (k & ~0xC) | ((k & 4) << 1) | ((k & 8) >> 1); return ((kk >> 3) * 4 + (c >> 5)) * 512 + ((kk & 7) * 32 + (c & 31)) * 2; }
__device__ __forceinline__ int v_rd_base(int lane) { return ((lane & 3) << 3) | (((lane >> 2) & 3) << 6) | (((lane >> 4) & 1) << 5) | (((lane >> 5) & 1) << 8); }
constexpr int v_rd_off(int d0, int ks, int half) { return d0 * 512 + ks * 4096 + half * 2048; }
template <int OFF> __device__ __forceinline__ s16x4 tr_read(int vb) {
  s16x4 r; asm volatile("ds_read_b64_tr_b16 %0, %1 offset:%2" : "=&v"(r) : "v"(vb), "i"(OFF) : "memory"); return r;
}
template <int D0> __device__ __forceinline__ void pv_one(f32x16& od, int vb, bf16x8 pa0, bf16x8 pa1, bf16x8 pa2, bf16x8 pa3) {
  const s16x4 l0 = tr_read<v_rd_off(D0, 0, 0)>(vb), h0 = tr_read<v_rd_off(D0, 0, 1)>(vb), l1 = tr_read<v_rd_off(D0, 1, 0)>(vb), h1 = tr_read<v_rd_off(D0, 1, 1)>(vb);
  const s16x4 l2 = tr_read<v_rd_off(D0, 2, 0)>(vb), h2 = tr_read<v_rd_off(D0, 2, 1)>(vb), l3 = tr_read<v_rd_off(D0, 3, 0)>(vb), h3 = tr_read<v_rd_off(D0, 3, 1)>(vb);
  asm volatile("s_waitcnt lgkmcnt(0)" ::: "memory"); SBAR();
#define PK(L, H) (bf16x8){L[0], L[1], L[2], L[3], H[0], H[1], H[2], H[3]}
  od = __builtin_amdgcn_mfma_f32_32x32x16_bf16(pa0, PK(l0, h0), od, 0, 0, 0);
  od = __builtin_amdgcn_mfma_f32_32x32x16_bf16(pa1, PK(l1, h1), od, 0, 0, 0);
  od = __builtin_amdgcn_mfma_f32_32x32x16_bf16(pa2, PK(l2, h2), od, 0, 0, 0);
  od = __builtin_amdgcn_mfma_f32_32x32x16_bf16(pa3, PK(l3, h3), od, 0, 0, 0);
#undef PK
}
__device__ __forceinline__ void pv_d0(f32x16* o, int vb, bf16x8 pa0, bf16x8 pa1, bf16x8 pa2, bf16x8 pa3) {
  pv_one<0>(o[0], vb, pa0, pa1, pa2, pa3); pv_one<1>(o[1], vb, pa0, pa1, pa2, pa3); pv_one<2>(o[2], vb, pa0, pa1, pa2, pa3); pv_one<3>(o[3], vb, pa0, pa1, pa2, pa3);
}
__device__ __forceinline__ void attn_dense_body(const bf16* __restrict__ Qb, const bf16* __restrict__ Kh, const bf16* __restrict__ Vh, bf16* __restrict__ Ob, int seq, char* lds, const int tid) {
  const int wid = tid >> 6, lane = tid & 63, r32 = lane & 31, hi = lane >> 5;
  bf16* V_lds = (bf16*)lds; bf16* K_lds = (bf16*)(lds + 2 * SHM_V);
  float* ws = (float*)(lds + 2 * SHM_V + 2 * SHM_K) + wid * 64; float* li_l = ws; float* al_l = ws + 32;
  float m_reg = -1e30f, l_reg = 0; f32x16 o[4] = {}; bf16x8 qr[8];
  const bf16* Qw = Qb + (long)(wid * QBLK + r32) * LDQ + hi * 8;
#pragma unroll
  for (int d0 = 0; d0 < 8; ++d0) qr[d0] = *reinterpret_cast<const bf16x8*>(Qw + d0 * 16);
  const int sr = tid >> 4, sc = (tid & 15) * 8, vst0 = v_st(sr, sc), vst1 = v_st(32 + sr, sc);
  const int vb0 = (int)(uintptr_t)V_lds + v_rd_base(lane);
  struct { bf16x8 vs0, vs1, ks0, ks1; } sr_[2];
#define LD8(p) (*reinterpret_cast<const bf16x8*>(p))
#define SLOAD(i, k0) do { sr_[i].vs0 = LD8(&Vh[(long)((k0) + sr) * LDK + sc]); sr_[i].vs1 = LD8(&Vh[(long)((k0) + 32 + sr) * LDK + sc]); \
    sr_[i].ks0 = LD8(&Kh[(long)((k0) + sr) * LDK + sc]); sr_[i].ks1 = LD8(&Kh[(long)((k0) + 32 + sr) * LDK + sc]); } while (0)
#define SWRITE(b, i) do { *(bf16x8*)((char*)V_lds + (b) * SHM_V + vst0) = sr_[i].vs0;          \
    *(bf16x8*)((char*)V_lds + (b) * SHM_V + vst1) = sr_[i].vs1; int kc = sc * 2;               \
    *(bf16x8*)((char*)K_lds + (b) * SHM_K + KSWZ(sr, kc)) = sr_[i].ks0;                       \
    *(bf16x8*)((char*)K_lds + (b) * SHM_K + KSWZ(32 + sr, kc)) = sr_[i].ks1; } while (0)
#define SWAIT() asm volatile("s_waitcnt vmcnt(4)" ::: "memory")
#define RESC(a) do { if (__any((a) < 1.f)) { if (hi == 0) al_l[r32] = (a); asm volatile("s_waitcnt lgkmcnt(0)" ::: "memory"); \
    for (int d = 0; d < 4; ++d) for (int r = 0; r < 16; ++r) o[d][r] *= al_l[crow(r, hi)]; } } while (0)
  f32x16 pA0, pA1, pB0, pB1; float mnA, mnB, alA, alB; bf16x8 pa0, pa1, pa2, pa3; const int NT = seq / KVBLK;
  constexpr int SE = 0, SO = 1;
  SLOAD(SE, 0); asm volatile("s_waitcnt vmcnt(0)" ::: "memory"); SWRITE(0, SE); __syncthreads();
  qkt(pA0, pA1, K_lds, qr, r32, hi); partialSM(pA0, pA1, m_reg, mnA, alA);
  SLOAD(SO, KVBLK); if (2 < NT) SLOAD(SE, 2 * KVBLK);
  SWAIT(); SWRITE(1, SO); __syncthreads();
  for (int j = 1; j + 1 < NT; j += 2) {
    SBAR(); qkt(pB0, pB1, (bf16*)((char*)K_lds + SHM_K), qr, r32, hi);
    finishSM(pA0, pA1, alA, l_reg, pa0, pa1, pa2, pa3); SBAR();
    SLOAD(SO, (j + 2) * KVBLK); SBAR();
    pv_d0(o, vb0, pa0, pa1, pa2, pa3); partialSM(pB0, pB1, m_reg, mnB, alB);
    __syncthreads(); SWAIT(); SWRITE(0, SE);
    RESC(alB); __syncthreads();
    SBAR(); qkt(pA0, pA1, K_lds, qr, r32, hi);
    finishSM(pB0, pB1, alB, l_reg, pa0, pa1, pa2, pa3); SBAR();
    if (j + 3 < NT) SLOAD(SE, (j + 3) * KVBLK); SBAR();
    pv_d0(o, vb0 + (int)SHM_V, pa0, pa1, pa2, pa3); partialSM(pA0, pA1, m_reg, mnA, alA);
    __syncthreads(); SWAIT(); SWRITE(1, SO);
    RESC(alA); __syncthreads();
  }
  SBAR(); qkt(pB0, pB1, (bf16*)((char*)K_lds + SHM_K), qr, r32, hi);
  finishSM(pA0, pA1, alA, l_reg, pa0, pa1, pa2, pa3); SBAR();
  pv_d0(o, vb0, pa0, pa1, pa2, pa3); partialSM(pB0, pB1, m_reg, mnB, alB);
  __syncthreads(); RESC(alB);
  finishSM(pB0, pB1, alB, l_reg, pa0, pa1, pa2, pa3); SBAR();
  pv_d0(o, vb0 + (int)SHM_V, pa0, pa1, pa2, pa3);
  if (hi == 0) li_l[r32] = l_reg; asm volatile("s_waitcnt lgkmcnt(0)" ::: "memory");
  float rli[16];
#pragma unroll
  for (int r = 0; r < 16; ++r) rli[r] = __builtin_amdgcn_rcpf(li_l[crow(r, hi)]);
  bf16* Ow = Ob + (long)(wid * QBLK) * LDO;
#pragma unroll
  for (int r = 0; r < 16; ++r) { int orow = crow(r, hi);
#pragma unroll
    for (int d0 = 0; d0 < 4; d0 += 1) { const unsigned w = cvtpk(o[d0][r] * rli[r], 0.f); Ow[(long)orow * LDO + d0 * 32 + r32] = (bf16)(w & 0xffffu); } }
  __syncthreads();
#undef LD8
#undef SLOAD
#undef SWRITE
#undef SWAIT
#undef RESC
}
}

constexpr int NWAVES = 8;
constexpr int N_LAUNCHES = MK_N_LAUNCHES;
constexpr int N_PHASES = 15;
constexpr int DM = 2048, NB = 4, T = 4096, LC = 256, M = NB * T, MC = NB * LC, SKV = LC + T;
constexpr int NE = 16, FFD = 2048, CAP = 512;
constexpr float EPS = 1e-6f;

constexpr size_t MiB = 1u << 20;
constexpr size_t WS_CTL = 0, CTL_ZERO_BYTES = 64 * 1024;
constexpr size_t WS_ZROW = 48 * 1024;
constexpr size_t WS_ROPE = 1 * MiB;
constexpr size_t WS_MOD = WS_ROPE + 64 * 1024;
constexpr size_t WS_WRT = WS_ROPE + 512 * 1024;
constexpr size_t WS_AFF = 2 * MiB;
constexpr size_t WS_ROWIDX = 3 * MiB;
constexpr size_t WS_TOPW = WS_ROWIDX + 256 * 1024;
constexpr size_t WS_INV = 4 * MiB;
constexpr size_t WS_MODP = 5 * MiB;
constexpr size_t WS_CRIT = 2 * MiB;
constexpr size_t WS_WIN = 8 * MiB;
constexpr size_t WS_WIN8 = WS_WIN + (size_t)2560 * 4096;
constexpr size_t WS_WOA = 42 * MiB, WS_WOR = 46 * MiB, WS_WOUT = 50 * MiB;
constexpr size_t WS_WGU = 58 * MiB;
constexpr size_t WS_WDN = 314 * MiB;
constexpr size_t WS_H = 442 * MiB;
constexpr size_t WS_QA = 510 * MiB, WS_QR = 542 * MiB, WS_GR = 558 * MiB, WS_GATE = 590 * MiB;
constexpr size_t WS_KA = 718 * MiB, WS_VA = WS_KA + (size_t)NB * SKV * 256 * 2, WS_KR = 735 * MiB, WS_VR = 752 * MiB;
constexpr size_t WS_ACT = 510 * MiB, WS_YEXP = 638 * MiB;
constexpr size_t WS_H8 = 786 * MiB;
constexpr size_t WS_U = 786 * MiB;
constexpr size_t WS_ST = 854 * MiB;
constexpr size_t WS_YO = 786 * MiB;
constexpr size_t WS_Y = 854 * MiB;
constexpr size_t WS_XG = 786 * MiB;
constexpr size_t WS_O = 918 * MiB;
constexpr size_t WS_END = 982 * MiB;
static_assert(WS_VA + (size_t)NB * SKV * 256 * 2 <= WS_KR && WS_KR + (size_t)NB * SKV * 512 * 2 <= WS_VR && WS_VR + (size_t)NB * SKV * 1024 * 2 <= WS_U, "z map");
static_assert(WS_XG + (size_t)32768 * 2048 * 2 <= WS_O, "xg map");
constexpr int CW_TMO = 0, CW_CODE = 1, CW_BAR = 4096, CW_QUEUE = 8192;

constexpr int RING_OFF = 0, RING_BYTES = 131072;
constexpr int SCRATCH_BYTES = 155648;
constexpr int LDSCTL_OFF = SCRATCH_BYTES, MISC_OFF = LDSCTL_OFF + 320;
constexpr int LDS_BYTES = 156672;
static_assert(MISC_OFF + 128 <= LDS_BYTES, "LDS map");

#define GAS __attribute__((address_space(1)))
#define LAS __attribute__((address_space(3)))
typedef unsigned short bf16;
typedef unsigned v4u __attribute__((ext_vector_type(4)));
typedef unsigned v2u __attribute__((ext_vector_type(2)));
typedef float f32x4 __attribute__((ext_vector_type(4)));
typedef GAS unsigned gu32;
#define RLX_AGENT __ATOMIC_RELAXED, __HIP_MEMORY_SCOPE_AGENT
#define LDS_WAIT() asm volatile("s_waitcnt lgkmcnt(0)" ::: "memory")
#define VM_WAIT() asm volatile("s_waitcnt vmcnt(0)" ::: "memory")
__device__ __forceinline__ unsigned pk2(float lo, float hi) { return pg8::cvt_pk_bf16(lo, hi); }
__device__ __forceinline__ float bflo(unsigned w) { return __uint_as_float(w << 16); }
__device__ __forceinline__ float bfhi(unsigned w) { return __uint_as_float(w & 0xffff0000u); }
__device__ __forceinline__ float bf1(bf16 b) { return __uint_as_float(((unsigned)b) << 16); }
__device__ __forceinline__ float siluf_(float x) { return x * __builtin_amdgcn_rcpf(1.0f + __expf(-x)); }

#define XB_TMO      128
#define XB_XCNT(j)  (256  + 64 * (j))
#define XB_XSUB(j)  (1280 + 64 * (j))
#define XB_XGEN(j)  (2304 + 64 * (j))
#define XB_TOP      3328
#define XB_TOPGEN   3392
#define XCD_BAR_WORDS 3456
#define XB_SPIN_CAP (1u << 18)
__device__ __forceinline__ unsigned xb_ld(unsigned* p)              { return __hip_atomic_load(p, __ATOMIC_RELAXED, __HIP_MEMORY_SCOPE_AGENT); }
__device__ __forceinline__ unsigned xb_add(unsigned* p, unsigned v) { return __hip_atomic_fetch_add(p, v, __ATOMIC_RELAXED, __HIP_MEMORY_SCOPE_AGENT); }
__device__ __forceinline__ unsigned xb_xcc_id() { return (unsigned)__builtin_amdgcn_s_getreg((3 << 11) | 20) & 0xFu; }
#define XB_SPIN(cond, bar) do { unsigned _sp = 0; while (cond) { __builtin_amdgcn_s_sleep(1); \
    if ((++_sp & 255u) == 0u) { if (xb_ld(&(bar)[XB_TMO])) break; if (_sp > XB_SPIN_CAP) { atomicAdd(&(bar)[XB_TMO], 1u); break; } } } } while (0)
struct XcdBarrier { unsigned* bar; unsigned x; volatile LAS unsigned* st; };
__device__ __forceinline__ XcdBarrier xcd_barrier_post(unsigned* bar, volatile LAS unsigned* st) {
    XcdBarrier b; b.bar = bar; b.x = xb_xcc_id(); b.st = st;
    if (threadIdx.x == 0) (void)xb_add(&bar[XB_XCNT(b.x)], 1u);
    return b;
}
__device__ __forceinline__ void xcd_barrier_complete(unsigned* bar, unsigned x, unsigned& nloc, unsigned& nx) {
    const unsigned G = gridDim.x * gridDim.y * gridDim.z;
    unsigned sum, cnt, mine, sp = 0u;
    for (;;) {
        sum = 0u; cnt = 0u; mine = 0u;
#pragma unroll
        for (unsigned j = 0; j < 16; ++j) { const unsigned c = xb_ld(&bar[XB_XCNT(j)]); sum += c; cnt += (c > 0u) ? 1u : 0u; mine = (j == x) ? c : mine; }
        if (sum == G) break;
        __builtin_amdgcn_s_sleep(1);
        if ((++sp & 255u) == 0u) { if (xb_ld(&bar[XB_TMO])) break; if (sp > XB_SPIN_CAP) { atomicAdd(&bar[XB_TMO], 1u); break; } }
    }
    nloc = mine > 0u ? mine : 1u; nx = cnt > 0u ? cnt : 1u;
}
__device__ __forceinline__ void xcd_barrier(const XcdBarrier& b) {
    asm volatile("s_waitcnt vmcnt(0)" ::: "memory");
    __syncthreads();
    if (threadIdx.x == 0) {
        unsigned* bar = b.bar;
        __builtin_amdgcn_s_waitcnt(0);
        unsigned nloc = b.st[0], nx = b.st[1];
        if (nloc == 0u) { xcd_barrier_complete(bar, b.x, nloc, nx); b.st[0] = nloc; b.st[1] = nx; }
        const unsigned old = xb_add(&bar[XB_XSUB(b.x)], 1u);
        const unsigned gen = old / nloc;
        if (old + 1u == (gen + 1u) * nloc) {
            __builtin_amdgcn_fence(__ATOMIC_RELEASE, "agent");
            asm volatile("s_waitcnt vmcnt(0)" ::: "memory");
            const unsigned og = xb_add(&bar[XB_TOP], 1u);
            const unsigned tg = og / nx;
            if (og + 1u == (tg + 1u) * nx) xb_add(&bar[XB_TOPGEN], 1u);
            else XB_SPIN(xb_ld(&bar[XB_TOPGEN]) == tg, bar);
            __builtin_amdgcn_fence(__ATOMIC_ACQUIRE, "agent");
            xb_add(&bar[XB_XGEN(b.x)], 1u);
            asm volatile("s_waitcnt vmcnt(0)" ::: "memory");
        } else {
            XB_SPIN(xb_ld(&bar[XB_XGEN(b.x)]) == gen, bar);
            __builtin_amdgcn_fence(__ATOMIC_ACQUIRE, "agent");
            asm volatile("s_waitcnt vmcnt(0)" ::: "memory");
        }
    }
    __syncthreads();
}

struct Frame {
    LAS unsigned char* lds;
    volatile LAS unsigned* MISC;
    gu32* ctl;
    int tid, lane, wave;
    int vcu, G;
    float* out; unsigned char* ws;
};
enum { I_X = 0, I_C, I_CTX, I_CCTX, I_WMOD, I_BMOD, I_PRE1, I_POST1, I_PRE2, I_POST2, I_WIN, I_QN, I_KN, I_DECAY, I_GN, I_WOA, I_WOR, I_WOUT, I_WR, I_WG, I_WU, I_WD };
__device__ __forceinline__ const float* inp(const Frame& F, int k) {
    const unsigned long long v = ((const LAS unsigned long long*)(F.lds + LDSCTL_OFF))[k];
    const unsigned lo = __builtin_amdgcn_readfirstlane((unsigned)v), hi = __builtin_amdgcn_readfirstlane((unsigned)(v >> 32));
    return (const float*)(const GAS float*)(((unsigned long long)hi << 32) | lo);
}

#ifndef PROBE_SUB
#define PROBE_SUB -1
#endif
#define SUBP(F, k) do { if (PROBE_SUB >= 0 && F.tid == 0) { if ((k) == PROBE_SUB) { const unsigned long long t_ = __builtin_amdgcn_s_memrealtime(); F.MISC[16] = (unsigned)t_; F.MISC[17] = (unsigned)(t_ >> 32); } \
    if ((k) == PROBE_SUB + 1) { const unsigned long long t0_ = ((unsigned long long)F.MISC[17] << 32) | F.MISC[16]; const unsigned long long a_ = (((unsigned long long)F.MISC[19] << 32) | F.MISC[18]) + (__builtin_amdgcn_s_memrealtime() - t0_); F.MISC[18] = (unsigned)a_; F.MISC[19] = (unsigned)(a_ >> 32); } } } while (0)
__device__ __forceinline__ float wave_sum(float v) {
#pragma unroll
    for (int o = 1; o < 64; o <<= 1) v += __shfl_xor(v, o);
    return v;
}

constexpr int I_IN = 32 * 272, I_OA = 16 * 64, I_OUT = 32 * 64, I_EX = 16 * 2048;
constexpr int N_SMALL_ITEMS = I_IN + 2 * I_OA + I_OUT, N_COPY_ITEMS = N_SMALL_ITEMS + 3 * I_EX;
struct CopyDesc { const float* src; bf16* dst; int ldw, ldt, hp, f8; };
__device__ __forceinline__ CopyDesc copy_desc(Frame& F, int it) {
    unsigned char* ws = F.ws; int r = it; CopyDesc d;
    d.hp = 0; d.f8 = 0;
    if (r < I_IN) { const int kb = r / 272, nb = r % 272, C0 = 32 * nb; d.src = inp(F, I_WIN) + (size_t)(64 * kb) * 8704 + C0; d.ldw = 8704; d.ldt = 2048;
        const bool headcols = C0 < 1536 || (C0 >= 6656 && C0 < 6912) || (C0 >= 7168 && C0 < 7680);
        if (headcols) { const int c0 = C0 & 127; d.hp = 1; d.dst = (bf16*)(ws + WS_WIN) + (size_t)((C0 & ~127) + 64 * (c0 >> 6) + 4 * ((c0 >> 5) & 1)) * 2048 + 64 * kb; }
        else if (C0 >= 2560 && C0 < 6656) { d.f8 = 1; d.dst = (bf16*)(ws + WS_WIN8 + (size_t)(C0 - 2560) * 2048 + 64 * kb); }
        else d.dst = (bf16*)(ws + WS_WIN) + (size_t)C0 * 2048 + 64 * kb;
        return d; } r -= I_IN;
    if (r < 2 * I_OA) { const int second = r >= I_OA; if (second) r -= I_OA; const int kb = r / 64, nb = r % 64; d.src = inp(F, second ? I_WOR : I_WOA) + (size_t)(64 * kb) * 2048 + 32 * nb; d.ldw = 2048;
        d.dst = (bf16*)(ws + WS_WOA) + (size_t)(32 * nb) * 2048 + second * 1024 + 64 * kb; d.ldt = 2048; return d; } r -= 2 * I_OA;
    if (r < I_OUT) { const int kb = r / 64, nb = r % 64; d.src = inp(F, I_WOUT) + (size_t)(64 * kb) * 2048 + 32 * nb; d.ldw = 2048; d.dst = (bf16*)(ws + WS_WOUT) + (size_t)(32 * nb) * 2048 + 64 * kb; d.ldt = 2048; return d; } r -= I_OUT;
    d.ldw = 2048; d.ldt = 2048;
    if (r < 2 * I_EX) { const int up = r >= I_EX; if (up) r -= I_EX; const int e = r >> 11, q = r & 2047, kb = q / 64, nb = q % 64, n0 = 32 * nb;
        d.src = inp(F, up ? I_WU : I_WG) + (size_t)e * 2048 * 2048 + (size_t)(64 * kb) * 2048 + n0; d.f8 = 1;
        d.dst = (bf16*)(ws + WS_WGU + (size_t)(e * 4096 + (n0 >> 7) * 256 + up * 128 + (n0 & 127)) * 2048 + 64 * kb); return d; } r -= 2 * I_EX;
    { const int e = r >> 11, q = r & 2047, kb = q / 64, nb = q % 64; d.src = inp(F, I_WD) + (size_t)e * 2048 * 2048 + (size_t)(64 * kb) * 2048 + 32 * nb; d.f8 = 1;
      d.dst = (bf16*)(ws + WS_WDN + (size_t)(e * 2048 + 32 * nb) * 2048 + 64 * kb); return d; }
}
template <int NI> __device__ __forceinline__ void copy_items(Frame& F, int it0, int stride, int it_end, LAS float* scr) {
    const int lane = F.lane, c = lane >> 3, g = lane & 7; f32x4 wv[NI][8]; CopyDesc d[NI]; (void)scr;
#pragma unroll
    for (int q = 0; q < NI; ++q) { const int it = it0 + q * stride; if (it < it_end) { d[q] = copy_desc(F, it);
#pragma unroll
            for (int i = 0; i < 8; ++i) wv[q][i] = __builtin_nontemporal_load((const f32x4*)(d[q].src + (size_t)(8 * c + i) * d[q].ldw + 4 * g)); } }
#pragma unroll
    for (int q = 0; q < NI; ++q) { const int it = it0 + q * stride; if (it < it_end) {
#pragma unroll
            for (int j = 0; j < 4; ++j) { const int n = 4 * g + j;
                const int nr = d[q].hp ? (32 * (n >> 4) + 8 * ((n >> 2) & 3) + (n & 3)) : n;
                if (d[q].f8) { v2u o8; o8.x = pg8::pk4_fp8(wv[q][0][j] * 64.f, wv[q][1][j] * 64.f, wv[q][2][j] * 64.f, wv[q][3][j] * 64.f); o8.y = pg8::pk4_fp8(wv[q][4][j] * 64.f, wv[q][5][j] * 64.f, wv[q][6][j] * 64.f, wv[q][7][j] * 64.f);
                    __builtin_nontemporal_store(o8, (GAS v2u*)((unsigned char*)d[q].dst + (size_t)nr * d[q].ldt + 8 * c)); }
                else { v4u o; o.x = pk2(wv[q][0][j], wv[q][1][j]); o.y = pk2(wv[q][2][j], wv[q][3][j]); o.z = pk2(wv[q][4][j], wv[q][5][j]); o.w = pk2(wv[q][6][j], wv[q][7][j]);
                    __builtin_nontemporal_store(o, (GAS v4u*)(d[q].dst + (size_t)nr * d[q].ldt + 8 * c)); } } } }
}
#ifndef CONV_PER_XCD
#define CONV_PER_XCD 9
#endif
constexpr int COPY_CHUNK = 32;
constexpr int N_QUEUE_ITEMS = N_COPY_ITEMS - I_IN;
static_assert(N_QUEUE_ITEMS % COPY_CHUNK == 0, "copy queue");
__device__ __forceinline__ void copy_pair_load(Frame& F, int it, f32x4 (&w)[2][8], CopyDesc (&d)[2]) {
    const int c = F.lane >> 3, g = F.lane & 7;
#pragma unroll
    for (int q = 0; q < 2; ++q) { d[q] = copy_desc(F, it + q * NWAVES);
#pragma unroll
        for (int i = 0; i < 8; ++i) w[q][i] = __builtin_nontemporal_load((const f32x4*)(d[q].src + (size_t)(8 * c + i) * d[q].ldw + 4 * g)); }
}
__device__ __forceinline__ void copy_pair_store(Frame& F, const f32x4 (&w)[2][8], const CopyDesc (&d)[2]) {
    const int c = F.lane >> 3, g = F.lane & 7;
#pragma unroll
    for (int q = 0; q < 2; ++q)
#pragma unroll
        for (int j = 0; j < 4; ++j) { const int n = 4 * g + j;
            const int nr = d[q].hp ? (32 * (n >> 4) + 8 * ((n >> 2) & 3) + (n & 3)) : n;
            if (d[q].f8) { v2u o8; o8.x = pg8::pk4_fp8(w[q][0][j] * 64.f, w[q][1][j] * 64.f, w[q][2][j] * 64.f, w[q][3][j] * 64.f); o8.y = pg8::pk4_fp8(w[q][4][j] * 64.f, w[q][5][j] * 64.f, w[q][6][j] * 64.f, w[q][7][j] * 64.f);
                __builtin_nontemporal_store(o8, (GAS v2u*)((unsigned char*)d[q].dst + (size_t)nr * d[q].ldt + 8 * c)); }
            else { v4u o; o.x = pk2(w[q][0][j], w[q][1][j]); o.y = pk2(w[q][2][j], w[q][3][j]); o.z = pk2(w[q][4][j], w[q][5][j]); o.w = pk2(w[q][6][j], w[q][7][j]);
                __builtin_nontemporal_store(o, (GAS v4u*)(d[q].dst + (size_t)nr * d[q].ldt + 8 * c)); } }
}
__device__ __forceinline__ void copy_queue_drain(Frame& F, const int qword = 8, const int item0 = I_IN, const unsigned NT = (unsigned)(N_QUEUE_ITEMS / COPY_CHUNK)) {
    unsigned* ctr = (unsigned*)(F.ctl + CW_QUEUE + 64 * qword);
    if (F.tid == 0) F.MISC[24] = __hip_atomic_fetch_add(ctr, 1u, __ATOMIC_RELAXED, __HIP_MEMORY_SCOPE_AGENT);
    __syncthreads();
    unsigned ticket = F.MISC[24];
    if (ticket < NT) {
        f32x4 wa[2][8], wb[2][8]; CopyDesc da[2], db[2]; int par = 1;
        int base = item0 + (int)ticket * COPY_CHUNK + F.wave;
        copy_pair_load(F, base, wa, da);
        for (;;) {
            unsigned nxt = 0u; if (F.tid == 0) nxt = __hip_atomic_fetch_add(ctr, 1u, __ATOMIC_RELAXED, __HIP_MEMORY_SCOPE_AGENT);
            copy_pair_load(F, base + 2 * NWAVES, wb, db);
            copy_pair_store(F, wa, da);
            if (F.tid == 0) F.MISC[24 + par] = nxt;
            __syncthreads();
            const unsigned tn = F.MISC[24 + par]; par ^= 1;
            const bool more = tn < NT;
            if (more) { base = item0 + (int)tn * COPY_CHUNK + F.wave; copy_pair_load(F, base, wa, da); }
            copy_pair_store(F, wb, db);
            if (!more) break;
        }
    }
    __syncthreads();
}
__device__ __forceinline__ void mod_gemv_units(Frame& F, int u0, int nunits, int ustride, bool deferred) {
    unsigned char* ws = F.ws;
    {
        LAS float* sl = (LAS float*)(F.lds);
        LAS float* red = (LAS float*)(F.lds + 40960);
        if (u0 >= nunits) return;
        { const float* cp = inp(F, I_C); const float* cc = inp(F, I_CCTX); float v[20];
#pragma unroll
          for (int q = 0; q < 20; ++q) { const int i = F.tid + 512 * q; v[q] = i < 4 * 2048 ? cp[i] : cc[i - 4 * 2048]; }
#pragma unroll
          for (int q = 0; q < 20; ++q) sl[F.tid + 512 * q] = siluf_(v[q]); }
        __syncthreads();
        const int kg = F.tid >> 7, c4 = F.tid & 127;
        for (int u = u0; u < nunits; u += ustride) {
            const int kc = deferred ? u / 16 : u / 8, nc = deferred ? 8 + u % 16 : u % 8, KR = deferred ? 256 : 128;
            f32x4 a0 = {0, 0, 0, 0}, a1 = a0, a2 = a0, a3 = a0, a4 = a0;
            const float* wp = inp(F, I_WMOD) + (size_t)(KR * kc + kg) * 12288 + 512 * nc + 4 * c4;
#pragma unroll 8
            for (int kk = 0; kk < KR / 4; ++kk) {
                const f32x4 w = __builtin_nontemporal_load((const f32x4*)(wp + (size_t)(4 * kk) * 12288)); const int k = KR * kc + 4 * kk + kg;
                a0 += w * sl[k]; a1 += w * sl[2048 + k]; a2 += w * sl[4096 + k]; a3 += w * sl[6144 + k]; a4 += w * sl[8192 + k];
            }
            *(LAS f32x4*)(red + (kg * 5 + 0) * 512 + 4 * c4) = a0; *(LAS f32x4*)(red + (kg * 5 + 1) * 512 + 4 * c4) = a1; *(LAS f32x4*)(red + (kg * 5 + 2) * 512 + 4 * c4) = a2;
            *(LAS f32x4*)(red + (kg * 5 + 3) * 512 + 4 * c4) = a3; *(LAS f32x4*)(red + (kg * 5 + 4) * 512 + 4 * c4) = a4;
            __syncthreads();
            float* mp = deferred ? (float*)(ws + WS_MODP) + (size_t)kc * 5 * 12288 + 512 * nc : (float*)(ws + WS_CRIT) + (size_t)kc * 5 * 4096 + 512 * nc; const int bstride = deferred ? 12288 : 4096;
            for (int i = F.tid; i < 5 * 512; i += 512) { const int b = i >> 9, n = i & 511; mp[b * bstride + n] = red[(0 * 5 + b) * 512 + n] + red[(1 * 5 + b) * 512 + n] + red[(2 * 5 + b) * 512 + n] + red[(3 * 5 + b) * 512 + n]; }
            __syncthreads();
        }
    }
}
__device__ __forceinline__ void p0_prologue(Frame& F) {
    unsigned char* ws = F.ws;
    SUBP(F, 10);
    mod_gemv_units(F, F.vcu, 128, F.G, false);
    SUBP(F, 12);
    if (F.vcu == F.G - 1) {
        float* tab = (float*)(ws + WS_ROPE);
        for (int i = F.tid; i < 64 * 32; i += 512) { const int p = i >> 5, j = i & 31; const float inv = powf(10000.0f, -(float)j / 32.0f); const float ang = (float)p * inv; tab[2 * i] = cosf(ang); tab[2 * i + 1] = sinf(ang); }
    }
    if (F.vcu == F.G - 2) { float* wt = (float*)(ws + WS_WRT); const float* wr = inp(F, I_WR);
#pragma unroll 1
        for (int i0 = F.tid; i0 < 2048 * 16; i0 += 512 * 16) { float v[16];
#pragma unroll
            for (int q = 0; q < 16; ++q) v[q] = wr[i0 + 512 * q];
#pragma unroll
            for (int q = 0; q < 16; ++q) { const int i = i0 + 512 * q; wt[(i & 15) * 2048 + (i >> 4)] = v[q]; } } }
    SUBP(F, 13);
    __syncthreads();
    copy_queue_drain(F, 9, 0, (unsigned)(I_IN / COPY_CHUNK));
    if (PROBE_SUB >= 0) { VM_WAIT(); __syncthreads(); }
    SUBP(F, 14);
}
__device__ __forceinline__ float crit_val(const Frame& F, int b, int n) {
    const float* mp = (const float*)(F.ws + WS_CRIT) + (size_t)b * 4096 + n; float s = inp(F, I_BMOD)[n];
#pragma unroll
    for (int kc = 0; kc < 16; ++kc) s += mp[(size_t)kc * 5 * 4096];
    return s;
}
__device__ __forceinline__ f32x4 crit_val4(const Frame& F, int b, int n) {
    const float* mp = (const float*)(F.ws + WS_CRIT) + (size_t)b * 4096 + n; f32x4 s = *(const f32x4*)(inp(F, I_BMOD) + n);
#pragma unroll
    for (int kc = 0; kc < 16; ++kc) s += *(const f32x4*)(mp + (size_t)kc * 5 * 4096);
    return s;
}
__device__ __forceinline__ float mod_val(const Frame& F, int b, int n) {
    const float* mp = (const float*)(F.ws + WS_MODP) + (size_t)b * 12288 + n; float s = inp(F, I_BMOD)[n];
#pragma unroll
    for (int kc = 0; kc < 8; ++kc) s += mp[(size_t)kc * 5 * 12288];
    return s;
}
__device__ __forceinline__ void rms_row_load(const float* xrow, f32x4 (&v)[8], int lane) {
    const f32x4* xr = (const f32x4*)xrow + lane;
#pragma unroll
    for (int j = 0; j < 8; ++j) v[j] = __builtin_nontemporal_load(xr + 64 * j);
}
__device__ __forceinline__ void rms_row_finish(const f32x4 (&v)[8], bf16* orow, unsigned char* orow8, const LAS float* A, const LAS float* Bv, int lane) {
    float s = 0.f;
#pragma unroll
    for (int j = 0; j < 8; ++j) s += (v[j].x * v[j].x + v[j].y * v[j].y) + (v[j].z * v[j].z + v[j].w * v[j].w);
    const float r = 1.0f / sqrtf(wave_sum(s) * (1.0f / DM) + EPS);
    v2u* o8 = (v2u*)orow + lane;
#pragma unroll
    for (int j = 0; j < 8; ++j) { const f32x4 a = *(const LAS f32x4*)(A + 4 * (64 * j + lane)), b = *(const LAS f32x4*)(Bv + 4 * (64 * j + lane)); const f32x4 h = v[j] * r * a + b;
        v2u w; w.x = pk2(h.x, h.y); w.y = pk2(h.z, h.w); o8[64 * j] = w;
        if (orow8) ((unsigned*)orow8 + lane)[64 * j] = pg8::pk4_fp8(h.x * 4.f, h.y * 4.f, h.z * 4.f, h.w * 4.f); }
}
__device__ __forceinline__ void rms_mod_row(const float* xrow, bf16* orow, unsigned char* orow8, const LAS float* A, const LAS float* Bv, int lane) {
    f32x4 v[8]; rms_row_load(xrow, v, lane); rms_row_finish(v, orow, orow8, A, Bv, lane);
}
__device__ __forceinline__ void p1_h(Frame& F) {
    LAS float* A = (LAS float*)F.lds; LAS float* Bv = A + 2048; LAS float* Ac = A + 4096; LAS float* Bc = A + 6144;
    const int b = F.vcu & 3, sub = F.vcu >> 2, nsub = F.G >> 2;
    { const int k = 4 * F.tid; const f32x4 g = *(const f32x4*)(inp(F, I_PRE1) + k);
      *(LAS f32x4*)(A + k) = g * (1.0f + crit_val4(F, b, 2048 + k)); *(LAS f32x4*)(Bv + k) = crit_val4(F, b, k); *(LAS f32x4*)(Ac + k) = g * (1.0f + crit_val4(F, 4, 2048 + k)); *(LAS f32x4*)(Bc + k) = crit_val4(F, 4, k); }
    __syncthreads();
    bf16* H = (bf16*)(F.ws + WS_H);
    {
        const float* X = inp(F, I_X); const int step = nsub * NWAVES; int t = sub * NWAVES + F.wave;
        f32x4 v[8], nv[8];
        if (t < T) rms_row_load(X + ((size_t)b * T + t) * DM, v, F.lane);
        for (; t < T; t += step) { const size_t m = (size_t)b * T + t; const bool more = t + step < T;
            if (more) rms_row_load(X + (m + step) * DM, nv, F.lane);
            rms_row_finish(v, H + m * DM, F.ws + WS_H8 + m * DM, A, Bv, F.lane);
            if (more) {
#pragma unroll
                for (int j = 0; j < 8; ++j) v[j] = nv[j]; } }
    }
    for (int r = F.vcu * NWAVES + F.wave; r < MC; r += F.G * NWAVES) rms_mod_row(inp(F, I_CTX) + (size_t)r * DM, H + (size_t)(M + r) * DM, nullptr, Ac, Bc, F.lane);
}

__device__ __forceinline__ void head_op(bf16* hp, int c, bool active, bool do_norm, const float* g, bool do_scale, bool do_rope, int prow, int pcol, const LAS float* tab) {
    v4u raw = {0u, 0u, 0u, 0u}; if (active) raw = *(const v4u*)(hp + 8 * c);
    float v[8] = {bflo(raw.x), bfhi(raw.x), bflo(raw.y), bfhi(raw.y), bflo(raw.z), bfhi(raw.z), bflo(raw.w), bfhi(raw.w)};
    float ss = 0.f;
#pragma unroll
    for (int i = 0; i < 8; ++i) ss += v[i] * v[i];
    ss += __shfl_xor(ss, 1); ss += __shfl_xor(ss, 2); ss += __shfl_xor(ss, 4); ss += __shfl_xor(ss, 8);
    const float r = 1.0f / sqrtf(ss * (1.0f / 128.0f) + EPS);
#pragma unroll
    for (int i = 0; i < 8; ++i) { float x = v[i]; if (do_norm) x = x * r * g[8 * c + i]; if (do_scale) x *= 0.08838834764831845f; v[i] = x; }
    const int a = c >> 3, p = (c >> 2) & 1, jb = (c & 3) * 8, pos = a ? pcol : prow;
    const LAS f32x4* tp = (const LAS f32x4*)(tab + (pos * 32 + jb) * 2);
    const f32x4 t0 = tp[0], t1 = tp[1], t2 = tp[2], t3 = tp[3];
    const float cs[8] = {t0[0], t0[2], t1[0], t1[2], t2[0], t2[2], t3[0], t3[2]}, sn[8] = {t0[1], t0[3], t1[1], t1[3], t2[1], t2[3], t3[1], t3[3]};
#pragma unroll
    for (int i = 0; i < 8; ++i) { const float pv = __shfl_xor(v[i], 4);
        if (do_rope) v[i] = p ? (v[i] * cs[i] + pv * sn[i]) : (v[i] * cs[i] - pv * sn[i]); }
    if (active) { v4u o; o.x = pk2(v[0], v[1]); o.y = pk2(v[2], v[3]); o.z = pk2(v[4], v[5]); o.w = pk2(v[6], v[7]); *(v4u*)(hp + 8 * c) = o; }
}
__device__ __forceinline__ void p3_rope(Frame& F) {
    unsigned char* ws = F.ws; LAS float* tab = (LAS float*)F.lds;
    { const f32x4* tg = (const f32x4*)(ws + WS_ROPE);
#pragma unroll
      for (int i = F.tid; i < 64 * 32 * 2 / 4; i += 512) *(LAS f32x4*)(tab + 4 * i) = tg[i]; }
    __syncthreads();
    const int gw = F.vcu * NWAVES + F.wave, NGW = F.G * NWAVES, grp = F.lane >> 4, c = F.lane & 15;
    for (int m = gw; m < M; m += NGW) {
        const int b = m >> 12, t = m & 4095, prow = t >> 6, pcol = t & 63; const size_t kvrow = (size_t)b * SKV + LC + t;
#pragma unroll
        for (int s = 0; s < 5; ++s) {
            const int slot = 4 * s + grp; const bool active = slot < 18;
            bf16* hp; bool do_norm = false, do_scale = false; const float* g = inp(F, I_QN);
            if (slot < 8) { hp = (bf16*)(ws + WS_QA) + (size_t)m * 1024 + slot * 128; do_norm = true; }
            else if (slot < 12) { hp = (bf16*)(ws + WS_QR) + (size_t)m * 512 + (slot - 8) * 128; }
            else if (slot < 14) { hp = (bf16*)(ws + WS_KA) + kvrow * 256 + (slot - 12) * 128; do_norm = true; g = inp(F, I_KN); }
            else { hp = (bf16*)(ws + WS_KR) + kvrow * 512 + ((slot - 14) & 3) * 128; do_scale = true; }
            head_op(hp, c, active, do_norm, g, do_scale, true, prow, pcol, tab);
        }
    }
    for (int r = gw; r < MC; r += NGW) {
        const int b = r >> 8, l = r & 255; const size_t kvrow = (size_t)b * SKV + l;
#pragma unroll
        for (int s = 0; s < 2; ++s) {
            const int slot = 4 * s + grp; const bool active = slot < 6;
            bf16* hp; bool do_norm = false, do_scale = false;
            if (slot < 2) { hp = (bf16*)(ws + WS_KA) + kvrow * 256 + slot * 128; do_norm = true; }
            else { hp = (bf16*)(ws + WS_KR) + kvrow * 512 + ((slot - 2) & 3) * 128; do_scale = true; }
            head_op(hp, c, active, do_norm, inp(F, I_KN), do_scale, false, 0, 0, tab);
        }
    }
}

__device__ __forceinline__ float softplusf_(float x) { return x > 20.f ? x : log1pf(expf(x)); }
__device__ __forceinline__ float log_gamma(const Frame& F, int dir, int h) { return -softplusf_(inp(F, I_DECAY)[dir * 4 + h]); }

__device__ __forceinline__ void p4_chunk_states(Frame& F) {
    unsigned char* ws = F.ws;
    LAS bf16* Ks = (LAS bf16*)F.lds;
    LAS bf16* Vs = (LAS bf16*)(F.lds + 32768);
    for (int u = F.vcu; u < NB * 4 * 34; u += F.G) {
        int tid = F.tid; asm volatile("" : "+v"(tid));
        const int td = tid & 15, tv = tid >> 4;
        const int cidx = u % 34, h = (u / 34) & 3, b = u / (34 * 4);
        const float lgf = log_gamma(F, 0, h), lgb = log_gamma(F, 1, h);
        const size_t row0 = (size_t)b * SKV + 128 * cidx;
        const bf16* Kg = (const bf16*)(ws + WS_KR) + row0 * 512 + h * 128; const bf16* Vg = (const bf16*)(ws + WS_VR) + row0 * 1024 + h * 256;
        for (int i = tid; i < 128 * 16; i += 512) { const int j = i >> 4, cc = i & 15; *(LAS v4u*)(Ks + j * 128 + 8 * cc) = *(const v4u*)(Kg + (size_t)j * 512 + 8 * cc); }
        for (int i = tid; i < 128 * 32; i += 512) { const int j = i >> 5, cc = i & 31; *(LAS v4u*)(Vs + j * 256 + 8 * cc) = *(const v4u*)(Vg + (size_t)j * 1024 + 8 * cc); }
        __syncthreads();
        float af[8][8], ab[8][8];
#pragma unroll
        for (int x = 0; x < 8; ++x)
#pragma unroll
            for (int y = 0; y < 8; ++y) { af[x][y] = 0.f; ab[x][y] = 0.f; }
        for (int j = 0; j < 128; ++j) {
            const v4u kr = *(const LAS v4u*)(Ks + j * 128 + 8 * td), vr = *(const LAS v4u*)(Vs + j * 256 + 8 * tv);
            const float wf = __expf(lgf * (float)(127 - j)), wb = __expf(lgb * (float)j);
            const float kk[8] = {bflo(kr.x), bfhi(kr.x), bflo(kr.y), bfhi(kr.y), bflo(kr.z), bfhi(kr.z), bflo(kr.w), bfhi(kr.w)};
            const float vv[8] = {bflo(vr.x), bfhi(vr.x), bflo(vr.y), bfhi(vr.y), bflo(vr.z), bfhi(vr.z), bflo(vr.w), bfhi(vr.w)};
#pragma unroll
            for (int x = 0; x < 8; ++x) { const float vf = vv[x] * wf, vbk = vv[x] * wb;
#pragma unroll
                for (int y = 0; y < 8; ++y) { af[x][y] += vf * kk[y]; ab[x][y] += vbk * kk[y]; } }
        }
        bf16* Uf = (bf16*)(ws + WS_U) + ((((size_t)(b * 4 + h) * 2 + 0) * 34 + cidx) * 256) * 128; bf16* Ub = Uf + (size_t)34 * 256 * 128;
#pragma unroll
        for (int x = 0; x < 8; ++x) { v4u o; o.x = pk2(af[x][0], af[x][1]); o.y = pk2(af[x][2], af[x][3]); o.z = pk2(af[x][4], af[x][5]); o.w = pk2(af[x][6], af[x][7]); *(v4u*)(Uf + (size_t)(8 * tv + x) * 128 + 8 * td) = o;
            o.x = pk2(ab[x][0], ab[x][1]); o.y = pk2(ab[x][2], ab[x][3]); o.z = pk2(ab[x][4], ab[x][5]); o.w = pk2(ab[x][6], ab[x][7]); *(v4u*)(Ub + (size_t)(8 * tv + x) * 128 + 8 * td) = o; }
        __syncthreads();
    }
}
namespace ret {
using att::bf16x8; using att::s16x4; using att::f32x16; using att::u32x4;
template <int OFF> __device__ __forceinline__ void vfrag_issue(int vb, s16x4& l, s16x4& h) { l = att::tr_read<OFF>(vb); h = att::tr_read<OFF + 2048>(vb); }
__device__ __forceinline__ bf16x8 vfrag_pack(const s16x4& l, const s16x4& h) { return (bf16x8){l[0], l[1], l[2], l[3], h[0], h[1], h[2], h[3]}; }
#define RET_PK4(P, BASE, OUT) do { unsigned a0 = att::cvtpk(P[BASE + 0], P[BASE + 1]), a1 = att::cvtpk(P[BASE + 2], P[BASE + 3]);   \
    unsigned b0 = att::cvtpk(P[BASE + 4], P[BASE + 5]), b1 = att::cvtpk(P[BASE + 6], P[BASE + 7]);                              \
    auto r0 = __builtin_amdgcn_permlane32_swap(a0, b0, false, false); auto r1 = __builtin_amdgcn_permlane32_swap(a1, b1, false, false); \
    att::u32x4 w = {r0[0], r1[0], r0[1], r1[1]}; OUT = *reinterpret_cast<att::bf16x8*>(&w); } while (0)
__device__ __forceinline__ bf16x8 scale8(const bf16x8& q, float w) {
    const u32x4 u = *reinterpret_cast<const u32x4*>(&q); u32x4 o;
    o.x = att::cvtpk(__uint_as_float(u.x << 16) * w, __uint_as_float(u.x & 0xffff0000u) * w); o.y = att::cvtpk(__uint_as_float(u.y << 16) * w, __uint_as_float(u.y & 0xffff0000u) * w);
    o.z = att::cvtpk(__uint_as_float(u.z << 16) * w, __uint_as_float(u.z & 0xffff0000u) * w); o.w = att::cvtpk(__uint_as_float(u.w << 16) * w, __uint_as_float(u.w & 0xffff0000u) * w);
    return *reinterpret_cast<const bf16x8*>(&o);
}
template <int KH, int KS> __device__ __forceinline__ void p4_step(f32x16 (&acc)[2][4], int vbase, int vbv) {
    s16x4 bl, bh, al[4], ah[4];
    vfrag_issue<KH * 32768 + KS * 4096>(vbv, bl, bh);
#define RET_A(dir, db) vfrag_issue<(dir) * 32768 + KH * 16384 + (db) * 512 + KS * 4096>(vbase, al[db], ah[db])
    RET_A(0, 0); RET_A(0, 1); RET_A(0, 2); RET_A(0, 3);
    asm volatile("s_waitcnt lgkmcnt(0)" ::: "memory"); __builtin_amdgcn_sched_barrier(0);
    const bf16x8 B = vfrag_pack(bl, bh);
#pragma unroll
    for (int db = 0; db < 4; ++db) acc[0][db] = __builtin_amdgcn_mfma_f32_32x32x16_bf16(vfrag_pack(al[db], ah[db]), B, acc[0][db], 0, 0, 0);
    __builtin_amdgcn_sched_barrier(0);
    RET_A(1, 0); RET_A(1, 1); RET_A(1, 2); RET_A(1, 3);
#undef RET_A
    asm volatile("s_waitcnt lgkmcnt(0)" ::: "memory"); __builtin_amdgcn_sched_barrier(0);
#pragma unroll
    for (int db = 0; db < 4; ++db) acc[1][db] = __builtin_amdgcn_mfma_f32_32x32x16_bf16(vfrag_pack(al[db], ah[db]), B, acc[1][db], 0, 0, 0);
}
template <int KT, int D0> __device__ __forceinline__ void p6_pv(f32x16& od, int vbv, const bf16x8& pa0, const bf16x8& pa1, const bf16x8& pa2, const bf16x8& pa3) {
    s16x4 l0, h0, l1, h1, l2, h2, l3, h3;
    vfrag_issue<KT * 32768 + D0 * 512 + 0 * 4096>(vbv, l0, h0); vfrag_issue<KT * 32768 + D0 * 512 + 1 * 4096>(vbv, l1, h1);
    vfrag_issue<KT * 32768 + D0 * 512 + 2 * 4096>(vbv, l2, h2); vfrag_issue<KT * 32768 + D0 * 512 + 3 * 4096>(vbv, l3, h3);
    asm volatile("s_waitcnt lgkmcnt(0)" ::: "memory"); __builtin_amdgcn_sched_barrier(0);
    od = __builtin_amdgcn_mfma_f32_32x32x16_bf16(vfrag_pack(l0, h0), pa0, od, 0, 0, 0);
    od = __builtin_amdgcn_mfma_f32_32x32x16_bf16(vfrag_pack(l1, h1), pa1, od, 0, 0, 0);
    od = __builtin_amdgcn_mfma_f32_32x32x16_bf16(vfrag_pack(l2, h2), pa2, od, 0, 0, 0);
    od = __builtin_amdgcn_mfma_f32_32x32x16_bf16(vfrag_pack(l3, h3), pa3, od, 0, 0, 0);
}
}

__device__ __forceinline__ void p4_chunk_states_mfma(Frame& F, char* lds_generic) {
    unsigned char* ws = F.ws;
    const int NU = NB * 4 * 34;
    int tid0 = F.tid; asm volatile("" : "+v"(tid0));
    v4u kreg[4], vreg[8];
#define P4_LOAD(uu) do { const int cidx_ = (uu) % 34, h_ = ((uu) / 34) & 3, b_ = (uu) / (34 * 4); const size_t row0_ = (size_t)b_ * SKV + 128 * cidx_; \
        const bf16* Kg_ = (const bf16*)(ws + WS_KR) + row0_ * 512 + h_ * 128; const bf16* Vg_ = (const bf16*)(ws + WS_VR) + row0_ * 1024 + h_ * 256; \
        _Pragma("unroll") for (int it = 0; it < 4; ++it) { const int i = tid0 + 512 * it; kreg[it] = *(const v4u*)(Kg_ + (size_t)(i >> 4) * 512 + 8 * (i & 15)); } \
        _Pragma("unroll") for (int it = 0; it < 8; ++it) { const int i = tid0 + 512 * it; vreg[it] = *(const v4u*)(Vg_ + (size_t)(i >> 5) * 1024 + 8 * (i & 31)); } } while (0)
    if (F.vcu < NU) P4_LOAD(F.vcu);
    for (int u = F.vcu; u < NU; u += F.G) {
        int tid = F.tid; asm volatile("" : "+v"(tid));
        const int lane = tid & 63, wave = __builtin_amdgcn_readfirstlane(tid >> 6), r32 = lane & 31, hi = lane >> 5;
        const int cidx = u % 34, h = (u / 34) & 3, b = u / (34 * 4);
        const float lgf = log_gamma(F, 0, h), lgb = log_gamma(F, 1, h);
#pragma unroll
        for (int it = 0; it < 4; ++it) { const int i = tid + 512 * it, j = i >> 4, cc = i & 15;
            const v4u k = kreg[it];
            const float wf = __expf(lgf * (float)(127 - j)), wb = __expf(lgb * (float)j);
            const float kk[8] = {bflo(k.x), bfhi(k.x), bflo(k.y), bfhi(k.y), bflo(k.z), bfhi(k.z), bflo(k.w), bfhi(k.w)};
            v4u of, ob; of.x = pk2(kk[0] * wf, kk[1] * wf); of.y = pk2(kk[2] * wf, kk[3] * wf); of.z = pk2(kk[4] * wf, kk[5] * wf); of.w = pk2(kk[6] * wf, kk[7] * wf);
            ob.x = pk2(kk[0] * wb, kk[1] * wb); ob.y = pk2(kk[2] * wb, kk[3] * wb); ob.z = pk2(kk[4] * wb, kk[5] * wb); ob.w = pk2(kk[6] * wb, kk[7] * wb);
            const int off = (j >> 6) * 16384 + att::v_st(j & 63, 8 * cc);
            *(v4u*)(lds_generic + off) = of; *(v4u*)(lds_generic + 32768 + off) = ob; }
#pragma unroll
        for (int it = 0; it < 8; ++it) { const int i = tid + 512 * it, j = i >> 5, cc = i & 31;
            *(v4u*)(lds_generic + 65536 + ((j >> 6) * 2 + (cc >> 4)) * 16384 + att::v_st(j & 63, 8 * (cc & 15))) = vreg[it]; }
        __syncthreads();
        if (u + F.G < NU) P4_LOAD(u + F.G);
        const int vh = wave >> 2, d0v = wave & 3;
        const int vbase = (int)(uintptr_t)lds_generic + att::v_rd_base(lane), vbv = vbase + 65536 + vh * 16384 + d0v * 512;
        att::f32x16 acc[2][4];
#pragma unroll
        for (int dir = 0; dir < 2; ++dir)
#pragma unroll
            for (int db = 0; db < 4; ++db) acc[dir][db] = att::f32x16{};
        ret::p4_step<0, 0>(acc, vbase, vbv); ret::p4_step<0, 1>(acc, vbase, vbv); ret::p4_step<0, 2>(acc, vbase, vbv); ret::p4_step<0, 3>(acc, vbase, vbv);
        ret::p4_step<1, 0>(acc, vbase, vbv); ret::p4_step<1, 1>(acc, vbase, vbv); ret::p4_step<1, 2>(acc, vbase, vbv); ret::p4_step<1, 3>(acc, vbase, vbv);
        const int v = 128 * vh + 32 * d0v + r32;
        __syncthreads();
#pragma unroll
        for (int dir = 0; dir < 2; ++dir)
#pragma unroll
            for (int db = 0; db < 4; ++db)
#pragma unroll
                for (int g4 = 0; g4 < 4; ++g4) { v2u o; o.x = pk2(acc[dir][db][4 * g4] + 0.0f, acc[dir][db][4 * g4 + 1] + 0.0f); o.y = pk2(acc[dir][db][4 * g4 + 2] + 0.0f, acc[dir][db][4 * g4 + 3] + 0.0f);
                    *(v2u*)(lds_generic + (dir * 256 + v) * 272 + (32 * db + 8 * g4 + 4 * hi) * 2) = o; }
        __syncthreads();
        { bf16* Ub = (bf16*)(ws + WS_U) + (((size_t)(b * 4 + h) * 2) * 34 + cidx) * 32768;
#pragma unroll
          for (int it = 0; it < 16; ++it) { const int row = 64 * wave + 4 * it + (lane >> 4), dir = row >> 8, vv = row & 255;
              const v4u w = *(const v4u*)(lds_generic + row * 272 + (lane & 15) * 16);
              *(v4u*)(Ub + (size_t)dir * 34 * 32768 + (size_t)vv * 128 + 8 * (lane & 15)) = w; } }
        __syncthreads();
    }
#undef P4_LOAD
}

__device__ __forceinline__ void p6_ret_out_mfma(Frame& F, char* lds_generic) {
    unsigned char* ws = F.ws;
    float* XS = (float*)(lds_generic + 147456);
    for (int u = F.vcu; u < NB * 4 * 32; u += F.G) {
        int tid = F.tid; asm volatile("" : "+v"(tid));
        const int lane = tid & 63, wave = __builtin_amdgcn_readfirstlane(tid >> 6), r32 = lane & 31, hi = lane >> 5;
        const int n = u & 31, h = (u >> 5) & 3, b = u >> 7;
        const float lgf = log_gamma(F, 0, h), lgb = log_gamma(F, 1, h);
        const size_t qrow0 = (size_t)b * T + 128 * n, krow0 = (size_t)b * SKV + LC + 128 * n;
        const bf16* Qg = (const bf16*)(ws + WS_QR) + qrow0 * 512 + h * 128; const bf16* Kg = (const bf16*)(ws + WS_KR) + krow0 * 512 + h * 128;
        const bf16* Vg = (const bf16*)(ws + WS_VR) + krow0 * 1024 + h * 256;
        const int qb = wave & 3, vh = wave >> 2, iq = 32 * qb + r32;
        SUBP(F, 0);
        v4u kreg[4], vreg[8]; att::bf16x8 qr[8];
#pragma unroll
        for (int it = 0; it < 4; ++it) { const int i = tid + 512 * it, j = i >> 4, cc = i & 15; kreg[it] = __builtin_nontemporal_load((const v4u*)(Kg + (size_t)j * 512 + 8 * cc)); }
#pragma unroll
        for (int it = 0; it < 8; ++it) { const int i = tid + 512 * it, j = i >> 5, cc = i & 31; vreg[it] = __builtin_nontemporal_load((const v4u*)(Vg + (size_t)j * 1024 + 8 * cc)); }
        { const bf16* Qw = Qg + (size_t)iq * 512 + hi * 8;
#pragma unroll
          for (int d0 = 0; d0 < 8; ++d0) qr[d0] = *reinterpret_cast<const att::bf16x8*>(Qw + d0 * 16); }
        {
            const bf16* STu = (const bf16*)(ws + WS_ST) + (((size_t)(b * 4 + h) * 2) * 32 + n) * 32768;
#pragma unroll
            for (int k = 0; k < 16; ++k) { const int idx = wave + 8 * k, dir = idx >> 6, row = 4 * (idx & 63) + (lane >> 4), slot = lane & 15;
                const bf16* src = STu + (size_t)dir * 32 * 32768 + (size_t)row * 128 + 8 * (slot ^ (row & 7));
                __builtin_amdgcn_global_load_lds((const unsigned*)src, (LAS unsigned*)(F.lds + idx * 1024), 16, 0, 0); }
        }
        asm volatile("s_waitcnt vmcnt(0)" ::: "memory");
        __syncthreads();
        SUBP(F, 1);
        att::f32x16 o[4] = {};
        {
            const float wqf = __expf(lgf * (float)(iq + 1)), wqr = __expf(lgb * (float)(128 - iq) - lgf * (float)(iq + 1));
#pragma unroll
            for (int dir = 0; dir < 2; ++dir) {
#pragma unroll
                for (int ds = 0; ds < 8; ++ds) qr[ds] = ret::scale8(qr[ds], dir == 0 ? wqf : wqr);
#pragma unroll
                for (int vblk = 0; vblk < 4; ++vblk) { const int row = 128 * vh + 32 * vblk + r32;
#pragma unroll
                    for (int ds = 0; ds < 8; ++ds) { const att::bf16x8 a = *reinterpret_cast<const att::bf16x8*>(lds_generic + dir * 65536 + row * 256 + (((hi * 8 + ds) * 16) ^ ((row & 7) << 4)));
                        o[vblk] = __builtin_amdgcn_mfma_f32_32x32x16_bf16(a, qr[ds], o[vblk], 0, 0, 0); }
                    __builtin_amdgcn_sched_barrier(0); }
            }
        }
        { const bf16* Qw = Qg + (size_t)iq * 512 + hi * 8;
#pragma unroll
          for (int d0 = 0; d0 < 8; ++d0) qr[d0] = *reinterpret_cast<const att::bf16x8*>(Qw + d0 * 16); }
        __syncthreads();
        SUBP(F, 2);
#pragma unroll
        for (int it = 0; it < 4; ++it) { const int i = tid + 512 * it, j = i >> 4, cc = i & 15; *(v4u*)(lds_generic + KSWZ(j, 16 * cc)) = kreg[it]; }
#pragma unroll
        for (int it = 0; it < 8; ++it) { const int i = tid + 512 * it, j = i >> 5, cc = i & 31;
            *(v4u*)(lds_generic + 32768 + ((j >> 6) * 2 + (cc >> 4)) * 16384 + att::v_st(j & 63, 8 * (cc & 15))) = vreg[it]; }
        __syncthreads();
        SUBP(F, 3);
        att::bf16x8 pa[2][4];
#pragma unroll
        for (int kb = 0; kb < 4; ++kb) {
            att::f32x16 p = att::f32x16{};
#pragma unroll
            for (int d0 = 0; d0 < 8; ++d0) { const int cb = (d0 * 16 + hi * 8) * 2;
                const att::bf16x8 a = *reinterpret_cast<const att::bf16x8*>(lds_generic + KSWZ(32 * kb + r32, cb));
                p = __builtin_amdgcn_mfma_f32_32x32x16_bf16(a, qr[d0], p, 0, 0, 0); }
#pragma unroll
            for (int r = 0; r < 16; ++r) { const int j = 32 * kb + att::crow(r, hi); const float df = (float)(iq - j);
                const float w = df > 0.f ? __expf(lgf * df) : (df < 0.f ? __expf(-lgb * df) : 2.0f); p[r] *= w; }
            if (kb & 1) { RET_PK4(p, 0, pa[kb >> 1][2]); RET_PK4(p, 8, pa[kb >> 1][3]); } else { RET_PK4(p, 0, pa[kb >> 1][0]); RET_PK4(p, 8, pa[kb >> 1][1]); }
        }
        const int vbv = (int)(uintptr_t)lds_generic + att::v_rd_base(lane) + 32768 + vh * 16384;
        ret::p6_pv<0, 0>(o[0], vbv, pa[0][0], pa[0][1], pa[0][2], pa[0][3]); ret::p6_pv<0, 1>(o[1], vbv, pa[0][0], pa[0][1], pa[0][2], pa[0][3]);
        ret::p6_pv<0, 2>(o[2], vbv, pa[0][0], pa[0][1], pa[0][2], pa[0][3]); ret::p6_pv<0, 3>(o[3], vbv, pa[0][0], pa[0][1], pa[0][2], pa[0][3]);
        ret::p6_pv<1, 0>(o[0], vbv, pa[1][0], pa[1][1], pa[1][2], pa[1][3]); ret::p6_pv<1, 1>(o[1], vbv, pa[1][0], pa[1][1], pa[1][2], pa[1][3]);
        ret::p6_pv<1, 2>(o[2], vbv, pa[1][0], pa[1][1], pa[1][2], pa[1][3]); ret::p6_pv<1, 3>(o[3], vbv, pa[1][0], pa[1][1], pa[1][2], pa[1][3]);
        SUBP(F, 4);
        __syncthreads();
        { const bf16* GRt = (const bf16*)(ws + WS_GR) + qrow0 * 1024 + h * 256;
#pragma unroll
          for (int k = 0; k < 8; ++k) { const int pr = wave + 8 * k, row = 2 * pr + (lane >> 5);
              __builtin_amdgcn_global_load_lds((const unsigned*)(GRt + (size_t)row * 1024 + 8 * (lane & 31)), (LAS unsigned*)(F.lds + pr * 1040), 16, 0, 0); } }
        float s1 = 0.f, s2 = 0.f;
#pragma unroll
        for (int vblk = 0; vblk < 4; ++vblk)
#pragma unroll
            for (int r = 0; r < 16; ++r) { s1 += o[vblk][r]; s2 += o[vblk][r] * o[vblk][r]; }
        s1 += __shfl_xor(s1, 32); s2 += __shfl_xor(s2, 32);
        if (hi == 0) { XS[(wave * 32 + r32) * 2] = s1; XS[(wave * 32 + r32) * 2 + 1] = s2; }
        asm volatile("s_waitcnt vmcnt(0)" ::: "memory");
        __syncthreads();
        s1 += XS[((wave ^ 4) * 32 + r32) * 2]; s2 += XS[((wave ^ 4) * 32 + r32) * 2 + 1];
        const float mu = s1 * (1.0f / 256.0f); const float var = fmaxf(s2 * (1.0f / 256.0f) - mu * mu, 0.f); const float rstd = 1.0f / sqrtf(var + EPS);
        const float* gn = inp(F, I_GN) + h * 256 + 128 * vh + 4 * hi;
        const int rowoff = (iq >> 1) * 1040 + (iq & 1) * 512 + (128 * vh + 4 * hi) * 2;
#pragma unroll
        for (int vblk = 0; vblk < 4; ++vblk)
#pragma unroll
            for (int g4 = 0; g4 < 4; ++g4) { const int vo = 32 * vblk + 8 * g4;
                const f32x4 g = *(const f32x4*)(gn + vo); const v2u gr = *(const v2u*)(lds_generic + rowoff + vo * 2);
                const float y0 = (o[vblk][4 * g4] - mu) * rstd * g[0] * siluf_(bflo(gr.x)), y1 = (o[vblk][4 * g4 + 1] - mu) * rstd * g[1] * siluf_(bfhi(gr.x));
                const float y2 = (o[vblk][4 * g4 + 2] - mu) * rstd * g[2] * siluf_(bflo(gr.y)), y3 = (o[vblk][4 * g4 + 3] - mu) * rstd * g[3] * siluf_(bfhi(gr.y));
                v2u w; w.x = pk2(y0, y1); w.y = pk2(y2, y3); *(v2u*)(lds_generic + 69632 + rowoff + vo * 2) = w; }
        __syncthreads();
        { bf16* Ot = (bf16*)(ws + WS_O) + qrow0 * 2048 + 1024 + h * 256;
#pragma unroll
          for (int k = 0; k < 8; ++k) { const int pr = wave + 8 * k, row = 2 * pr + (lane >> 5);
              *(v4u*)(Ot + (size_t)row * 2048 + 8 * (lane & 31)) = *(const v4u*)(lds_generic + 69632 + pr * 1040 + lane * 16); } }
        if (PROBE_SUB >= 0) asm volatile("s_waitcnt vmcnt(0)" ::: "memory");
        __syncthreads();
        SUBP(F, 5);
    }
}

__device__ __forceinline__ void p5_scan(Frame& F) {
    unsigned char* ws = F.ws;
    for (int it = F.vcu * 512 + F.tid; it < 32 * 4096; it += F.G * 512) {
        const int e8 = it & 4095, bhd = it >> 12, dir = bhd & 1, h = (bhd >> 1) & 3;
        const float g = __expf(128.0f * log_gamma(F, dir, h));
        const bf16* U = (const bf16*)(ws + WS_U) + (size_t)bhd * 34 * 32768 + 8 * e8; bf16* ST = (bf16*)(ws + WS_ST) + (size_t)bhd * 32 * 32768 + 8 * ((e8 & ~15) | ((e8 & 1) << 3) | ((e8 & 15) >> 1));
        float s[8];
#pragma unroll
        for (int i = 0; i < 8; ++i) s[i] = 0.f;
#pragma unroll 1
        for (int half = 0; half < 2; ++half) {
            v4u ur[17];
#pragma unroll
            for (int k = 0; k < 17; ++k) { const int stp = 17 * half + k; const int cidx = dir == 0 ? stp : (stp < 2 ? 1 - stp : 35 - stp); ur[k] = __builtin_nontemporal_load((const v4u*)(U + (size_t)cidx * 32768)); }
#pragma unroll
            for (int k = 0; k < 17; ++k) { const int stp = 17 * half + k; const int cidx = dir == 0 ? stp : (stp < 2 ? 1 - stp : 35 - stp);
                if (stp >= 2) { v4u o; o.x = pk2(s[0], s[1]); o.y = pk2(s[2], s[3]); o.z = pk2(s[4], s[5]); o.w = pk2(s[6], s[7]); *(v4u*)(ST + (size_t)(cidx - 2) * 32768) = o; }
                const float uu[8] = {bflo(ur[k].x), bfhi(ur[k].x), bflo(ur[k].y), bfhi(ur[k].y), bflo(ur[k].z), bfhi(ur[k].z), bflo(ur[k].w), bfhi(ur[k].w)};
#pragma unroll
                for (int i = 0; i < 8; ++i) s[i] = g * s[i] + uu[i]; }
        }
    }
}
__device__ __forceinline__ void p5_attention(Frame& F, char* lds_generic) {
    unsigned char* ws = F.ws;
    for (int u = F.vcu; u < NB * 8 * 16; u += F.G) {
        const int qb = u & 15, hq = (u >> 4) & 7, b = u >> 7, kvh = hq >> 2;
        const bf16* Q = (const bf16*)(ws + WS_QA) + ((size_t)b * T + qb * 256) * 1024 + hq * 128;
        const bf16* K = (const bf16*)(ws + WS_KA) + (size_t)b * SKV * 256 + kvh * 128; const bf16* V = (const bf16*)(ws + WS_VA) + (size_t)b * SKV * 256 + kvh * 128;
        bf16* O = (bf16*)(ws + WS_O) + ((size_t)b * T + qb * 256) * 2048 + hq * 128;
        att::attn_dense_body(Q, K, V, O, SKV, lds_generic, F.tid);
    }
}
__device__ __forceinline__ void p6_ret_out(Frame& F) {
    unsigned char* ws = F.ws;
    LAS bf16* QT = (LAS bf16*)F.lds;
    LAS float* PT = (LAS float*)(F.lds + 32768);
    LAS bf16* KT = (LAS bf16*)(F.lds + 98304);
    LAS float* RS = (LAS float*)(F.lds + 98304);
    for (int u = F.vcu; u < NB * 4 * 32; u += F.G) {
        int tid = F.tid; asm volatile("" : "+v"(tid));
        const int n = u & 31, h = (u >> 5) & 3, b = u >> 7;
        const float lgf = log_gamma(F, 0, h), lgb = log_gamma(F, 1, h);
        const size_t qrow0 = (size_t)b * T + 128 * n, krow0 = (size_t)b * SKV + LC + 128 * n;
        const bf16* Qg = (const bf16*)(ws + WS_QR) + qrow0 * 512 + h * 128; const bf16* Kg = (const bf16*)(ws + WS_KR) + krow0 * 512 + h * 128;
        const bf16* Vg = (const bf16*)(ws + WS_VR) + krow0 * 1024 + h * 256;
        for (int i = tid; i < 128 * 16; i += 512) { const int r = i & 127, cc = i >> 7;
            const v4u q = *(const v4u*)(Qg + (size_t)r * 512 + 8 * cc), k = *(const v4u*)(Kg + (size_t)r * 512 + 8 * cc);
            const unsigned qq[4] = {q.x, q.y, q.z, q.w}, kk[4] = {k.x, k.y, k.z, k.w};
#pragma unroll
            for (int x = 0; x < 4; ++x) { QT[(8 * cc + 2 * x) * 128 + r] = (bf16)(qq[x] & 0xffffu); QT[(8 * cc + 2 * x + 1) * 128 + r] = (bf16)(qq[x] >> 16);
                KT[(8 * cc + 2 * x) * 128 + r] = (bf16)(kk[x] & 0xffffu); KT[(8 * cc + 2 * x + 1) * 128 + r] = (bf16)(kk[x] >> 16); } }
        __syncthreads();
        {
            const int ti = tid & 31, tj = tid >> 5;
            float s[4][8];
#pragma unroll
            for (int x = 0; x < 4; ++x)
#pragma unroll
                for (int y = 0; y < 8; ++y) s[x][y] = 0.f;
            for (int d = 0; d < 128; ++d) {
                const v2u qr = *(const LAS v2u*)(QT + d * 128 + 4 * ti); const v4u kr = *(const LAS v4u*)(KT + d * 128 + 8 * tj);
                const float qv[4] = {bflo(qr.x), bfhi(qr.x), bflo(qr.y), bfhi(qr.y)};
                const float kv[8] = {bflo(kr.x), bfhi(kr.x), bflo(kr.y), bfhi(kr.y), bflo(kr.z), bfhi(kr.z), bflo(kr.w), bfhi(kr.w)};
#pragma unroll
                for (int x = 0; x < 4; ++x)
#pragma unroll
                    for (int y = 0; y < 8; ++y) s[x][y] += qv[x] * kv[y];
                __builtin_amdgcn_sched_barrier(0);
            }
#pragma unroll
            for (int y = 0; y < 8; ++y) { const int j = 8 * tj + y; f32x4 o;
#pragma unroll
                for (int x = 0; x < 4; ++x) { const int i = 4 * ti + x; const float w = i > j ? __expf(lgf * (float)(i - j)) : (i < j ? __expf(lgb * (float)(j - i)) : 2.0f); o[x] = s[x][y] * w; }
                *(LAS f32x4*)(PT + j * 128 + 4 * ti) = o; }
        }
        __syncthreads();
        {
            const int i2 = (tid & 63) * 2;
            const float f0 = __expf(lgf * (float)(i2 + 1)), f1 = __expf(lgf * (float)(i2 + 2)), b0 = __expf(lgb * (float)(128 - i2)), b1 = __expf(lgb * (float)(127 - i2));
            for (int d = tid >> 6; d < 128; d += 8) { const unsigned w = *(const LAS unsigned*)(QT + d * 128 + i2); const float q0 = bflo(w), q1 = bfhi(w);
                *(LAS unsigned*)(QT + d * 128 + i2) = pk2(q0 * f0, q1 * f1); *(LAS unsigned*)(KT + d * 128 + i2) = pk2(q0 * b0, q1 * b1); }
        }
        __syncthreads();
        const int ib = tid & 15, vb = tid >> 4;
        float o[8][8];
#pragma unroll
        for (int x = 0; x < 8; ++x)
#pragma unroll
            for (int y = 0; y < 8; ++y) o[x][y] = 0.f;
#pragma unroll 2
        for (int j = 0; j < 128; ++j) {
            const f32x4 p0 = *(const LAS f32x4*)(PT + j * 128 + 8 * ib), p1 = *(const LAS f32x4*)(PT + j * 128 + 8 * ib + 4);
            const v4u vr = *(const v4u*)(Vg + (size_t)j * 1024 + 8 * vb);
            const float pv[8] = {p0[0], p0[1], p0[2], p0[3], p1[0], p1[1], p1[2], p1[3]};
            const float vv[8] = {bflo(vr.x), bfhi(vr.x), bflo(vr.y), bfhi(vr.y), bflo(vr.z), bfhi(vr.z), bflo(vr.w), bfhi(vr.w)};
#pragma unroll
            for (int x = 0; x < 8; ++x)
#pragma unroll
                for (int y = 0; y < 8; ++y) o[x][y] += pv[x] * vv[y];
        }
        LAS bf16* STt = (LAS bf16*)(F.lds + 32768);
#pragma unroll 1
        for (int dir = 0; dir < 2; ++dir) {
            __syncthreads();
            const bf16* STg = (const bf16*)(ws + WS_ST) + ((((size_t)(b * 4 + h) * 2 + dir) * 32 + n) * 256) * 128;
            for (int i = tid; i < 256 * 16; i += 512) { const int v = i >> 4, cc = i & 15; const v4u w = *(const v4u*)(STg + (size_t)v * 128 + 8 * (((cc & 1) << 3) | (cc >> 1)));
                const unsigned ww[4] = {w.x, w.y, w.z, w.w};
#pragma unroll
                for (int x = 0; x < 4; ++x) { STt[(8 * cc + 2 * x) * 256 + v] = (bf16)(ww[x] & 0xffffu); STt[(8 * cc + 2 * x + 1) * 256 + v] = (bf16)(ww[x] >> 16); } }
            __syncthreads();
            const LAS bf16* QS = dir == 0 ? QT : KT;
#pragma unroll 2
            for (int d = 0; d < 128; ++d) {
                const v4u qr = *(const LAS v4u*)(QS + d * 128 + 8 * ib), sr = *(const LAS v4u*)(STt + d * 256 + 8 * vb);
                const float qv[8] = {bflo(qr.x), bfhi(qr.x), bflo(qr.y), bfhi(qr.y), bflo(qr.z), bfhi(qr.z), bflo(qr.w), bfhi(qr.w)};
                const float sv[8] = {bflo(sr.x), bfhi(sr.x), bflo(sr.y), bfhi(sr.y), bflo(sr.z), bfhi(sr.z), bflo(sr.w), bfhi(sr.w)};
#pragma unroll
                for (int x = 0; x < 8; ++x)
#pragma unroll
                    for (int y = 0; y < 8; ++y) o[x][y] += qv[x] * sv[y];
            }
        }
        __syncthreads();
#pragma unroll
        for (int x = 0; x < 8; ++x) { float s1 = 0.f, s2 = 0.f;
#pragma unroll
            for (int y = 0; y < 8; ++y) { s1 += o[x][y]; s2 += o[x][y] * o[x][y]; }
            RS[((8 * ib + x) * 32 + vb) * 2] = s1; RS[((8 * ib + x) * 32 + vb) * 2 + 1] = s2; }
        __syncthreads();
        const float* gn = inp(F, I_GN) + h * 256 + 8 * vb;
        float gnv[8];
#pragma unroll
        for (int y = 0; y < 8; ++y) gnv[y] = gn[y];
#pragma unroll
        for (int x = 0; x < 8; ++x) { const int i = 8 * ib + x; float s1 = 0.f, s2 = 0.f;
            for (int q = 0; q < 32; ++q) { s1 += RS[(i * 32 + q) * 2]; s2 += RS[(i * 32 + q) * 2 + 1]; }
            const float mu = s1 * (1.0f / 256.0f); const float var = fmaxf(s2 * (1.0f / 256.0f) - mu * mu, 0.f); const float rstd = 1.0f / sqrtf(var + EPS);
            const v4u gr = *(const v4u*)((const bf16*)(ws + WS_GR) + (qrow0 + i) * 1024 + h * 256 + 8 * vb);
            const float gg[8] = {bflo(gr.x), bfhi(gr.x), bflo(gr.y), bfhi(gr.y), bflo(gr.z), bfhi(gr.z), bflo(gr.w), bfhi(gr.w)};
            float y8[8];
#pragma unroll
            for (int y = 0; y < 8; ++y) y8[y] = (o[x][y] - mu) * rstd * gnv[y] * siluf_(gg[y]);
            v4u w; w.x = pk2(y8[0], y8[1]); w.y = pk2(y8[2], y8[3]); w.z = pk2(y8[4], y8[5]); w.w = pk2(y8[6], y8[7]);
            *(v4u*)((bf16*)(ws + WS_O) + (qrow0 + i) * 2048 + 1024 + h * 256 + 8 * vb) = w;
            __builtin_amdgcn_sched_barrier(0); }
        __syncthreads();
    }
}

__device__ __forceinline__ float reduce16(float (&v)[16], int lane) {
#define R16_STEP(o, n) do { const bool up = (lane & (o)) != 0; _Pragma("unroll") for (int i = 0; i < (n) / 2; ++i) { const float mine = up ? v[i + (n) / 2] : v[i], other = up ? v[i] : v[i + (n) / 2]; v[i] = mine + __shfl_xor(other, (o)); } } while (0)
    R16_STEP(32, 16); R16_STEP(16, 8); R16_STEP(8, 4); R16_STEP(4, 2);
#undef R16_STEP
    float r = v[0]; r += __shfl_xor(r, 2); r += __shfl_xor(r, 1); return r;
}
__device__ __forceinline__ void p10_norm_router(Frame& F) {
    unsigned char* ws = F.ws;
    LAS float* WRT = (LAS float*)F.lds;
    LAS float* C1 = (LAS float*)(F.lds + 131072); LAS float* A2 = C1 + 2048; LAS float* B2 = C1 + 4096;
    const int b = F.vcu & 3, sub = F.vcu >> 2, nsub = F.G >> 2;
    const float* MOD = (const float*)(ws + WS_MOD) + (size_t)b * 12288;
    { const f32x4* wg = (const f32x4*)(ws + WS_WRT); f32x4 wv[16];
#pragma unroll
      for (int q = 0; q < 16; ++q) wv[q] = wg[F.tid + 512 * q];
#pragma unroll
      for (int q = 0; q < 16; ++q) *(LAS f32x4*)(WRT + 4 * (F.tid + 512 * q)) = wv[q]; }
#pragma unroll
    for (int k = F.tid; k < 2048; k += 512) { C1[k] = MOD[4096 + k] * inp(F, I_POST1)[k]; A2[k] = inp(F, I_PRE2)[k] * (1.0f + MOD[8192 + k]); B2[k] = MOD[6144 + k]; }
    __syncthreads();
    const bf16* YO = (const bf16*)(ws + WS_YO); bf16* H2 = (bf16*)(ws + WS_H); float* AFF = (float*)(ws + WS_AFF);
    const int lane = F.lane; const float* X = inp(F, I_X);
    const int eown = ((lane >> 5) & 1) * 8 + ((lane >> 4) & 1) * 4 + ((lane >> 3) & 1) * 2 + ((lane >> 2) & 1);
    const int tstep = 2 * nsub * NWAVES;
    f32x4 nxa[8], nxb[8];
#define P10_LOAD(tt) do { const int ta_ = (tt), tb_ = ((tt) + nsub * NWAVES < T) ? (tt) + nsub * NWAVES : (tt); const size_t ma_ = (size_t)b * T + ta_, mb_ = (size_t)b * T + tb_; \
        const f32x4* xr0 = (const f32x4*)(X + ma_ * DM) + lane; const f32x4* xr1 = (const f32x4*)(X + mb_ * DM) + lane; \
        _Pragma("unroll") for (int j = 0; j < 8; ++j) { nxa[j] = __builtin_nontemporal_load(xr0 + 64 * j); nxb[j] = __builtin_nontemporal_load(xr1 + 64 * j); } } while (0)
    if (sub * NWAVES + F.wave < T) P10_LOAD(sub * NWAVES + F.wave);
    for (int t0 = sub * NWAVES + F.wave; t0 < T; t0 += tstep) {
        int lane = F.lane; asm volatile("" : "+v"(lane));
        const int t1r = t0 + nsub * NWAVES; const bool has1 = t1r < T; const int t1 = has1 ? t1r : t0;
        const size_t m0 = (size_t)b * T + t0, m1 = (size_t)b * T + t1;
        f32x4 xa[8], xb[8]; float sa = 0.f, sb = 0.f;
        {   v2u ya[8], yb[8];
            const v2u* yr0 = (const v2u*)(YO + m0 * DM) + lane; const v2u* yr1 = (const v2u*)(YO + m1 * DM) + lane;
#pragma unroll
            for (int j = 0; j < 8; ++j) { ya[j] = __builtin_nontemporal_load(yr0 + 64 * j); yb[j] = __builtin_nontemporal_load(yr1 + 64 * j); }
#pragma unroll
            for (int j = 0; j < 8; ++j) { xa[j] = nxa[j]; xb[j] = nxb[j]; }
            if (t0 + tstep < T) { P10_LOAD(t0 + tstep); asm volatile("" ::: "memory"); }
#pragma unroll
            for (int j = 0; j < 8; ++j) { const float a0 = bflo(ya[j].x), a1 = bfhi(ya[j].x), a2 = bflo(ya[j].y), a3 = bfhi(ya[j].y), b0 = bflo(yb[j].x), b1 = bfhi(yb[j].x), b2 = bflo(yb[j].y), b3 = bfhi(yb[j].y);
                sa += (a0 * a0 + a1 * a1) + (a2 * a2 + a3 * a3); sb += (b0 * b0 + b1 * b1) + (b2 * b2 + b3 * b3); }
            const float ra = 1.0f / sqrtf(wave_sum(sa) * (1.0f / DM) + EPS), rb = 1.0f / sqrtf(wave_sum(sb) * (1.0f / DM) + EPS);
            v2u* o0 = (v2u*)((bf16*)(ws + WS_YO) + m0 * DM) + lane; v2u* o1 = (v2u*)((bf16*)(ws + WS_YO) + m1 * DM) + lane; sa = 0.f; sb = 0.f;
#pragma unroll
            for (int j = 0; j < 8; ++j) { const f32x4 c1 = *(const LAS f32x4*)(C1 + 4 * (64 * j + lane));
                const f32x4 fa = {bflo(ya[j].x), bfhi(ya[j].x), bflo(ya[j].y), bfhi(ya[j].y)}, fb = {bflo(yb[j].x), bfhi(yb[j].x), bflo(yb[j].y), bfhi(yb[j].y)};
                xa[j] = xa[j] + c1 * (fa * ra); xb[j] = xb[j] + c1 * (fb * rb);
                { v2u w; w.x = pk2(xa[j].x, xa[j].y); w.y = pk2(xa[j].z, xa[j].w); o0[64 * j] = w; w.x = pk2(xb[j].x, xb[j].y); w.y = pk2(xb[j].z, xb[j].w); if (has1) o1[64 * j] = w; }
                sa += (xa[j].x * xa[j].x + xa[j].y * xa[j].y) + (xa[j].z * xa[j].z + xa[j].w * xa[j].w); sb += (xb[j].x * xb[j].x + xb[j].y * xb[j].y) + (xb[j].z * xb[j].z + xb[j].w * xb[j].w); }
        }
        const float r2a = 1.0f / sqrtf(wave_sum(sa) * (1.0f / DM) + EPS), r2b = 1.0f / sqrtf(wave_sum(sb) * (1.0f / DM) + EPS);
        unsigned* h0 = (unsigned*)((unsigned char*)H2 + m0 * DM) + lane; unsigned* h1 = (unsigned*)((unsigned char*)H2 + m1 * DM) + lane;
#pragma unroll
        for (int j = 0; j < 8; ++j) { const f32x4 a2 = *(const LAS f32x4*)(A2 + 4 * (64 * j + lane)), b2 = *(const LAS f32x4*)(B2 + 4 * (64 * j + lane)); xa[j] = xa[j] * r2a * a2 + b2; xb[j] = xb[j] * r2b * a2 + b2;
            __builtin_nontemporal_store(pg8::pk4_fp8(xa[j].x * 4.f, xa[j].y * 4.f, xa[j].z * 4.f, xa[j].w * 4.f), h0 + 64 * j); if (has1) __builtin_nontemporal_store(pg8::pk4_fp8(xb[j].x * 4.f, xb[j].y * 4.f, xb[j].z * 4.f, xb[j].w * 4.f), h1 + 64 * j); }
        float la[16], lb[16];
        const LAS float* W0 = WRT + 4 * lane; const LAS float* W1; { unsigned wo = (unsigned)(uintptr_t)(WRT + 16384 + 4 * lane); asm volatile("" : "+v"(wo)); W1 = (const LAS float*)(uintptr_t)wo; }
#pragma unroll
        for (int e = 0; e < 16; ++e) { typedef float f32x2_ __attribute__((ext_vector_type(2))); f32x2_ a2 = {0.f, 0.f}, c2 = {0.f, 0.f};
#pragma unroll
            for (int j = 0; j < 8; ++j) { const f32x4 w = *(const LAS f32x4*)((e < 8 ? W0 : W1) + (e & 7) * 2048 + 256 * j);
                const f32x2_ wl = {w.x, w.y}, wh = {w.z, w.w};
                a2 += (f32x2_){xa[j].x, xa[j].y} * wl; a2 += (f32x2_){xa[j].z, xa[j].w} * wh; c2 += (f32x2_){xb[j].x, xb[j].y} * wl; c2 += (f32x2_){xb[j].z, xb[j].w} * wh; }
            la[e] = a2.x + a2.y; lb[e] = c2.x + c2.y; __builtin_amdgcn_sched_barrier(0); }
        const float ga = reduce16(la, lane), gb = reduce16(lb, lane);
        float ma = ga, mb = gb;
#pragma unroll
        for (int o = 4; o < 64; o <<= 1) { ma = fmaxf(ma, __shfl_xor(ma, o)); mb = fmaxf(mb, __shfl_xor(mb, o)); }
        const float pa = expf(ga - ma), pb = expf(gb - mb); float da = pa, db = pb;
#pragma unroll
        for (int o = 4; o < 64; o <<= 1) { da += __shfl_xor(da, o); db += __shfl_xor(db, o); }
        if ((lane & 3) == 0) { AFF[((size_t)b * 16 + eown) * T + t0] = pa / da; if (has1) AFF[((size_t)b * 16 + eown) * T + t1] = pb / db; }
    }
}

__device__ __forceinline__ void p11_topk(Frame& F) {
    unsigned char* ws = F.ws;
    LAS unsigned* hist = (LAS unsigned*)F.lds;
    LAS unsigned* bc = hist + 256;
    LAS unsigned* wtot = hist + 272;
    const int tid = F.tid, lane = F.lane, wave = F.wave;
    for (int u = F.vcu; u < NB * NE; u += F.G) {
        const int b = u >> 4, e = u & 15;
        const float* aff = (const float*)(ws + WS_AFF) + ((size_t)b * 16 + e) * T;
        const f32x4 v0 = *(const f32x4*)(aff + 8 * tid), v1 = *(const f32x4*)(aff + 8 * tid + 4);
        const float val[8] = {v0[0], v0[1], v0[2], v0[3], v1[0], v1[1], v1[2], v1[3]};
        unsigned key[8];
#pragma unroll
        for (int i = 0; i < 8; ++i) key[i] = __float_as_uint(val[i]);
        unsigned prefix = 0u, kth = CAP;
#pragma unroll 1
        for (int pass = 0; pass < 4; ++pass) {
            const int shift = 24 - 8 * pass;
            if (tid < 256) hist[tid] = 0u;
            __syncthreads();
#pragma unroll
            for (int i = 0; i < 8; ++i) { const bool in = pass == 0 ? true : ((key[i] >> (shift + 8)) == prefix); if (in) atomicAdd((unsigned*)&hist[(key[i] >> shift) & 255u], 1u); }
            __syncthreads();
            if (wave == 0) {
                const unsigned h0 = hist[4 * lane], h1 = hist[4 * lane + 1], h2 = hist[4 * lane + 2], h3 = hist[4 * lane + 3]; const unsigned sl = h0 + h1 + h2 + h3;
                unsigned suf = sl;
#pragma unroll
                for (int o = 1; o < 64; o <<= 1) { const unsigned a = __shfl_down(suf, o); if (lane + o < 64) suf += a; }
                unsigned cum = suf - sl;
                if (cum < kth && kth <= suf) { int bin; unsigned c2 = cum;
                    if (c2 + h3 >= kth) bin = 4 * lane + 3; else { c2 += h3; if (c2 + h2 >= kth) bin = 4 * lane + 2; else { c2 += h2; if (c2 + h1 >= kth) bin = 4 * lane + 1; else { c2 += h1; bin = 4 * lane; } } }
                    bc[0] = (prefix << 8) | (unsigned)bin; bc[1] = kth - c2; }
            }
            __syncthreads();
            prefix = bc[0]; kth = bc[1];
            __syncthreads();
        }
        const unsigned thr = prefix, need = kth;
        unsigned ng = 0u, neq = 0u;
#pragma unroll
        for (int i = 0; i < 8; ++i) { ng += key[i] > thr ? 1u : 0u; neq += key[i] == thr ? 1u : 0u; }
        unsigned sg = ng, se = neq;
#pragma unroll
        for (int o = 1; o < 64; o <<= 1) { const unsigned a = __shfl_up(sg, o), c = __shfl_up(se, o); if (lane >= o) { sg += a; se += c; } }
        if (lane == 63) { wtot[wave * 2] = sg; wtot[wave * 2 + 1] = se; }
        __syncthreads();
        unsigned bg = sg - ng, be = se - neq;
        for (int w = 0; w < wave; ++w) { bg += wtot[w * 2]; be += wtot[w * 2 + 1]; }
        int* rowidx = (int*)(ws + WS_ROWIDX) + e * 2048 + b * CAP; float* topw = (float*)(ws + WS_TOPW) + e * 2048 + b * CAP; int* inv = (int*)(ws + WS_INV);
#pragma unroll
        for (int i = 0; i < 8; ++i) {
            const int t = 8 * tid + i; const bool gt = key[i] > thr, eq = key[i] == thr; const bool sel = gt || (eq && be < need);
            const unsigned slot = bg + (be < need ? be : need);
            if (sel) { rowidx[slot] = b * T + t; topw[slot] = val[i]; }
            inv[((size_t)b * T + t) * 16 + e] = sel ? (int)(e * 2048 + b * CAP + slot) : -1;
            bg += gt ? 1u : 0u; be += eq ? 1u : 0u;
        }
        __syncthreads();
        __syncthreads();
    }
}

__device__ __forceinline__ void p14_final(Frame& F) {
    unsigned char* ws = F.ws;
    LAS float* C2 = (LAS float*)F.lds;
    const int b = F.vcu & 3, sub = F.vcu >> 2, nsub = F.G >> 2;
    const float* MOD = (const float*)(ws + WS_MOD) + (size_t)b * 12288;
#pragma unroll
    for (int k = F.tid; k < 2048; k += 512) C2[k] = MOD[10240 + k] * inp(F, I_POST2)[k];
    __syncthreads();
    const bf16* YEXP = (const bf16*)(ws + WS_YEXP); const int* inv = (const int*)(ws + WS_INV); const int lane = F.lane;
    const bf16* zrow = (const bf16*)(ws + WS_ZROW);
    const int tstep = nsub * NWAVES; int t = sub * NWAVES + F.wave;
    int slotv = (t < T && lane < 16) ? inv[((size_t)b * T + t) * 16 + lane] : -1;
    for (; t < T; t += tstep) {
        const size_t m = (size_t)b * T + t;
        const int tn = t + tstep; const int nslot = (tn < T && lane < 16) ? inv[((size_t)b * T + tn) * 16 + lane] : -1;
        f32x4* orow = (f32x4*)(F.out + m * DM) + lane; v2u xr[8]; { const v2u* x1r = (const v2u*)((const bf16*)(ws + WS_YO) + m * DM) + lane;
#pragma unroll
        for (int j = 0; j < 8; ++j) xr[j] = x1r[64 * j]; }
        unsigned mask = (unsigned)__ballot(slotv >= 0) & 0xffffu;
        f32x4 acc[8];
#pragma unroll
        for (int j = 0; j < 8; ++j) acc[j] = (f32x4){0.f, 0.f, 0.f, 0.f};
        while (mask != 0u) {
            const unsigned char* rp[4];
#pragma unroll
            for (int q = 0; q < 4; ++q) { if (mask != 0u) { const int e = __builtin_ctz(mask); mask &= mask - 1u; rp[q] = (const unsigned char*)YEXP + (size_t)__builtin_amdgcn_readlane(slotv, e) * DM; } else rp[q] = (const unsigned char*)zrow; }
            unsigned w[4][8];
#pragma unroll
            for (int q = 0; q < 4; ++q)
#pragma unroll
                for (int j = 0; j < 8; ++j) w[q][j] = ((const unsigned*)rp[q] + lane)[64 * j];
#pragma unroll
            for (int q = 0; q < 4; ++q)
#pragma unroll
                for (int j = 0; j < 8; ++j) { float f[4]; pg8::up4_fp8(w[q][j], f); acc[j] += (f32x4){f[0], f[1], f[2], f[3]}; }
        }
        float s = 0.f;
#pragma unroll
        for (int j = 0; j < 8; ++j) s += (acc[j].x * acc[j].x + acc[j].y * acc[j].y) + (acc[j].z * acc[j].z + acc[j].w * acc[j].w);
        const float r = 1.0f / sqrtf(wave_sum(s) * (1.0f / DM) + EPS * 16384.f);
#pragma unroll
        for (int j = 0; j < 8; ++j) { const f32x4 c2 = *(const LAS f32x4*)(C2 + 4 * (64 * j + lane)); const f32x4 x1 = {bflo(xr[j].x), bfhi(xr[j].x), bflo(xr[j].y), bfhi(xr[j].y)}; orow[64 * j] = x1 + c2 * (acc[j] * r); }
        slotv = nslot;
    }
}

struct Args { const float* in[22]; float* out; unsigned char* ws; int ph_lo, ph_hi; };
__global__ void __launch_bounds__(NWAVES * 64, 2) fwd(Args args) {
    extern __shared__ __attribute__((aligned(16))) unsigned char lds[];
    Frame F;
    F.lds = (LAS unsigned char*)lds;
    F.MISC = (volatile LAS unsigned*)(F.lds + MISC_OFF);
    F.tid = threadIdx.x; F.lane = F.tid & 63; F.wave = __builtin_amdgcn_readfirstlane(F.tid >> 6);
    F.G = gridDim.x; { const int bx = blockIdx.x; F.vcu = (F.G % 8 == 0) ? (bx % 8) * (F.G / 8) + bx / 8 : bx; }
    unsigned char* ws = args.ws; F.ws = ws; F.out = args.out;
    F.ctl = (gu32*)(ws + WS_CTL);
    for (int u = F.tid; u < (LDS_BYTES - LDSCTL_OFF) / 4; u += NWAVES * 64) ((LAS unsigned*)(F.lds + LDSCTL_OFF))[u] = 0u;
    __syncthreads();
    if (F.tid < 22) ((LAS unsigned long long*)(F.lds + LDSCTL_OFF))[F.tid] = (unsigned long long)(uintptr_t)args.in[F.tid];
    __syncthreads();
    XcdBarrier bar; bar.bar = (unsigned*)(F.ctl + CW_BAR); bar.x = 0; bar.st = nullptr;
    if (N_LAUNCHES != N_PHASES) bar = xcd_barrier_post((unsigned*)(F.ctl + CW_BAR), F.MISC + 8);
#define GRID_BAR(seam) do { if (N_LAUNCHES == N_PHASES) { if (F.tid == 0) __hip_atomic_store(F.ctl + CW_TMO, 0xBADBA0u | (unsigned)(seam), RLX_AGENT); } else { xcd_barrier(bar); } } while (0)
    const int lo = args.ph_lo, hi = args.ph_hi;
#ifndef PH_MASK
#define PH_MASK 0x7fff
#endif
#define IN(k) (((PH_MASK >> (k)) & 1) && lo <= (k) && (k) < hi)
#define BOTH(k) (IN(k) && IN((k) + 1))
#ifndef P7_PAIR
#define P7_PAIR 0
#endif
#ifndef PROBE_MASK
#define PROBE_MASK 0
#endif
#ifndef PROBE_AMP
#define PROBE_AMP 4
#endif
#define PB_BEGIN(k) do { if (PROBE_MASK & (1 << (k))) { if (F.tid == 0) { const unsigned long long t = __builtin_amdgcn_s_memrealtime(); F.MISC[16] = (unsigned)t; F.MISC[17] = (unsigned)(t >> 32); } } } while (0)
#define PB_END(k) do { if (PROBE_MASK & (1 << (k))) { if (F.tid == 0) { const unsigned long long t0 = ((unsigned long long)F.MISC[17] << 32) | F.MISC[16]; const unsigned long long d = __builtin_amdgcn_s_memrealtime() - t0; \
        const unsigned long long a = (((unsigned long long)F.MISC[19] << 32) | F.MISC[18]) + d; F.MISC[18] = (unsigned)a; F.MISC[19] = (unsigned)(a >> 32); } } } while (0)
#define FRESH() do { asm volatile("" : "+v"(F.tid)); F.lane = F.tid & 63; F.wave = __builtin_amdgcn_readfirstlane(F.tid >> 6); asm volatile("" : "+s"(F.vcu), "+s"(F.G)); } while (0)

    if (IN(0)) { FRESH(); PB_BEGIN(0); p0_prologue(F); if (BOTH(0)) GRID_BAR(0); PB_END(0); }
    if (IN(1)) { FRESH(); PB_BEGIN(1); p1_h(F); if (BOTH(1)) GRID_BAR(1); PB_END(1); }
    if (IN(2)) { FRESH(); PB_BEGIN(2);
        const bool copier = (F.vcu & 31) < CONV_PER_XCD;
        if (copier) { const int ci = (F.vcu >> 5) * CONV_PER_XCD + (F.vcu & 31), nci = (F.G / 32) * CONV_PER_XCD; mod_gemv_units(F, ci, 128, nci, true); __syncthreads(); copy_queue_drain(F); }
        pg8::EpiZ E{(bf16*)(ws + WS_QA), (bf16*)(ws + WS_QR), (bf16*)(ws + WS_GR), (bf16*)(ws + WS_GATE), (bf16*)(ws + WS_KA), (bf16*)(ws + WS_VA), (bf16*)(ws + WS_KR), (bf16*)(ws + WS_VR),
                     inp(F, I_QN), inp(F, I_KN), (const float*)(ws + WS_ROPE), (LAS float*)(F.lds + pg8::STAGE_BYTES + 2048), 0};
        {
            pg8::Gemm g{(const bf16*)(ws + WS_H), (const bf16*)(ws + WS_WIN), 2048, 2048, 2048, nullptr, 0x7f7f7f7f, 0x7f7f7f7f}; pg8::InProjDynOrder S; S.init((int)blockIdx.x, (unsigned*)(F.ctl + CW_QUEUE), 0);
            pg8::gemm_phase<pg8::EpiZ, pg8::InProjDynOrder, true>(F.lds + RING_OFF, g, S, E, F.tid); }
        FRESH();
        {
            pg8::Gemm g{(const bf16*)(ws + WS_H8), (const bf16*)(ws + WS_WIN8), 2048, 2048, 2048, nullptr, 0x7d7d7d7d, 0x79797979}; pg8::InProjDynOrder S; S.init((int)blockIdx.x, (unsigned*)(F.ctl + CW_QUEUE + 64 * 16), 1);
            pg8::EpiGate8 Eg{ws + WS_GATE};
            pg8::gemm_phase<pg8::EpiGate8, pg8::InProjDynOrder, true, false, true>(F.lds + RING_OFF, g, S, Eg, F.tid); }
        if (!copier) copy_queue_drain(F);
        if (BOTH(2)) GRID_BAR(2); PB_END(2);
    }
    if (IN(3) && FUSE_ROPE == 0) { FRESH(); PB_BEGIN(3); p3_rope(F); if (BOTH(3)) GRID_BAR(3); PB_END(3); }
    if (IN(4)) { FRESH(); PB_BEGIN(4);
        { float* MOD = (float*)(F.ws + WS_MOD); for (int i = F.vcu * 512 + F.tid; i < 5 * 12288; i += F.G * 512) if (i % 12288 >= 4096) MOD[i] = mod_val(F, i / 12288, i % 12288); }
        if (RET_VALU & 1) p4_chunk_states(F); else p4_chunk_states_mfma(F, (char*)lds); if (BOTH(4)) GRID_BAR(4); PB_END(4); }
    if (IN(5)) { FRESH(); PB_BEGIN(5); SUBP(F, 50); p5_scan(F); if (PROBE_SUB >= 0) { VM_WAIT(); __syncthreads(); } SUBP(F, 51); p5_attention(F, (char*)lds); if (BOTH(5)) GRID_BAR(5); PB_END(5); }
    if (IN(6)) { FRESH(); PB_BEGIN(6); if (RET_VALU & 2) p6_ret_out(F); else p6_ret_out_mfma(F, (char*)lds); if (BOTH(6)) GRID_BAR(6); PB_END(6); }
    if (IN(7)) { FRESH(); PB_BEGIN(7);
#if P7_PAIR
        pg8::Gemm g{(const bf16*)(ws + WS_O), (const bf16*)(ws + WS_WOA), 2048, 2048, 1024, nullptr, 0x7f7f7f7f, 0x7f7f7f7f}; pg8::PairOrder S; S.init(M, DM, 1024, F.G, (int)blockIdx.x);
#else
        pg8::Gemm g{(const bf16*)(ws + WS_O), (const bf16*)(ws + WS_WOA), 2048, 2048, 2048, nullptr, 0x7f7f7f7f, 0x7f7f7f7f}; pg8::StaticOrder S; S.init(M, DM, F.G, (int)blockIdx.x);
#endif
        LAS float* lut = (LAS float*)(F.lds + pg8::STAGE_BYTES + 2048);
        if (F.tid < 256) { float d[4]; pg8::up4_fp8((unsigned)F.tid, d); const float e = __expf(-0.0625f * d[0]); lut[F.tid] = 1.0f / (1.0f + e); lut[256 + F.tid] = 1.0f + e; }
        __syncthreads();
#if P7_PAIR
        pg8::EpiGatePair E{(bf16*)(ws + WS_Y), (const unsigned char*)(ws + WS_GATE), lut};
        pg8::gemm_phase<pg8::EpiGatePair, pg8::PairOrder, true>(F.lds + RING_OFF, g, S, E, F.tid);
#else
        pg8::EpiGateMerge E{(bf16*)(ws + WS_Y), (const unsigned char*)(ws + WS_GATE), lut};
        pg8::gemm_phase<pg8::EpiGateMerge, pg8::StaticOrder, true>(F.lds + RING_OFF, g, S, E, F.tid);
#endif
        if (IN(9)) GRID_BAR(7); PB_END(7);
    }
    if (IN(9)) { FRESH(); PB_BEGIN(9);
        pg8::Gemm g{(const bf16*)(ws + WS_Y), (const bf16*)(ws + WS_WOUT), 2048, 2048, 2048, nullptr, 0x7f7f7f7f, 0x7f7f7f7f}; pg8::StaticOrder S; S.init(M, DM, F.G, (int)blockIdx.x);
        pg8::EpiPlain E{(bf16*)(ws + WS_YO), 2048};
        pg8::gemm_phase<pg8::EpiPlain, pg8::StaticOrder, true>(F.lds + RING_OFF, g, S, E, F.tid);
        if (BOTH(9)) GRID_BAR(9); PB_END(9);
    }
    if (IN(10)) { FRESH(); PB_BEGIN(10); p10_norm_router(F); if (BOTH(10)) GRID_BAR(10); PB_END(10); }
    if (IN(11)) { FRESH(); PB_BEGIN(11); p11_topk(F); if (BOTH(11)) GRID_BAR(11); PB_END(11); }
    if (IN(12)) { FRESH(); PB_BEGIN(12);
        pg8::Gemm g{(const bf16*)(ws + WS_H), (const bf16*)(ws + WS_WGU), 2048, 2048, 2048, (const int*)(ws + WS_ROWIDX), 0x7d7d7d7d, 0x79797979}; pg8::ExpertOrder S; S.init(NE, 8, 16, F.G, (int)blockIdx.x);
        pg8::EpiSwiGLU E{(bf16*)(ws + WS_ACT)};
        pg8::gemm_phase<pg8::EpiSwiGLU, pg8::ExpertOrder, true, true, true>(F.lds + RING_OFF, g, S, E, F.tid);
        if (BOTH(12)) GRID_BAR(12); PB_END(12);
    }
    if (IN(13)) { FRESH(); PB_BEGIN(13);
        pg8::Gemm g{(const bf16*)(ws + WS_ACT), (const bf16*)(ws + WS_WDN), 2048, 2048, 2048, nullptr, 0x7f7f7f7f, 0x79797979}; pg8::ExpertOrder S; S.init(NE, 8, 8, F.G, (int)blockIdx.x);
        pg8::EpiDown E{(bf16*)(ws + WS_YEXP), (const float*)(ws + WS_TOPW)};
        pg8::gemm_phase<pg8::EpiDown, pg8::ExpertOrder, true, false, true>(F.lds + RING_OFF, g, S, E, F.tid);
        if (BOTH(13)) GRID_BAR(13); PB_END(13);
    }
    if (IN(14)) { FRESH(); PB_BEGIN(14); p14_final(F); VM_WAIT(); __syncthreads(); PB_END(14); }
    if ((PROBE_MASK != 0 || PROBE_SUB >= 0) && blockIdx.x == 0 && F.tid == 0) { const unsigned long long a = (((unsigned long long)F.MISC[19] << 32) | F.MISC[18]) * PROBE_AMP; const unsigned long long t0 = __builtin_amdgcn_s_memrealtime();
        while (__builtin_amdgcn_s_memrealtime() - t0 < a) __builtin_amdgcn_s_sleep(8); }
#undef IN
#undef BOTH
}

extern "C" void kernel_launch(void* const* d_in, const int* in_sizes, int n_in, void* d_out, int out_size, void* d_ws, size_t ws_size, hipStream_t stream) {
    static int grid = 0;
    if (grid == 0) {
        if (n_in != 22 || out_size != M * DM || ws_size < WS_END) { fprintf(stderr, "kernel_launch: unexpected shapes: n_in %d out %d ws %zu (need %zu)\n", n_in, out_size, ws_size, (size_t)WS_END); grid = -1; return; }
        int dev = 0, cus = 0, per_cu = 0;
        if (hipGetDevice(&dev) != hipSuccess || hipDeviceGetAttribute(&cus, hipDeviceAttributeMultiprocessorCount, dev) != hipSuccess) { grid = -1; return; }
        if (hipFuncSetAttribute((const void*)fwd, hipFuncAttributeMaxDynamicSharedMemorySize, LDS_BYTES) != hipSuccess) { fprintf(stderr, "kernel_launch: hipFuncSetAttribute failed\n"); grid = -1; return; }
        if (hipOccupancyMaxActiveBlocksPerMultiprocessor(&per_cu, (const void*)fwd, NWAVES * 64, LDS_BYTES) != hipSuccess || per_cu < 1) fprintf(stderr, "kernel_launch: occupancy query reports %d\n", per_cu);
        (void)hipGetLastError();
        grid = cus - (cus % 8);
        if (grid < 8) grid = 8;
    }
    if (grid < 0) return;
    if (hipMemsetAsync((char*)d_ws + WS_CTL, 0, CTL_ZERO_BYTES, stream) != hipSuccess) return;
    Args a{};
    for (int i = 0; i < 22; ++i) a.in[i] = (const float*)d_in[i];
    a.out = (float*)d_out; a.ws = (unsigned char*)d_ws;
    if (N_LAUNCHES == 1) { a.ph_lo = 0; a.ph_hi = N_PHASES; hipLaunchKernelGGL(fwd, dim3(grid), dim3(NWAVES * 64), LDS_BYTES, stream, a); }
    else for (int p = 0; p < N_PHASES; ++p) { a.ph_lo = p; a.ph_hi = p + 1; hipLaunchKernelGGL(fwd, dim3(grid), dim3(NWAVES * 64), LDS_BYTES, stream, a); }
    const hipError_t le = hipPeekAtLastError();
    if (le != hipSuccess) fprintf(stderr, "kernel_launch: launch failed: %s\n", hipGetErrorName(le));
}
```
